# Optimizing an MI355X kernel written in HIP

```python
import math
import jax, jax.numpy as jnp
from jax import lax
import numpy as np

D_MODEL = 1024
BATCH = 16
SEQ = 4096
DEPTH = 4

GRID_W = 64
CTX_LEN = 256
HEAD_DIM = 64
ATTN_WIDTH = D_MODEL // 2
N_HEADS = ATTN_WIDTH // HEAD_DIM
KV_HEADS = N_HEADS // 4
Q_PER_KV = N_HEADS // KV_HEADS
KV_WIDTH = KV_HEADS * HEAD_DIM
WINDOW = 128
ATTN_BLOCK = WINDOW
ATTN_SCALE = HEAD_DIM ** -0.5
ROPE_BASE = 10000.0
ROPE_PAIRS = HEAD_DIM // 4
SSM_WIDTH = D_MODEL // 4
SSM_GROUP = 16
SSM_GROUPS = SSM_WIDTH // SSM_GROUP
SSM_STATE = 64
LOG_DT_MIN = math.log(1e-3)
LOG_DT_MAX = math.log(1e-1)
CONV_WIDTH = D_MODEL // 4
CONV_K = 3
MIX_WIDTH = ATTN_WIDTH + SSM_WIDTH + CONV_WIDTH
Q_END = ATTN_WIDTH
K_END = Q_END + KV_WIDTH
V_END = K_END + KV_WIDTH
U_END = V_END + SSM_WIDTH
GB_END = U_END + CONV_WIDTH
GC_END = GB_END + CONV_WIDTH
IN_COLS = GC_END + CONV_WIDTH
SPLITS = (Q_END, K_END, V_END, U_END, GB_END, GC_END)
D_FF = ((8 * D_MODEL // 3 + 127) // 128) * 128
MACARON = 0.5
N_MOD = 9
EPS = 1e-6
NEG_INF = -1e30

kernel_name = 'hybrid_headgroup_diffusion_trunk'


def _rms_norm(x, g):
    xf = x.astype(jnp.float32)
    xf = xf * lax.rsqrt(jnp.mean(xf * xf, axis=-1, keepdims=True) + EPS)
    return (xf * g.astype(jnp.float32)).astype(x.dtype)


def _modulate(x, g, shift, scale):
    return _rms_norm(x, g) * (1 + scale) + shift


def _gated_post(y, g, gate):
    return gate * _rms_norm(y, g)


def _swiglu(h, wg, wu, wd):
    return (jax.nn.silu(h @ wg) * (h @ wu)) @ wd


def _ffn_sublayer(x, m, s, g_pre, g_post, wg, wu, wd):
    h = _modulate(x, g_pre, m[:, 3 * s], m[:, 3 * s + 1])
    return _gated_post(_swiglu(h, wg, wu, wd), g_post, m[:, 3 * s + 2])


def _axial_rope_tables(length):
    rows = length // GRID_W
    row = jnp.repeat(jnp.arange(rows, dtype=jnp.float32), GRID_W)
    col = jnp.tile(jnp.arange(GRID_W, dtype=jnp.float32), rows)
    inv_freq = ROPE_BASE ** (-jnp.arange(ROPE_PAIRS, dtype=jnp.float32) / ROPE_PAIRS)
    ang = jnp.stack([row[:, None] * inv_freq, col[:, None] * inv_freq], axis=1)
    return jnp.cos(ang), jnp.sin(ang)


def _apply_rope(t, cos, sin):
    tf = t.astype(jnp.float32).reshape(t.shape[:-1] + (2, 2, ROPE_PAIRS))
    t1, t2 = tf[..., 0, :], tf[..., 1, :]
    cs, sn = cos[None, :, None], sin[None, :, None]
    out = jnp.stack([t1 * cs - t2 * sn, t2 * cs + t1 * sn], axis=-2)
    return out.reshape(t.shape).astype(t.dtype)


def _band(t, nb):
    b_, length = t.shape[:2]
    tp = jnp.pad(t, ((0, 0), (ATTN_BLOCK, ATTN_BLOCK), (0, 0), (0, 0)))
    return jnp.concatenate(
        [tp[:, o * ATTN_BLOCK:o * ATTN_BLOCK + length].reshape((b_, nb, ATTN_BLOCK) + t.shape[2:]) for o in range(3)],
        axis=2)


def _window_attention(q, k, v, kc, vc, sink):
    b_, length = q.shape[:2]
    nb = length // ATTN_BLOCK
    n_loc, n_ctx = 3 * ATTN_BLOCK, kc.shape[1]
    qb = (q * ATTN_SCALE).reshape(b_, nb, ATTN_BLOCK, KV_HEADS, Q_PER_KV, HEAD_DIM)
    kb, vb = _band(k, nb), _band(v, nb)
    s_loc = jnp.einsum('bnqkgd,bnjkd->bnkgqj', qb, kb).astype(jnp.float32)
    s_ctx = jnp.einsum('bnqkgd,bckd->bnkgqc', qb, kc).astype(jnp.float32)
    qi = jnp.arange(ATTN_BLOCK)[:, None]
    kj = jnp.arange(n_loc)[None, :]
    kpos = jnp.arange(nb)[:, None, None] * ATTN_BLOCK + kj[None] - ATTN_BLOCK
    valid = (jnp.abs(kj - ATTN_BLOCK - qi) <= WINDOW)[None] & (kpos >= 0) & (kpos < length)
    s_loc = jnp.where(valid[None, :, None, None], s_loc, NEG_INF)
    sink_l = jnp.broadcast_to(sink.astype(jnp.float32).reshape(1, 1, KV_HEADS, Q_PER_KV, 1, 1), s_loc.shape[:-1] + (1,))
    p = jax.nn.softmax(jnp.concatenate([s_loc, s_ctx, sink_l], axis=-1), axis=-1).astype(v.dtype)
    out = (jnp.einsum('bnkgqj,bnjkd->bnqkgd', p[..., :n_loc], vb)
           + jnp.einsum('bnkgqc,bckd->bnqkgd', p[..., n_loc:n_loc + n_ctx], vc))
    return out.reshape(b_, length, ATTN_WIDTH)


def _context_attention(qc, kc, vc, sink):
    b_, n_ctx = qc.shape[:2]
    qg = (qc * ATTN_SCALE).reshape(b_, n_ctx, KV_HEADS, Q_PER_KV, HEAD_DIM)
    s = jnp.einsum('bqkgd,bckd->bkgqc', qg, kc).astype(jnp.float32)
    sink_c = jnp.broadcast_to(sink.astype(jnp.float32).reshape(1, KV_HEADS, Q_PER_KV, 1, 1), s.shape[:-1] + (1,))
    p = jax.nn.softmax(jnp.concatenate([s, sink_c], axis=-1), axis=-1)[..., :n_ctx].astype(vc.dtype)
    return jnp.einsum('bkgqc,bckd->bqkgd', p, vc).reshape(b_, n_ctx, ATTN_WIDTH)


def _complex_combine(left, right):
    a1r, a1i, b1r, b1i = left
    a2r, a2i, b2r, b2i = right
    return (a2r * a1r - a2i * a1i,
            a2r * a1i + a2i * a1r,
            a2r * b1r - a2i * b1i + b2r,
            a2r * b1i + a2i * b1r + b2i)


def _zoh(lam_re, lam_im, log_step, b_re, b_im):
    lr, li = lam_re.astype(jnp.float32), lam_im.astype(jnp.float32)
    dt = jnp.exp(log_step.astype(jnp.float32))[:, None]
    mag = jnp.exp(lr * dt)
    ar, ai = mag * jnp.cos(li * dt), mag * jnp.sin(li * dt)
    den = lr * lr + li * li
    gr = ((ar - 1) * lr + ai * li) / den
    gi = (ai * lr - (ar - 1) * li) / den
    br, bi = b_re.astype(jnp.float32), b_im.astype(jnp.float32)
    bbr = gr[..., None] * br - gi[..., None] * bi
    bbi = gr[..., None] * bi + gi[..., None] * br
    return ar, ai, bbr, bbi


def _diag_scan(u, ar, ai, bbr, bbi, init, reverse):
    length = u.shape[1]
    bu_r = jnp.einsum('gph,blgh->blgp', bbr, u)
    bu_i = jnp.einsum('gph,blgh->blgp', bbi, u)
    if init is not None:
        ir, ii = init
        pos = length - 1 if reverse else 0
        bu_r = bu_r.at[:, pos].add(ar * ir - ai * ii)
        bu_i = bu_i.at[:, pos].add(ar * ii + ai * ir)
    a_r = jnp.broadcast_to(ar, (1, length) + ar.shape)
    a_i = jnp.broadcast_to(ai, (1, length) + ai.shape)
    _, _, s_r, s_i = lax.associative_scan(_complex_combine, (a_r, a_i, bu_r, bu_i), reverse=reverse, axis=1)
    return s_r, s_i


def _readout(cr, ci, sr, si):
    return jnp.einsum('ghp,blgp->blgh', cr, sr) - jnp.einsum('ghp,blgp->blgh', ci, si)


def _glu(y, w, b):
    g = jax.nn.gelu(y)
    return g * jax.nn.sigmoid(g @ w + b)


def _s5_mixer(u, uc, lam_re, lam_im, log_step, b_re, b_im, c_re, c_im, d_skip, w_glu, b_glu, ctx_out):
    b_, length, _ = u.shape
    n_ctx = uc.shape[1]
    uf = u.astype(jnp.float32).reshape(b_, length, SSM_GROUPS, SSM_GROUP)
    ucf = uc.astype(jnp.float32).reshape(b_, n_ctx, SSM_GROUPS, SSM_GROUP)
    d = d_skip.astype(jnp.float32).reshape(SSM_GROUPS, SSM_GROUP)
    y = d * uf
    yc = d * ucf if ctx_out else None
    for dirn in range(2):
        rev = dirn == 1
        ar, ai, bbr, bbi = _zoh(lam_re[dirn], lam_im[dirn], log_step[dirn], b_re[dirn], b_im[dirn])
        cr, ci = c_re[dirn].astype(jnp.float32), c_im[dirn].astype(jnp.float32)
        sc_r, sc_i = _diag_scan(ucf, ar, ai, bbr, bbi, None, rev)
        end = 0 if rev else -1
        s_r, s_i = _diag_scan(uf, ar, ai, bbr, bbi, (sc_r[:, end], sc_i[:, end]), rev)
        y = y + _readout(cr, ci, s_r, s_i)
        if ctx_out:
            yc = yc + _readout(cr, ci, sc_r, sc_i)
    out = _glu(y.reshape(b_, length, SSM_WIDTH).astype(u.dtype), w_glu, b_glu)
    out_c = _glu(yc.reshape(b_, n_ctx, SSM_WIDTH).astype(uc.dtype), w_glu, b_glu) if ctx_out else None
    return out, out_c


def _short_conv(t, w):
    tp = jnp.pad(t, ((0, 0), (1, 1), (0, 0)))
    return tp[:, :-2] * w[0] + tp[:, 1:-1] * w[1] + tp[:, 2:] * w[2]


def _token_mixer(h, hc, cos, sin, w_in, w_out, sink, lam_re, lam_im, log_step, b_re, b_im, c_re, c_im,
                 d_skip, w_glu, b_glu, conv_w, ctx_out):
    b_, length, _ = h.shape
    n_ctx = hc.shape[1]
    q, k, v, u, gb, gc, z = jnp.split(h @ w_in, SPLITS, axis=-1)
    q = _apply_rope(q.reshape(b_, length, N_HEADS, HEAD_DIM), cos, sin)
    k = _apply_rope(k.reshape(b_, length, KV_HEADS, HEAD_DIM), cos, sin)
    v = v.reshape(b_, length, KV_HEADS, HEAD_DIM)
    kc, vc, uc = jnp.split(hc @ w_in[:, Q_END:U_END], (KV_WIDTH, 2 * KV_WIDTH), axis=-1)
    kc = kc.reshape(b_, n_ctx, KV_HEADS, HEAD_DIM)
    vc = vc.reshape(b_, n_ctx, KV_HEADS, HEAD_DIM)
    attn = _window_attention(q, k, v, kc, vc, sink)
    ssm, ssm_c = _s5_mixer(u, uc, lam_re, lam_im, log_step, b_re, b_im, c_re, c_im, d_skip, w_glu, b_glu, ctx_out)
    conv = gb * _short_conv(gc * z, conv_w)
    y = jnp.concatenate([attn, ssm, conv], axis=-1) @ w_out
    if not ctx_out:
        return y, None
    qc = (hc @ w_in[:, :Q_END]).reshape(b_, n_ctx, N_HEADS, HEAD_DIM)
    gbc, gcc, zc = jnp.split(hc @ w_in[:, U_END:], (CONV_WIDTH, 2 * CONV_WIDTH), axis=-1)
    yc = jnp.concatenate([_context_attention(qc, kc, vc, sink), ssm_c, gbc * _short_conv(gcc * zc, conv_w)], axis=-1) @ w_out
    return y, yc


def setup_inputs(seed: int = 0) -> dict:
    key = jax.random.key(seed)
    ks = jax.random.split(key, 26)
    f32 = jnp.float32

    def nrm(k, shape, s):
        return jax.random.normal(k, shape, f32) * s

    sg = (DEPTH, 2, SSM_GROUPS, SSM_STATE)
    n_idx = jnp.arange(SSM_STATE, dtype=f32)
    return {
        'x': nrm(ks[0], (BATCH, SEQ, D_MODEL), 1.0),
        'c': nrm(ks[1], (BATCH, D_MODEL), 1.0),
        'ctx': nrm(ks[2], (BATCH, CTX_LEN, D_MODEL), 1.0),
        'c_ctx': nrm(ks[3], (D_MODEL,), 1.0),
        'w_ada': nrm(ks[4], (DEPTH, D_MODEL, N_MOD * D_MODEL), 0.5 * D_MODEL ** -0.5),
        'b_ada': nrm(ks[5], (DEPTH, N_MOD * D_MODEL), 0.02),
        'norm_pre': 1.0 + nrm(ks[6], (DEPTH, 3, D_MODEL), 0.02),
        'norm_post': 1.0 + nrm(ks[7], (DEPTH, 3, D_MODEL), 0.02),
        'ffn_w_gate': nrm(ks[8], (DEPTH, 2, D_MODEL, D_FF), D_MODEL ** -0.5),
        'ffn_w_up': nrm(ks[9], (DEPTH, 2, D_MODEL, D_FF), D_MODEL ** -0.5),
        'ffn_w_down': nrm(ks[10], (DEPTH, 2, D_FF, D_MODEL), D_FF ** -0.5),
        'w_in': nrm(ks[11], (DEPTH, D_MODEL, IN_COLS), D_MODEL ** -0.5),
        'w_out': nrm(ks[12], (DEPTH, MIX_WIDTH, D_MODEL), MIX_WIDTH ** -0.5),
        'attn_sink': nrm(ks[13], (DEPTH, N_HEADS), 1.0),
        'ssm_lambda_re': -0.5 + nrm(ks[14], sg, 0.01),
        'ssm_lambda_im': jnp.pi * n_idx + nrm(ks[15], sg, 0.01),
        'ssm_log_step': jax.random.uniform(ks[16], (DEPTH, 2, SSM_GROUPS), f32, LOG_DT_MIN, LOG_DT_MAX),
        'ssm_b_re': nrm(ks[17], sg + (SSM_GROUP,), (2 * SSM_GROUP) ** -0.5),
        'ssm_b_im': nrm(ks[18], sg + (SSM_GROUP,), (2 * SSM_GROUP) ** -0.5),
        'ssm_c_re': nrm(ks[19], (DEPTH, 2, SSM_GROUPS, SSM_GROUP, SSM_STATE), SSM_STATE ** -0.5),
        'ssm_c_im': nrm(ks[20], (DEPTH, 2, SSM_GROUPS, SSM_GROUP, SSM_STATE), SSM_STATE ** -0.5),
        'ssm_d': nrm(ks[21], (DEPTH, SSM_WIDTH), 1.0),
        'ssm_w_glu': nrm(ks[22], (DEPTH, SSM_WIDTH, SSM_WIDTH), SSM_WIDTH ** -0.5),
        'ssm_b_glu': nrm(ks[23], (DEPTH, SSM_WIDTH), 0.02),
        'conv_w': nrm(ks[24], (DEPTH, CONV_K, CONV_WIDTH), CONV_K ** -0.5),
    }


def reference(x, c, ctx, c_ctx, w_ada, b_ada, norm_pre, norm_post, ffn_w_gate, ffn_w_up, ffn_w_down,
              w_in, w_out, attn_sink, ssm_lambda_re, ssm_lambda_im, ssm_log_step, ssm_b_re, ssm_b_im,
              ssm_c_re, ssm_c_im, ssm_d, ssm_w_glu, ssm_b_glu, conv_w):
    b_, length, _ = x.shape
    cos, sin = _axial_rope_tables(length)
    silu_c = jax.nn.silu(c)
    silu_cc = jax.nn.silu(c_ctx)
    xc = ctx
    for l in range(DEPTH):
        last = l == DEPTH - 1
        m = (silu_c @ w_ada[l] + b_ada[l]).reshape(b_, N_MOD, 1, D_MODEL)
        mc = (silu_cc @ w_ada[l] + b_ada[l]).reshape(1, N_MOD, 1, D_MODEL)
        f0 = (norm_pre[l, 0], norm_post[l, 0], ffn_w_gate[l, 0], ffn_w_up[l, 0], ffn_w_down[l, 0])
        x = x + MACARON * _ffn_sublayer(x, m, 0, *f0)
        xc = xc + MACARON * _ffn_sublayer(xc, mc, 0, *f0)
        h = _modulate(x, norm_pre[l, 1], m[:, 3], m[:, 4])
        hc = _modulate(xc, norm_pre[l, 1], mc[:, 3], mc[:, 4])
        y, yc = _token_mixer(h, hc, cos, sin, w_in[l], w_out[l], attn_sink[l],
                             ssm_lambda_re[l], ssm_lambda_im[l], ssm_log_step[l], ssm_b_re[l], ssm_b_im[l],
                             ssm_c_re[l], ssm_c_im[l], ssm_d[l], ssm_w_glu[l], ssm_b_glu[l], conv_w[l],
                             not last)
        x = x + _gated_post(y, norm_post[l, 1], m[:, 5])
        f1 = (norm_pre[l, 2], norm_post[l, 2], ffn_w_gate[l, 1], ffn_w_up[l, 1], ffn_w_down[l, 1])
        x = x + MACARON * _ffn_sublayer(x, m, 2, *f1)
        if not last:
            xc = xc + _gated_post(yc, norm_post[l, 1], mc[:, 5])
            xc = xc + MACARON * _ffn_sublayer(xc, mc, 2, *f1)
    return x
```

```cpp
#include <hip/hip_runtime.h>
#include <hip/hip_cooperative_groups.h>
#include <cstdio>
#include <cstdint>
namespace cg = cooperative_groups;

#define LAS __attribute__((address_space(3)))
typedef unsigned short bf16_t;
typedef short bf16x8 __attribute__((ext_vector_type(8)));
typedef short s16x4 __attribute__((ext_vector_type(4)));
typedef float f32x4 __attribute__((ext_vector_type(4)));
typedef float f32x16 __attribute__((ext_vector_type(16)));
typedef float f32x2 __attribute__((ext_vector_type(2)));
typedef __bf16 bf16x2_t __attribute__((ext_vector_type(2)));
typedef unsigned u32x4 __attribute__((ext_vector_type(4)));
typedef unsigned u32x2 __attribute__((ext_vector_type(2)));

constexpr int NB = 16, SEQL = 4096, NCTX = 256, DM = 1024, DEPTH = 4;
constexpr int ML = NB * SEQL;
constexpr int MC = NB * NCTX;
constexpr int MT = ML + MC;
constexpr int DFF = 2816, INC = 1792, NMOD = 9 * DM;
constexpr int NCHUNK = MT / 16;
constexpr int VTP = SEQL + NCTX;
constexpr float EPS = 1e-6f;
constexpr float LOG2E = 1.4426950408889634f;
constexpr float QSCALE = 0.125f * LOG2E;

constexpr size_t MiB = 1u << 20;
constexpr size_t WS_WGU = 0;
constexpr size_t WS_WD = 88 * MiB;
constexpr size_t WS_WIN = 132 * MiB;
constexpr size_t WS_WOUT = 146 * MiB;
constexpr size_t WS_WGLU = 154 * MiB;
constexpr size_t WS_SOUT = 155 * MiB;
constexpr size_t WS_SST = 171 * MiB;
constexpr size_t WS_MOD = 179 * MiB;
constexpr size_t WS_MODP = 620 * MiB;
constexpr size_t WS_KT = 660 * MiB;
constexpr size_t WS_APOW = 192 * MiB;
constexpr size_t WS_BBAR = 194 * MiB;
constexpr size_t WS_CS = 195 * MiB;
constexpr size_t WS_XC = 196 * MiB;
constexpr size_t WS_H = 212 * MiB;
constexpr size_t WS_Y = 348 * MiB;
constexpr size_t WS_Y2 = WS_Y + 136 * MiB;
constexpr size_t WS_G = 620 * MiB;
constexpr size_t WS_Q = WS_G;
constexpr size_t WS_K = WS_Q + 68 * MiB;
constexpr size_t WS_VT = WS_K + 17 * MiB;
constexpr size_t WS_SSMA = WS_VT + 17 * MiB;
constexpr size_t WS_SL = WS_SSMA + 68 * MiB;
constexpr size_t WS_CZ = WS_SL + 68 * MiB;
constexpr size_t WS_YG = WS_CZ + 102 * MiB;
constexpr size_t WS_END = 994 * MiB;
static_assert(WS_YG + 34 * MiB <= WS_END, "ws map");
static_assert((size_t)MT * DFF * 2 <= 374 * MiB, "G fits");

__device__ __forceinline__ unsigned pk2(float lo, float hi) { f32x2 v = {lo, hi}; bf16x2_t b = __builtin_convertvector(v, bf16x2_t); return __builtin_bit_cast(unsigned, b); }
__device__ __forceinline__ unsigned short f2bf(float f) { unsigned u = __builtin_bit_cast(unsigned, f); return (unsigned short)((u + 0x7fffu + ((u >> 16) & 1u)) >> 16); }
__device__ __forceinline__ float bf2f(unsigned short b) { return __builtin_bit_cast(float, (unsigned)b << 16); }
__device__ __forceinline__ float silu_f(float g) { return g * __builtin_amdgcn_rcpf(1.0f + __builtin_amdgcn_exp2f(-g * LOG2E)); }
__device__ __forceinline__ float sigmoid_f(float g) { return __builtin_amdgcn_rcpf(1.0f + __builtin_amdgcn_exp2f(-g * LOG2E)); }
__device__ __forceinline__ float gelu_tanh_f(float y) { const float t = 0.7978845608028654f * (y + 0.044715f * y * y * y); return y * __builtin_amdgcn_rcpf(1.0f + __builtin_amdgcn_exp2f(-2.0f * LOG2E * t)); }
__device__ __forceinline__ float shx(float v, int lane, int o) { return __builtin_bit_cast(float, __builtin_amdgcn_ds_bpermute((lane ^ o) << 2, __builtin_bit_cast(int, v))); }
__device__ __forceinline__ float wave_sum(float v, int lane) {
#pragma unroll
    for (int o = 1; o < 64; o <<= 1) v += shx(v, lane, o);
    return v;
}
__device__ __forceinline__ float exp_f(float x) { return __builtin_amdgcn_exp2f(x * LOG2E); }

namespace pg8 {
constexpr int BM = 256, BK = 64, HALF = 128, HTB = HALF * BK * 2, STAGE_BYTES = 8 * HTB, NXCD = 8, WGM = 4;
__host__ __device__ __forceinline__ int lds_byte(int r, int c) { const int st = (r >> 4) * 2 + (c >> 5), rr = r & 15, cc = c & 31, ob = rr * 64 + cc * 2; return st * 1024 + (ob ^ (((ob >> 9) & 1) << 5)); }
__host__ __device__ __forceinline__ void stage_rc(int b, int& R, int& C) { const int st = b / 1024, sb = b % 1024, swz = sb ^ (((sb >> 9) & 1) << 5); R = (st >> 1) * 16 + swz / 64; C = (st & 1) * 32 + (swz % 64) / 2; }
__host__ __device__ __forceinline__ int perm32(int rho) { const int n = rho >> 4, i = rho & 15; return 8 * (i >> 2) + 4 * n + (i & 3); }

struct Unit { int pm, pn, z; };
struct Gemm { const bf16_t* A; const bf16_t* Bt; int M, N, K, lda, ldb; size_t zsA, zsB; int nz; };

struct StaticOrder {
    int nM, nN, nwg, G, c, nz;
    __device__ void init(int M, int N, int nz_, int G_, int c_) { nM = M / BM; nN = N / BM; nwg = nM * nN; G = G_; c = c_; nz = nz_; }
    __device__ bool next(int i, Unit& u) const {
        const long L = (long)i * G + c; if (L >= (long)nwg * nz) return false;
        u.z = (int)(L / nwg);
        int wgid = (int)(L % nwg); { const int q = nwg / NXCD, r = nwg % NXCD, xcd = wgid % NXCD, off = wgid / NXCD; wgid = (xcd < r ? xcd * (q + 1) : r * (q + 1) + (xcd - r) * q) + off; }
        const int nig = WGM * nN, gid = wgid / nig, fm = gid * WGM, gsz = (nM - fm) < WGM ? (nM - fm) : WGM;
        u.pm = fm + ((wgid % nig) % gsz); u.pn = (wgid % nig) / gsz; return true;
    }
};

template <class Epi, bool ALIGN_EPI, bool SP2, bool ZB>
__device__ __forceinline__ void gemm_phase(LAS unsigned char* lds, const int tid, const Gemm g, const StaticOrder& S, const Epi& E) {
    const int wid = __builtin_amdgcn_readfirstlane(tid >> 6), lane = tid & 63, wr = wid >> 2, wc = wid & 3, fr = lane & 15, fq = lane >> 4;
    const int K = g.K, nt = K / BK, lda = g.lda, ldb = g.ldb;
    unsigned voffA[2], voffB[2];
#pragma unroll
    for (int i = 0; i < 2; ++i) { int R, C; stage_rc(tid * 16 + i * 8192, R, C); const int Rb = Epi::PERM ? ((R & ~31) + perm32(R & 31)) : R;
        voffA[i] = (unsigned)(R * lda + C) * 2u; voffB[i] = (unsigned)(Rb * ldb + C) * 2u; }
    const size_t kstep = (size_t)(BK * 2);
    const size_t hstepA = (size_t)HALF * lda * 2, hstepB = (size_t)HALF * ldb * 2;
    const size_t tstepA = 2 * hstepA, tstepB = 2 * hstepB;
    const unsigned ldsw = (unsigned)wid * 1024u;
    const int aoff = lds_byte(wr * 64 + fr, fq * 8), boff = lds_byte(wc * 32 + fr, fq * 8);
#define PG8_SA(b, h) (((b) * 2 + (h)) * HTB)
#define PG8_SB(b, h) ((4 + (b) * 2 + (h)) * HTB)
#define PG8_STAGE(bufoff, gbase, voff) do { _Pragma("unroll") for (int _i = 0; _i < 2; ++_i) { unsigned _vo = (voff)[_i]; asm volatile("" : "+v"(_vo)); \
        __builtin_amdgcn_global_load_lds((const unsigned*)((const char*)(gbase) + _vo), (LAS unsigned*)(lds + (bufoff) + ldsw + _i * 8192), 16, 0, 0); } } while (0)
#define PG8_LDA(dst, b, h) do { _Pragma("unroll") for (int m = 0; m < 4; ++m) _Pragma("unroll") for (int k = 0; k < 2; ++k) dst[m][k] = *(const LAS bf16x8*)(lds + PG8_SA(b, h) + aoff + m * 2048 + k * 1024); } while (0)
#define PG8_LDB(dst, b, h) do { _Pragma("unroll") for (int n = 0; n < 2; ++n) _Pragma("unroll") for (int k = 0; k < 2; ++k) dst[n][k] = *(const LAS bf16x8*)(lds + PG8_SB(b, h) + boff + n * 2048 + k * 1024); } while (0)
#define PG8_MMA(ai, bj, At, Bt) do { __builtin_amdgcn_s_setprio(1); _Pragma("unroll") for (int m = 0; m < 4; ++m) _Pragma("unroll") for (int n = 0; n < 2; ++n) _Pragma("unroll") for (int k = 0; k < 2; ++k) \
        acc[ai][bj][m][n] = __builtin_amdgcn_mfma_f32_16x16x32_bf16(Bt[n][k], At[m][k], acc[ai][bj][m][n], 0, 0, 0); __builtin_amdgcn_s_setprio(0); } while (0)
#define PG8_WAIT_V(n) asm volatile("s_waitcnt vmcnt(" #n ")" ::: "memory")
#define PG8_WAIT_L(n) asm volatile("s_waitcnt lgkmcnt(" #n ")" ::: "memory")
#define PG8_BAR __builtin_amdgcn_s_barrier()
#define PG8_SCHED __builtin_amdgcn_sched_barrier(0)
    Unit cur, nxt; int ui = 0;
    if (!S.next(0, cur)) return;
    f32x4 acc[2][2][4][2];
#pragma unroll
    for (int a = 0; a < 2; ++a)
#pragma unroll
        for (int b = 0; b < 2; ++b)
#pragma unroll
            for (int m = 0; m < 4; ++m)
#pragma unroll
                for (int n = 0; n < 2; ++n) acc[a][b][m][n] = (f32x4){0.f, 0.f, 0.f, 0.f};
    bf16x8 At[4][2], B0[2][2], B1[2][2];
    const char* cA = (const char*)g.A + (ZB ? (size_t)cur.z * g.zsA : (size_t)0) + (size_t)cur.pm * tstepA; const char* cB = (const char*)g.Bt + (ZB ? (size_t)cur.z * g.zsB : (size_t)0) + (size_t)cur.pn * tstepB;
    if constexpr (SP2) {
        PG8_STAGE(PG8_SB(0, 0), cB, voffB); PG8_STAGE(PG8_SB(0, 1), cB + hstepB, voffB); PG8_STAGE(PG8_SA(0, 0), cA, voffA); PG8_STAGE(PG8_SA(0, 1), cA + hstepA, voffA);
        if (wr == 1) PG8_BAR;
        PG8_WAIT_V(2); PG8_BAR;
        PG8_STAGE(PG8_SB(1, 0), cB + kstep, voffB); PG8_STAGE(PG8_SA(1, 0), cA + kstep, voffA); PG8_STAGE(PG8_SB(1, 1), cB + hstepB + kstep, voffB);
        PG8_WAIT_V(6); PG8_BAR;
    } else {
        PG8_STAGE(PG8_SB(0, 0), cB, voffB); PG8_STAGE(PG8_SA(0, 0), cA, voffA); PG8_STAGE(PG8_SB(0, 1), cB + hstepB, voffB); PG8_STAGE(PG8_SA(0, 1), cA + hstepA, voffA);
        if (wr == 1) PG8_BAR;
        PG8_WAIT_V(4); PG8_BAR;
        PG8_STAGE(PG8_SB(1, 0), cB + kstep, voffB); PG8_STAGE(PG8_SA(1, 0), cA + kstep, voffA); PG8_STAGE(PG8_SB(1, 1), cB + hstepB + kstep, voffB);
        PG8_WAIT_V(6); PG8_BAR;
    }
    for (;;) {
        const bool has_next = S.next(ui + 1, nxt);
        const char* nA = has_next ? (const char*)g.A + (ZB ? (size_t)nxt.z * g.zsA : (size_t)0) + (size_t)nxt.pm * tstepA : cA; const char* nB = has_next ? (const char*)g.Bt + (ZB ? (size_t)nxt.z * g.zsB : (size_t)0) + (size_t)nxt.pn * tstepB : cB;
        for (int t = 0; t < nt; t += 2) {
            const bool last = (t == nt - 2);
            const char* a1 = cA + (size_t)(t + 1) * kstep;
            const char* a2 = last ? nA : cA + (size_t)(t + 2) * kstep; const char* b2 = last ? nB : cB + (size_t)(t + 2) * kstep;
            const char* a3 = a2 + kstep; const char* b3 = b2 + kstep;
            if constexpr (SP2) {
            PG8_LDB(B0, 0, 0); PG8_LDB(B1, 0, 1); PG8_SCHED; PG8_LDA(At, 0, 0); PG8_STAGE(PG8_SA(1, 1), a1 + hstepA, voffA);
            PG8_WAIT_V(8); PG8_WAIT_L(0); PG8_BAR; PG8_MMA(0, 0, At, B0); PG8_MMA(0, 1, At, B1); PG8_BAR; PG8_SCHED;
            PG8_LDA(At, 0, 1); PG8_STAGE(PG8_SB(0, 0), b2, voffB); PG8_STAGE(PG8_SB(0, 1), b2 + hstepB, voffB); PG8_STAGE(PG8_SA(0, 0), a2, voffA);
            PG8_WAIT_V(8); PG8_WAIT_L(0); PG8_BAR; PG8_MMA(1, 0, At, B0); PG8_MMA(1, 1, At, B1); PG8_BAR; PG8_SCHED;
            PG8_LDB(B0, 1, 0); PG8_LDB(B1, 1, 1); PG8_SCHED; PG8_LDA(At, 1, 0); PG8_STAGE(PG8_SA(0, 1), a2 + hstepA, voffA);
            PG8_WAIT_V(8); PG8_WAIT_L(0); PG8_BAR; PG8_MMA(0, 0, At, B0); PG8_MMA(0, 1, At, B1); PG8_BAR; PG8_SCHED;
            PG8_LDA(At, 1, 1); PG8_STAGE(PG8_SB(1, 0), b3, voffB); PG8_STAGE(PG8_SB(1, 1), b3 + hstepB, voffB); PG8_STAGE(PG8_SA(1, 0), a3, voffA);
            PG8_WAIT_V(8); PG8_WAIT_L(0); PG8_BAR; PG8_MMA(1, 0, At, B0); PG8_MMA(1, 1, At, B1); PG8_BAR; PG8_SCHED;
            } else {
            PG8_LDB(B0, 0, 0); PG8_SCHED; PG8_LDA(At, 0, 0); PG8_STAGE(PG8_SA(1, 1), a1 + hstepA, voffA);
            PG8_WAIT_L(8); PG8_BAR; PG8_WAIT_L(0); PG8_MMA(0, 0, At, B0); PG8_BAR; PG8_SCHED;
            PG8_LDB(B1, 0, 1); PG8_STAGE(PG8_SB(0, 0), b2, voffB);
            PG8_BAR; PG8_WAIT_L(0); PG8_MMA(0, 1, At, B1); PG8_BAR;
            PG8_LDA(At, 0, 1); PG8_STAGE(PG8_SA(0, 0), a2, voffA);
            PG8_BAR; PG8_WAIT_L(0); PG8_MMA(1, 0, At, B0); PG8_BAR; PG8_SCHED;
            PG8_STAGE(PG8_SB(0, 1), b2 + hstepB, voffB);
            PG8_WAIT_V(6); PG8_BAR; PG8_MMA(1, 1, At, B1); PG8_BAR;
            PG8_LDB(B0, 1, 0); PG8_SCHED; PG8_LDA(At, 1, 0); PG8_STAGE(PG8_SA(0, 1), a2 + hstepA, voffA);
            PG8_WAIT_L(8); PG8_BAR; PG8_WAIT_L(0); PG8_MMA(0, 0, At, B0); PG8_BAR; PG8_SCHED;
            PG8_LDB(B1, 1, 1); PG8_STAGE(PG8_SB(1, 0), b3, voffB);
            PG8_BAR; PG8_WAIT_L(0); PG8_MMA(0, 1, At, B1); PG8_BAR;
            PG8_LDA(At, 1, 1); PG8_STAGE(PG8_SA(1, 0), a3, voffA);
            PG8_BAR; PG8_WAIT_L(0); PG8_MMA(1, 0, At, B0); PG8_BAR; PG8_SCHED;
            PG8_STAGE(PG8_SB(1, 1), b3 + hstepB, voffB);
            PG8_WAIT_V(6); PG8_BAR; PG8_MMA(1, 1, At, B1); PG8_BAR;
            }
        }
        if constexpr (ALIGN_EPI) { if (wr == 0) PG8_BAR; }
        { const int lane_e = (int)__builtin_amdgcn_mbcnt_hi(~0u, __builtin_amdgcn_mbcnt_lo(~0u, 0u)); E(acc, cur, wr, wc, lane_e); }
        if (!has_next) break;
#pragma unroll
        for (int a = 0; a < 2; ++a)
#pragma unroll
            for (int b = 0; b < 2; ++b)
#pragma unroll
                for (int m = 0; m < 4; ++m)
#pragma unroll
                    for (int n = 0; n < 2; ++n) acc[a][b][m][n] = (f32x4){0.f, 0.f, 0.f, 0.f};
        cur = nxt; cA = nA; cB = nB; ++ui;
        if constexpr (ALIGN_EPI) { if (wr == 1) PG8_BAR; }
    }
    PG8_WAIT_V(0);
    if constexpr (!ALIGN_EPI) { if (wr == 0) PG8_BAR; }
    PG8_BAR;
#undef PG8_SA
#undef PG8_SB
#undef PG8_STAGE
#undef PG8_LDA
#undef PG8_LDB
#undef PG8_MMA
#undef PG8_WAIT_V
#undef PG8_WAIT_L
#undef PG8_BAR
#undef PG8_SCHED
}

typedef f32x4 Acc[2][2][4][2];

struct EpiSwiGLU {
    static constexpr bool PERM = true;
    bf16_t* G;
    __device__ __forceinline__ void operator()(const Acc& acc, const Unit& u, int wr, int wc, int lane) const {
        asm volatile("" : "+v"(lane)); const int fr = lane & 15, fq = lane >> 4;
        const int row0 = u.pm * BM + wr * 64 + fr, col0 = u.pn * 128 + wc * 32 + 8 * fq;
#pragma unroll
        for (int ai = 0; ai < 2; ++ai)
#pragma unroll
            for (int m = 0; m < 4; ++m) {
                const f32x4 g0 = acc[ai][0][m][0], g1 = acc[ai][0][m][1], u0 = acc[ai][1][m][0], u1 = acc[ai][1][m][1];
                u32x4 w;
                w.x = pk2(silu_f(g0[0]) * u0[0], silu_f(g0[1]) * u0[1]); w.y = pk2(silu_f(g0[2]) * u0[2], silu_f(g0[3]) * u0[3]);
                w.z = pk2(silu_f(g1[0]) * u1[0], silu_f(g1[1]) * u1[1]); w.w = pk2(silu_f(g1[2]) * u1[2], silu_f(g1[3]) * u1[3]);
                *(u32x4*)(G + (size_t)(row0 + ai * HALF + m * 16) * DFF + col0) = w;
            }
    }
};

struct EpiF32 {
    static constexpr bool PERM = false;
    float* Y; int ldc; size_t zs;
    __device__ __forceinline__ void operator()(const Acc& acc, const Unit& u, int wr, int wc, int lane) const {
        asm volatile("" : "+v"(lane)); const int fr = lane & 15, fq = lane >> 4;
        float* base = Y + (size_t)u.z * zs;
        const int row0 = u.pm * BM + wr * 64 + fr, col0 = u.pn * BM + wc * 32 + 4 * fq;
#pragma unroll
        for (int ai = 0; ai < 2; ++ai)
#pragma unroll
            for (int m = 0; m < 4; ++m) { float* rp = base + (size_t)(row0 + ai * HALF + m * 16) * ldc + col0;
#pragma unroll
                for (int bj = 0; bj < 2; ++bj)
#pragma unroll
                    for (int n = 0; n < 2; ++n) *(f32x4*)(rp + bj * HALF + n * 16) = acc[ai][bj][m][n]; }
    }
};

struct EpiBf16Y {
    static constexpr bool PERM = true;
    bf16_t* Y; bf16_t* Yz1;
    __device__ __forceinline__ void operator()(const Acc& acc, const Unit& u, int wr, int wc, int lane) const {
        asm volatile("" : "+v"(lane)); const int fr = lane & 15, fq = lane >> 4;
        const int row0 = u.pm * BM + wr * 64 + fr, col0 = u.pn * BM + wc * 32 + 8 * fq;
        bf16_t* Yb = u.z ? Yz1 : Y;
#pragma unroll
        for (int ai = 0; ai < 2; ++ai)
#pragma unroll
            for (int m = 0; m < 4; ++m) { bf16_t* rp = Yb + (size_t)(row0 + ai * HALF + m * 16) * DM + col0;
#pragma unroll
                for (int bj = 0; bj < 2; ++bj) { const f32x4 a0 = acc[ai][bj][m][0], a1 = acc[ai][bj][m][1];
                    *(u32x4*)(rp + bj * HALF) = (u32x4){pk2(a0[0], a0[1]), pk2(a0[2], a0[3]), pk2(a1[0], a1[1]), pk2(a1[2], a1[3])}; } }
    }
};

struct EpiWin {
    static constexpr bool PERM = false;
    bf16_t *Q, *Kb, *VT, *SSMA, *CZ; const f32x2* CS;
    __device__ __forceinline__ void operator()(const Acc& acc, const Unit& u, int wr, int wc, int lane) const {
        asm volatile("" : "+v"(lane)); const int fr = lane & 15, fq = lane >> 4;
        const int pn = u.pn; const bool isctx = u.pm >= (ML / BM);
        f32x4 cc = {1.f, 1.f, 1.f, 1.f}, ss = {0.f, 0.f, 0.f, 0.f};
#pragma unroll
        for (int ai = 0; ai < 2; ++ai)
#pragma unroll
            for (int m = 0; m < 4; ++m) {
                const int r = u.pm * BM + ai * HALF + wr * 64 + m * 16 + fr;
                int b, pos;
                if (!isctx) { b = r >> 12; pos = r & 4095; } else { const int rc = r - ML; b = rc >> 8; pos = rc & 255; }
                if (pn <= 2 && !isctx) {
                    const int v = (wc & 1) ? (pos & 63) : (pos >> 6);
                    const f32x2* t = CS + v * 16 + 4 * fq;
                    const f32x2 t0 = t[0], t1 = t[1], t2 = t[2], t3 = t[3];
                    cc = (f32x4){t0.x, t1.x, t2.x, t3.x}; ss = (f32x4){t0.y, t1.y, t2.y, t3.y};
                }
#pragma unroll
                for (int bj = 0; bj < 2; ++bj) {
                    const f32x4 a0 = acc[ai][bj][m][0], a1 = acc[ai][bj][m][1];
                    const int cl = 128 * bj + 32 * wc + 4 * fq;
                    if (pn <= 1) {
                        f32x4 o0, o1;
                        if (!isctx) { o0 = a0 * cc - a1 * ss; o1 = a1 * cc + a0 * ss; } else { o0 = a0; o1 = a1; }
                        o0 = o0 * QSCALE; o1 = o1 * QSCALE;
                        bf16_t* p = Q + (size_t)r * 512 + pn * 256 + cl;
                        *(u32x2*)p = (u32x2){pk2(o0[0], o0[1]), pk2(o0[2], o0[3])}; *(u32x2*)(p + 16) = (u32x2){pk2(o1[0], o1[1]), pk2(o1[2], o1[3])};
                    } else if (pn == 2) {
                        if (bj == 0) {
                            f32x4 o0, o1;
                            if (!isctx) { o0 = a0 * cc - a1 * ss; o1 = a1 * cc + a0 * ss; } else { o0 = a0; o1 = a1; }
                            bf16_t* p = Kb + (size_t)r * 128 + 32 * wc + 4 * fq;
                            *(u32x2*)p = (u32x2){pk2(o0[0], o0[1]), pk2(o0[2], o0[3])}; *(u32x2*)(p + 16) = (u32x2){pk2(o1[0], o1[1]), pk2(o1[2], o1[3])};
                        } else {
                            const int vc = 32 * wc + 4 * fq;
                            const int pidx = isctx ? (SEQL + pos) : pos;
                            bf16_t* p = VT + ((size_t)(b * 2 + (vc >> 6)) * 64 + (vc & 63)) * VTP + pidx;
#pragma unroll
                            for (int j = 0; j < 4; ++j) { p[(size_t)j * VTP] = f2bf(a0[j]); p[(size_t)(j + 16) * VTP] = f2bf(a1[j]); }
                        }
                    } else if (pn == 3) {
                        const int g0 = 8 * bj + 2 * wc;
                        bf16_t* p = SSMA + ((size_t)g0 * NCHUNK + (r >> 4)) * 512 + (r & 15) * 16 + 4 * fq;
                        *(u32x2*)p = (u32x2){pk2(a0[0], a0[1]), pk2(a0[2], a0[3])};
                        *(u32x2*)(p + (size_t)NCHUNK * 512) = (u32x2){pk2(a1[0], a1[1]), pk2(a1[2], a1[3])};
                    } else {
                        bf16_t* p = CZ + (size_t)r * 768 + (pn - 4) * 256 + cl;
                        *(u32x2*)p = (u32x2){pk2(a0[0], a0[1]), pk2(a0[2], a0[3])}; *(u32x2*)(p + 16) = (u32x2){pk2(a1[0], a1[1]), pk2(a1[2], a1[3])};
                    }
                }
            }
    }
};

struct EpiSsmOut {
    static constexpr bool PERM = false;
    bf16_t* YG;
    __device__ __forceinline__ void operator()(const Acc& acc, const Unit& u, int wr, int wc, int lane) const {
        asm volatile("" : "+v"(lane)); const int fr = lane & 15, fq = lane >> 4;
#pragma unroll
        for (int ai = 0; ai < 2; ++ai)
#pragma unroll
            for (int m = 0; m < 4; ++m) {
                const int r = u.pm * BM + ai * HALF + wr * 64 + m * 16 + fr;
#pragma unroll
                for (int bj = 0; bj < 2; ++bj)
#pragma unroll
                    for (int n = 0; n < 2; ++n) {
                        const int t = 8 * bj + 2 * wc + n; const f32x4 a = acc[ai][bj][m][n];
                        bf16_t* p = YG + (size_t)(r * 16 + t) * 256 + u.z * 16 + 4 * fq;
                        *(u32x2*)p = (u32x2){pk2(gelu_tanh_f(a[0]), gelu_tanh_f(a[1])), pk2(gelu_tanh_f(a[2]), gelu_tanh_f(a[3]))};
                    }
            }
    }
};

struct EpiGlu {
    static constexpr bool PERM = true;
    const bf16_t* YG; const float* bias; bf16_t* MIX;
    __device__ __forceinline__ void operator()(const Acc& acc, const Unit& u, int wr, int wc, int lane) const {
        asm volatile("" : "+v"(lane)); const int fr = lane & 15, fq = lane >> 4;
        const int row0 = u.pm * BM + wr * 64 + fr;
#pragma unroll
        for (int bj = 0; bj < 2; ++bj) {
            const int col0 = bj * HALF + wc * 32 + 8 * fq;
            const f32x4 b0 = *(const f32x4*)(bias + col0), b1 = *(const f32x4*)(bias + col0 + 4);
#pragma unroll
            for (int ai = 0; ai < 2; ++ai)
#pragma unroll
                for (int m = 0; m < 4; ++m) {
                    const size_t r = (size_t)(row0 + ai * HALF + m * 16);
                    const u32x4 gv = *(const u32x4*)(YG + r * 256 + col0);
                    const f32x4 a0 = acc[ai][bj][m][0] + b0, a1 = acc[ai][bj][m][1] + b1;
                    float gg[8];
                    gg[0] = bf2f((unsigned short)(gv.x & 0xffff)); gg[1] = bf2f((unsigned short)(gv.x >> 16)); gg[2] = bf2f((unsigned short)(gv.y & 0xffff)); gg[3] = bf2f((unsigned short)(gv.y >> 16));
                    gg[4] = bf2f((unsigned short)(gv.z & 0xffff)); gg[5] = bf2f((unsigned short)(gv.z >> 16)); gg[6] = bf2f((unsigned short)(gv.w & 0xffff)); gg[7] = bf2f((unsigned short)(gv.w >> 16));
                    u32x4 w;
                    w.x = pk2(gg[0] * sigmoid_f(a0[0]), gg[1] * sigmoid_f(a0[1])); w.y = pk2(gg[2] * sigmoid_f(a0[2]), gg[3] * sigmoid_f(a0[3]));
                    w.z = pk2(gg[4] * sigmoid_f(a1[0]), gg[5] * sigmoid_f(a1[1])); w.w = pk2(gg[6] * sigmoid_f(a1[2]), gg[7] * sigmoid_f(a1[3]));
                    *(u32x4*)(MIX + r * 1024 + 512 + col0) = w;
                }
        }
    }
};
}

constexpr int NWAVES = 8, NTHR = 512;
constexpr int NPHASES = 3 + 13 * DEPTH;
constexpr int LDS_BYTES = 147456;
struct Args { const float* in[25]; float* out; unsigned char* ws; int ph_lo, ph_hi; };

typedef __attribute__((address_space(4))) const Args CArgs;
struct InView { CArgs* ap; __device__ __forceinline__ const float* operator[](int i) const { return ap->in[i]; } };
struct Ctx {
    LAS unsigned char* lds;
    int tid, lane, wave, G, bid;
    InView in;
    float* out; unsigned char* ws;
};

__device__ __forceinline__ float* xrow_ptr(const Ctx& F, int r) { return r < ML ? F.out + (size_t)r * DM : (float*)(F.ws + WS_XC) + (size_t)(r - ML) * DM; }

__device__ __forceinline__ void transpose_item(const float* W, int Nsrc, int k0, int n0, bf16_t* WT, int Kd, int drow0, LAS float* scr, int lane) {
#pragma unroll 8
    for (int i = 0; i < 32; ++i) { const int kk = 2 * i + (lane >> 5); scr[kk * 33 + (lane & 31)] = W[(size_t)(k0 + kk) * Nsrc + n0 + (lane & 31)]; }
    asm volatile("s_waitcnt lgkmcnt(0)" ::: "memory");
    const int c = lane & 7;
#pragma unroll
    for (int j = 0; j < 4; ++j) { const int n = (lane >> 3) + 8 * j; const LAS float* s = scr + (8 * c) * 33 + n;
        u32x4 o; o.x = pk2(s[0 * 33], s[1 * 33]); o.y = pk2(s[2 * 33], s[3 * 33]); o.z = pk2(s[4 * 33], s[5 * 33]); o.w = pk2(s[6 * 33], s[7 * 33]);
        *(u32x4*)(WT + (size_t)(drow0 + n) * Kd + k0 + 8 * c) = o; }
    asm volatile("s_waitcnt lgkmcnt(0)" ::: "memory");
}

__device__ __forceinline__ void phase_prologue(const Ctx& F) {
    const float* c_in = F.in[1]; const float* cctx = F.in[3]; const float* w_ada = F.in[4];
    {
        LAS float* sl = (LAS float*)F.lds;
        float* MODP = (float*)(F.ws + WS_MODP);
        for (int item = F.bid; item < 576; item += F.G) {
            const int l = item / 144, r2 = item % 144, kq = r2 / 18, nb = r2 % 18;
            __syncthreads();
            for (int idx = F.tid; idx < 17 * 128; idx += NTHR) { const int rr = idx >> 7, kk = idx & 127; const float v = rr < 16 ? c_in[rr * DM + kq * 128 + kk] : cctx[kq * 128 + kk]; sl[idx] = v / (1.0f + exp_f(-v)); }
            __syncthreads();
            const int n = nb * 512 + F.tid;
            float acc[17];
#pragma unroll
            for (int r = 0; r < 17; ++r) acc[r] = 0.f;
            const float* wp = w_ada + ((size_t)l * DM + kq * 128) * NMOD + n;
            for (int k0 = 0; k0 < 128; k0 += 16) {
                float w[16];
#pragma unroll
                for (int k = 0; k < 16; ++k) w[k] = __builtin_nontemporal_load(wp + (size_t)(k0 + k) * NMOD);
#pragma unroll
                for (int k = 0; k < 16; ++k) {
#pragma unroll
                    for (int r = 0; r < 17; ++r) acc[r] += sl[r * 128 + k0 + k] * w[k]; }
            }
#pragma unroll
            for (int r = 0; r < 17; ++r) MODP[(((size_t)kq * 4 + l) * 17 + r) * NMOD + n] = acc[r];
        }
        __syncthreads();
    }
    {
        LAS float* scr = (LAS float*)(F.lds + F.wave * 16384);
        const int gw = F.bid * NWAVES + F.wave, NGW = F.G * NWAVES;
        bf16_t* WGU = (bf16_t*)(F.ws + WS_WGU); bf16_t* WD = (bf16_t*)(F.ws + WS_WD); bf16_t* WIN = (bf16_t*)(F.ws + WS_WIN); bf16_t* WOUT = (bf16_t*)(F.ws + WS_WOUT); bf16_t* WGLU = (bf16_t*)(F.ws + WS_WGLU);
        constexpr int I_GU = 16 * 88, I_D = 44 * 32, I_IN = 16 * 56, I_OUT = 16 * 32, I_GLU = 4 * 8;
        constexpr int NITEMS = I_GU * 16 + I_D * 8 + I_IN * 4 + I_OUT * 4 + I_GLU * 4;
        for (int it = gw; it < NITEMS; it += NGW) {
            int r = it;
            if (r < I_GU * 16) { const int up = r / (I_GU * 8); r -= up * I_GU * 8; const int ls = r / I_GU; r %= I_GU; const int kb = r / 88, nb = r % 88, n0 = nb * 32;
                transpose_item(F.in[up ? 9 : 8] + (size_t)ls * DM * DFF, DFF, kb * 64, n0, WGU + (size_t)ls * 5632 * DM, DM, (n0 / 128) * 256 + (n0 % 128) + up * 128, scr, F.lane); continue; }
            r -= I_GU * 16;
            if (r < I_D * 8) { const int ls = r / I_D; r %= I_D; const int kb = r / 32, nb = r % 32;
                transpose_item(F.in[10] + (size_t)ls * DFF * DM, DM, kb * 64, nb * 32, WD + (size_t)ls * DM * DFF, DFF, nb * 32, scr, F.lane); continue; }
            r -= I_D * 8;
            if (r < I_IN * 4) { const int l = r / I_IN; r %= I_IN; const int kb = r / 56, nb = r % 56;
                transpose_item(F.in[11] + (size_t)l * DM * INC, INC, kb * 64, nb * 32, WIN + (size_t)l * INC * DM, DM, nb * 32, scr, F.lane); continue; }
            r -= I_IN * 4;
            if (r < I_OUT * 4) { const int l = r / I_OUT; r %= I_OUT; const int kb = r / 32, nb = r % 32;
                transpose_item(F.in[12] + (size_t)l * DM * DM, DM, kb * 64, nb * 32, WOUT + (size_t)l * DM * DM, DM, nb * 32, scr, F.lane); continue; }
            r -= I_OUT * 4;
            { const int l = r / I_GLU; r %= I_GLU; const int kb = r / 8, nb = r % 8;
                transpose_item(F.in[22] + (size_t)l * 256 * 256, 256, kb * 64, nb * 32, WGLU + (size_t)l * 256 * 256, 256, nb * 32, scr, F.lane); }
        }
    }
    const int gt = F.bid * NTHR + F.tid;
    if (gt < 1024) {
        const int v = gt >> 4, i = gt & 15;
        const float inv = __builtin_amdgcn_exp2f(-13.287712379549449f * (float)i * 0.0625f);
        float rev = (float)v * inv * 0.15915494309189535f; rev -= __builtin_rintf(rev);
        ((f32x2*)(F.ws + WS_CS))[gt] = (f32x2){__builtin_amdgcn_cosf(rev), __builtin_amdgcn_sinf(rev)};
    }
    if (gt >= 1024 && gt < 1024 + 8192) {
        const int id = gt - 1024, ldg = id >> 6, p = id & 63;
        const float lr = F.in[14][id], li = F.in[15][id]; const float dt = exp_f(F.in[16][ldg]);
        f32x2* AP = (f32x2*)(F.ws + WS_APOW) + (size_t)ldg * 17 * 64 + p;
        float a1r = 1.f, a1i = 0.f;
        for (int n = 0; n <= 16; ++n) {
            const float mag = exp_f((float)n * lr * dt);
            double a = (double)n * (double)li * (double)dt * 0.15915494309189535; a -= rint(a);
            const float rev = (float)a; const float cr = mag * __builtin_amdgcn_cosf(rev), ci = mag * __builtin_amdgcn_sinf(rev);
            AP[n * 64] = (f32x2){cr, ci};
            if (n == 1) { a1r = cr; a1i = ci; }
        }
        const float den = lr * lr + li * li;
        const float gr = ((a1r - 1.f) * lr + a1i * li) / den, gi = (a1i * lr - (a1r - 1.f) * li) / den;
        f32x2* BB = (f32x2*)(F.ws + WS_BBAR) + (size_t)id * 16;
        for (int h = 0; h < 16; ++h) { const float br = F.in[17][(size_t)id * 16 + h], bi = F.in[18][(size_t)id * 16 + h]; BB[h] = (f32x2){gr * br - gi * bi, gr * bi + gi * br}; }
    }
}

__device__ __forceinline__ float ssm_kval(const Ctx& F, int ldg, int tau, int h, int h2) {
    const float* cr = F.in[19] + ((size_t)ldg * 16 + h) * 64; const float* ci = F.in[20] + ((size_t)ldg * 16 + h) * 64;
    const f32x2* AP = (const f32x2*)(F.ws + WS_APOW) + ((size_t)ldg * 17 + tau) * 64;
    const f32x2* BB = (const f32x2*)(F.ws + WS_BBAR) + (size_t)ldg * 64 * 16 + h2;
    float s = 0.f;
    for (int p = 0; p < 64; ++p) { const f32x2 a = AP[p], b = BB[p * 16]; const float c_r = cr[p], c_i = ci[p];
        const float er = c_r * a.x - c_i * a.y, ei = c_r * a.y + c_i * a.x; s += er * b.x - ei * b.y; }
    return s;
}
__device__ __forceinline__ void phase_prologue2(const Ctx& F) {
    const int gt = F.bid * NTHR + F.tid, NT = F.G * NTHR;
    float* MOD = (float*)(F.ws + WS_MOD); const float* MODP = (const float*)(F.ws + WS_MODP);
    for (int idx = gt; idx < 4 * 17 * NMOD; idx += NT) {
        const int l = idx / (17 * NMOD), n = idx % NMOD;
        float s = F.in[5][l * NMOD + n];
#pragma unroll
        for (int kq = 0; kq < 8; ++kq) s += MODP[(size_t)kq * 4 * 17 * NMOD + idx];
        MOD[idx] = s;
    }
    float* KT = (float*)(F.ws + WS_KT);
    for (int idx = gt; idx < 4 * 2 * 16 * 16 * 256; idx += NT) {
        const int h2 = idx & 15, h = (idx >> 4) & 15, tau = (idx >> 8) & 15, g = (idx >> 12) & 15, dir = (idx >> 16) & 1, l = idx >> 17;
        KT[idx] = ssm_kval(F, (l * 2 + dir) * 16 + g, tau, h, h2);
    }
    bf16_t* SST = (bf16_t*)(F.ws + WS_SST);
    for (int idx = gt; idx < 4 * 16 * 256 * 256; idx += NT) {
        const int k = idx & 255, n = (idx >> 8) & 255, g = (idx >> 16) & 15, l = idx >> 20;
        const int dir = n >> 7, ri = (n >> 6) & 1, p = n & 63, j = k >> 4, h2 = k & 15, pw = dir == 0 ? 15 - j : j, ldg = (l * 2 + dir) * 16 + g;
        const f32x2 a = ((const f32x2*)(F.ws + WS_APOW))[((size_t)ldg * 17 + pw) * 64 + p];
        const f32x2 b = ((const f32x2*)(F.ws + WS_BBAR))[((size_t)ldg * 64 + p) * 16 + h2];
        SST[idx] = f2bf(ri == 0 ? (a.x * b.x - a.y * b.y) : (a.x * b.y + a.y * b.x));
    }
}
__device__ __forceinline__ void phase_prologue3(const Ctx& F) {
    const int gt = F.bid * NTHR + F.tid, NT = F.G * NTHR;
    bf16_t* SOUT = (bf16_t*)(F.ws + WS_SOUT); const float* KT = (const float*)(F.ws + WS_KT);
    for (int idx = gt; idx < 4 * 16 * 256 * 512; idx += NT) {
        const int k = idx & 511, row = (idx >> 9) & 255, g = (idx >> 17) & 15, l = idx >> 21, t = row >> 4, h = row & 15;
        float val = 0.f;
        if (k < 256) { const int j = k >> 4, h2 = k & 15;
            if (j <= t) val += KT[(((((size_t)l * 2 + 0) * 16 + g) * 16 + (t - j)) * 16 + h) * 16 + h2];
            if (j >= t) val += KT[(((((size_t)l * 2 + 1) * 16 + g) * 16 + (j - t)) * 16 + h) * 16 + h2];
            if (j == t && h == h2) val += F.in[21][l * 256 + g * 16 + h];
        } else { const int kk = k - 256, dir = kk >> 7, ri = (kk >> 6) & 1, p = kk & 63, n = dir == 0 ? t + 1 : 16 - t, ldg = (l * 2 + dir) * 16 + g;
            const float c_r = F.in[19][((size_t)ldg * 16 + h) * 64 + p], c_i = F.in[20][((size_t)ldg * 16 + h) * 64 + p];
            const f32x2 a = ((const f32x2*)(F.ws + WS_APOW))[((size_t)ldg * 17 + n) * 64 + p];
            const float er = c_r * a.x - c_i * a.y, ei = c_r * a.y + c_i * a.x; val = ri == 0 ? er : -ei; }
        SOUT[idx] = f2bf(val);
    }
}

__device__ __forceinline__ void phase_rowwise(const Ctx& F, bool first, bool has_y, bool y2, bool write_h, int nrows, float fac,
                                              const float* gpost, const float* modg  , int gate_idx,
                                              const float* gpre, const float* modh  , int shift_idx, int scale_idx) {
    const int gw = F.bid * NWAVES + F.wave, NGW = F.G * NWAVES, lane = F.lane;
    const bf16_t* Y = (const bf16_t*)(F.ws + WS_Y); bf16_t* H = (bf16_t*)(F.ws + WS_H);
    constexpr int NR = 2;
    for (int rb = gw; rb < nrows; rb += NR * NGW) {
        f32x4 xv[NR][4], yv[NR][4]; float* xr[NR]; int b17[NR]; bool ok[NR]; int rr[NR];
#pragma unroll
        for (int k = 0; k < NR; ++k) {
            const int r0 = rb + k * NGW; ok[k] = r0 < nrows; const int r = ok[k] ? r0 : rb; rr[k] = r;
            b17[k] = r < ML ? (r >> 12) : 16; xr[k] = xrow_ptr(F, r);
            const float* xs = first ? (r < ML ? F.in[0] + (size_t)r * DM : F.in[2] + (size_t)(r - ML) * DM) : xr[k];
#pragma unroll
            for (int j = 0; j < 4; ++j) xv[k][j] = __builtin_nontemporal_load((const f32x4*)(xs + 4 * lane + 256 * j));
            if (has_y) {
#pragma unroll
                for (int j = 0; j < 4; ++j) { const u32x2 w = __builtin_nontemporal_load((const u32x2*)(Y + (size_t)r * DM + 4 * lane + 256 * j));
                    yv[k][j] = (f32x4){bf2f((unsigned short)(w.x & 0xffff)), bf2f((unsigned short)(w.x >> 16)), bf2f((unsigned short)(w.y & 0xffff)), bf2f((unsigned short)(w.y >> 16))}; }
                if (y2 && r >= ML) {
#pragma unroll
                    for (int j = 0; j < 4; ++j) { const u32x2 w = __builtin_nontemporal_load((const u32x2*)((const bf16_t*)(F.ws + WS_Y2) + (size_t)(r - ML) * DM + 4 * lane + 256 * j));
                        yv[k][j] = yv[k][j] + (f32x4){bf2f((unsigned short)(w.x & 0xffff)), bf2f((unsigned short)(w.x >> 16)), bf2f((unsigned short)(w.y & 0xffff)), bf2f((unsigned short)(w.y >> 16))}; }
                }
            }
        }
        if (has_y) {
            float s[NR];
#pragma unroll
            for (int k = 0; k < NR; ++k) { s[k] = 0.f;
#pragma unroll
                for (int j = 0; j < 4; ++j) s[k] += (yv[k][j][0] * yv[k][j][0] + yv[k][j][1] * yv[k][j][1]) + (yv[k][j][2] * yv[k][j][2] + yv[k][j][3] * yv[k][j][3]); }
#pragma unroll
            for (int o = 1; o < 64; o <<= 1) {
#pragma unroll
                for (int k = 0; k < NR; ++k) s[k] += shx(s[k], lane, o);
            }
#pragma unroll
            for (int k = 0; k < NR; ++k) { const float rs = fac * __builtin_amdgcn_rsqf(s[k] * (1.0f / DM) + EPS);
#pragma unroll
                for (int j = 0; j < 4; ++j) { const f32x4 gp = *(const f32x4*)(gpost + 4 * lane + 256 * j); const f32x4 gt = *(const f32x4*)(modg + (size_t)b17[k] * NMOD + gate_idx * DM + 4 * lane + 256 * j);
                    xv[k][j] = xv[k][j] + gt * (yv[k][j] * rs * gp); } }
        }
        if (has_y) {
#pragma unroll
            for (int k = 0; k < NR; ++k) if (ok[k]) {
#pragma unroll
                for (int j = 0; j < 4; ++j) __builtin_nontemporal_store(xv[k][j], (f32x4*)(xr[k] + 4 * lane + 256 * j)); }
        }
        if (write_h) {
            float s[NR];
#pragma unroll
            for (int k = 0; k < NR; ++k) { s[k] = 0.f;
#pragma unroll
                for (int j = 0; j < 4; ++j) s[k] += (xv[k][j][0] * xv[k][j][0] + xv[k][j][1] * xv[k][j][1]) + (xv[k][j][2] * xv[k][j][2] + xv[k][j][3] * xv[k][j][3]); }
#pragma unroll
            for (int o = 1; o < 64; o <<= 1) {
#pragma unroll
                for (int k = 0; k < NR; ++k) s[k] += shx(s[k], lane, o);
            }
#pragma unroll
            for (int k = 0; k < NR; ++k) if (ok[k]) { const float rs = __builtin_amdgcn_rsqf(s[k] * (1.0f / DM) + EPS);
#pragma unroll
                for (int j = 0; j < 4; ++j) { const int c0 = 4 * lane + 256 * j; const f32x4 gp = *(const f32x4*)(gpre + c0);
                    const f32x4 sh = *(const f32x4*)(modh + (size_t)b17[k] * NMOD + shift_idx * DM + c0), sc = *(const f32x4*)(modh + (size_t)b17[k] * NMOD + scale_idx * DM + c0);
                    const f32x4 hv = (xv[k][j] * rs * gp) * (sc + 1.0f) + sh;
                    __builtin_nontemporal_store((u32x2){pk2(hv[0], hv[1]), pk2(hv[2], hv[3])}, (u32x2*)(H + (size_t)rr[k] * DM + c0)); } }
        }
    }
}

__device__ __forceinline__ int crow(int r, int hi) { return (r & 3) + 8 * (r >> 2) + 4 * hi; }
__device__ __forceinline__ void attn_tile(LAS unsigned char* lb, bool local, int kvstart, int qpos, int q, int hi, int lane, const bf16x8 (&qf)[4], float& mrun, float& lsum, f32x16 (&ot)[2]) {
    f32x16 p0, p1;
#pragma unroll
    for (int i = 0; i < 16; ++i) { p0[i] = 0.f; p1[i] = 0.f; }
#pragma unroll
    for (int s = 0; s < 4; ++s) {
        const bf16x8 a0 = *(const LAS bf16x8*)(lb + q * 144 + 32 * s + 16 * hi);
        const bf16x8 a1 = *(const LAS bf16x8*)(lb + (32 + q) * 144 + 32 * s + 16 * hi);
        p0 = __builtin_amdgcn_mfma_f32_32x32x16_bf16(a0, qf[s], p0, 0, 0, 0);
        p1 = __builtin_amdgcn_mfma_f32_32x32x16_bf16(a1, qf[s], p1, 0, 0, 0);
    }
    if (local) {
#pragma unroll
        for (int i = 0; i < 16; ++i) { const int d0 = kvstart + crow(i, hi) - qpos; if (d0 > 128 || d0 < -128) p0[i] = -1e30f; const int d1 = d0 + 32; if (d1 > 128 || d1 < -128) p1[i] = -1e30f; }
    }
    float mx = p0[0];
#pragma unroll
    for (int i = 1; i < 16; ++i) mx = fmaxf(mx, p0[i]);
#pragma unroll
    for (int i = 0; i < 16; ++i) mx = fmaxf(mx, p1[i]);
    mx = fmaxf(mx, shx(mx, lane, 32));
    const float mnew = fmaxf(mrun, mx), sc = __builtin_amdgcn_exp2f(mrun - mnew); mrun = mnew;
    float ps = 0.f;
#pragma unroll
    for (int i = 0; i < 16; ++i) { p0[i] = __builtin_amdgcn_exp2f(p0[i] - mnew); p1[i] = __builtin_amdgcn_exp2f(p1[i] - mnew); ps += p0[i] + p1[i]; }
    lsum = lsum * sc + ps;
#pragma unroll
    for (int i = 0; i < 16; ++i) { ot[0][i] *= sc; ot[1][i] *= sc; }
    bf16x8 pb[4];
#pragma unroll
    for (int ks = 0; ks < 4; ++ks) {
        u32x4 w;
        if (ks < 2) { w.x = pk2(p0[8 * ks + 0], p0[8 * ks + 1]); w.y = pk2(p0[8 * ks + 2], p0[8 * ks + 3]); w.z = pk2(p0[8 * ks + 4], p0[8 * ks + 5]); w.w = pk2(p0[8 * ks + 6], p0[8 * ks + 7]); }
        else { const int k2 = ks - 2; w.x = pk2(p1[8 * k2 + 0], p1[8 * k2 + 1]); w.y = pk2(p1[8 * k2 + 2], p1[8 * k2 + 3]); w.z = pk2(p1[8 * k2 + 4], p1[8 * k2 + 5]); w.w = pk2(p1[8 * k2 + 6], p1[8 * k2 + 7]); }
        pb[ks] = __builtin_bit_cast(bf16x8, w);
    }
#pragma unroll
    for (int dh = 0; dh < 2; ++dh)
#pragma unroll
        for (int ks = 0; ks < 4; ++ks) {
            const s16x4 lo = *(const LAS s16x4*)(lb + 9216 + (32 * dh + q) * 144 + (16 * ks + 4 * hi) * 2);
            const s16x4 h4 = *(const LAS s16x4*)(lb + 9216 + (32 * dh + q) * 144 + (16 * ks + 8 + 4 * hi) * 2);
            const bf16x8 va = __builtin_shufflevector(lo, h4, 0, 1, 2, 3, 4, 5, 6, 7);
            ot[dh] = __builtin_amdgcn_mfma_f32_32x32x16_bf16(va, pb[ks], ot[dh], 0, 0, 0);
        }
}
__device__ __forceinline__ void attn_unit(const Ctx& F, int b, int kh, int qc, const float* sink  ) {
    const bf16_t* Qb = (const bf16_t*)(F.ws + WS_Q); const bf16_t* Kb = (const bf16_t*)(F.ws + WS_K); const bf16_t* VT = (const bf16_t*)(F.ws + WS_VT); bf16_t* MIX = (bf16_t*)(F.ws + WS_H);
    LAS unsigned char* lds = F.lds;
    const int lane = F.lane, q = lane & 31, hi = lane >> 5, hq = kh * 4 + (F.wave >> 1), qs = F.wave & 1;
    const bool isctx = qc >= 64;
    int qpos; size_t qrow;
    if (!isctx) { qpos = qc * 64 + qs * 32 + q; qrow = (size_t)b * SEQL + qpos; } else { qpos = (qc - 64) * 64 + qs * 32 + q; qrow = (size_t)ML + b * NCTX + qpos; }
    const int ilo = isctx ? 0 : (qc < 2 ? 2 - qc : 0), ihi = isctx ? -1 : (65 - qc < 4 ? 65 - qc : 4), nloc = ihi - ilo + 1, nt = nloc + 4;
    const int row = F.tid >> 3, ch = F.tid & 7;
    const bf16_t* kbase = Kb + (size_t)row * 128 + kh * 64 + ch * 8;
    const bf16_t* vbase = VT + ((size_t)(b * 2 + kh) * 64 + row) * VTP + ch * 8;
#define ATT_LOAD(t, kk, vv) do { const int t_ = (t); size_t kr_; int vi_; \
        if (t_ < nloc) { const int ks_ = qc * 64 - 128 + 64 * (ilo + t_); kr_ = (size_t)b * SEQL + ks_; vi_ = ks_; } else { const int c_ = t_ - nloc; kr_ = (size_t)ML + b * NCTX + 64 * c_; vi_ = SEQL + 64 * c_; } \
        kk = *(const u32x4*)(kbase + kr_ * 128); vv = *(const u32x4*)(vbase + vi_); } while (0)
#define ATT_STORE(bo, kk, vv) do { *(LAS u32x4*)(lds + (bo) + row * 144 + ch * 16) = kk; *(LAS u32x4*)(lds + (bo) + 9216 + row * 144 + ch * 16) = vv; } while (0)
    u32x4 kA, vA, kB, vB;
    ATT_LOAD(0, kA, vA); ATT_LOAD(1, kB, vB);
    bf16x8 qf[4];
#pragma unroll
    for (int s = 0; s < 4; ++s) qf[s] = *(const bf16x8*)(Qb + qrow * 512 + hq * 64 + 16 * s + 8 * hi);
    float mrun = sink[hq] * LOG2E, lsum = hi == 0 ? 1.0f : 0.0f;
    f32x16 ot[2];
#pragma unroll
    for (int i = 0; i < 16; ++i) { ot[0][i] = 0.f; ot[1][i] = 0.f; }
    __syncthreads();
    for (int t = 0; t < nt; t += 2) {
        ATT_STORE(0, kA, vA);
        __syncthreads();
        if (t + 2 < nt) ATT_LOAD(t + 2, kA, vA);
        attn_tile(lds, t < nloc, qc * 64 - 128 + 64 * (ilo + t), qpos, q, hi, lane, qf, mrun, lsum, ot);
        if (t + 1 < nt) {
            ATT_STORE(18432, kB, vB);
            __syncthreads();
            if (t + 3 < nt) ATT_LOAD(t + 3, kB, vB);
            attn_tile(lds + 18432, t + 1 < nloc, qc * 64 - 128 + 64 * (ilo + t + 1), qpos, q, hi, lane, qf, mrun, lsum, ot);
        }
    }
#undef ATT_LOAD
#undef ATT_STORE
    lsum += shx(lsum, lane, 32);
    const float inv = 1.0f / lsum;
#pragma unroll
    for (int dh = 0; dh < 2; ++dh)
#pragma unroll
        for (int g4 = 0; g4 < 4; ++g4) {
            const int d0 = 32 * dh + 8 * g4 + 4 * hi;
            *(u32x2*)(MIX + qrow * 1024 + hq * 64 + d0) = (u32x2){pk2(ot[dh][4 * g4] * inv, ot[dh][4 * g4 + 1] * inv), pk2(ot[dh][4 * g4 + 2] * inv, ot[dh][4 * g4 + 3] * inv)};
        }
}
__device__ __forceinline__ void phase_attn(const Ctx& F, int l, bool lastl) {
    const int nq = lastl ? 64 : 68, nunits = NB * 2 * nq;
    for (int id = F.bid; id < nunits; id += F.G) { const int bk = id / nq, qc = id % nq; attn_unit(F, bk >> 1, bk & 1, qc, F.in[13] + l * 8); }
    __syncthreads();
}

__device__ __forceinline__ void unpack8(const u32x4 v, float* f) {
    f[0] = bf2f((unsigned short)(v.x & 0xffff)); f[1] = bf2f((unsigned short)(v.x >> 16)); f[2] = bf2f((unsigned short)(v.y & 0xffff)); f[3] = bf2f((unsigned short)(v.y >> 16));
    f[4] = bf2f((unsigned short)(v.z & 0xffff)); f[5] = bf2f((unsigned short)(v.z >> 16)); f[6] = bf2f((unsigned short)(v.w & 0xffff)); f[7] = bf2f((unsigned short)(v.w >> 16));
}
__device__ __forceinline__ void phase_conv(const Ctx& F, int l, int nrows) {
    const bf16_t* CZ = (const bf16_t*)(F.ws + WS_CZ); bf16_t* MIX = (bf16_t*)(F.ws + WS_H); const float* cw = F.in[24] + l * 768;
    const int gt = F.bid * NTHR + F.tid, NT = F.G * NTHR;
    for (int idx = gt; idx < nrows * 32; idx += NT) {
        const int r = idx >> 5, c0 = (idx & 31) * 8;
        int pos, len; if (r < ML) { pos = r & 4095; len = SEQL; } else { pos = (r - ML) & 255; len = NCTX; }
        const bf16_t* p = CZ + (size_t)r * 768 + c0;
        float gb[8], gc[8], z[8], tp[8], tn[8], a[8], b2[8];
        unpack8(*(const u32x4*)p, gb); unpack8(*(const u32x4*)(p + 256), gc); unpack8(*(const u32x4*)(p + 512), z);
        if (pos > 0) { unpack8(*(const u32x4*)(p - 768 + 256), a); unpack8(*(const u32x4*)(p - 768 + 512), b2);
#pragma unroll
            for (int i = 0; i < 8; ++i) tp[i] = a[i] * b2[i]; }
        else {
#pragma unroll
            for (int i = 0; i < 8; ++i) tp[i] = 0.f; }
        if (pos < len - 1) { unpack8(*(const u32x4*)(p + 768 + 256), a); unpack8(*(const u32x4*)(p + 768 + 512), b2);
#pragma unroll
            for (int i = 0; i < 8; ++i) tn[i] = a[i] * b2[i]; }
        else {
#pragma unroll
            for (int i = 0; i < 8; ++i) tn[i] = 0.f; }
        float o[8];
#pragma unroll
        for (int i = 0; i < 8; ++i) o[i] = gb[i] * (tp[i] * cw[c0 + i] + (gc[i] * z[i]) * cw[256 + c0 + i] + tn[i] * cw[512 + c0 + i]);
        *(u32x4*)(MIX + (size_t)r * 1024 + 768 + c0) = (u32x4){pk2(o[0], o[1]), pk2(o[2], o[3]), pk2(o[4], o[5]), pk2(o[6], o[7])};
    }
}

__device__ __forceinline__ int scan_chunk(int b, int dir, int step) {
    return step < 16 ? NB * 256 + b * 16 + (dir == 0 ? step : 15 - step) : b * 256 + (dir == 0 ? step - 16 : 271 - step);
}
__device__ __forceinline__ void phase_scan(const Ctx& F, int l) {
    const float* SL = (const float*)(F.ws + WS_SL); bf16_t* SSMA = (bf16_t*)(F.ws + WS_SSMA);
    LAS f32x2* sh = (LAS f32x2*)F.lds;
    for (int id = F.bid; id < 512; id += F.G) {
        const int b = id >> 5, g = (id >> 1) & 15, dir = id & 1, p = F.lane, seg = F.wave, ldg = (l * 2 + dir) * 16 + g;
        const f32x2 a16 = ((const f32x2*)(F.ws + WS_APOW))[((size_t)ldg * 17 + 16) * 64 + p];
        const float ar = a16.x, ai = a16.y;
        const size_t gbase = (size_t)g * NCHUNK;
        float xr[34], xi[34];
#pragma unroll
        for (int j = 0; j < 34; ++j) { const size_t rowc = gbase + scan_chunk(b, dir, seg * 34 + j); xr[j] = SL[rowc * 256 + dir * 128 + p]; xi[j] = SL[rowc * 256 + dir * 128 + 64 + p]; }
        float sr = 0.f, si = 0.f;
#pragma unroll
        for (int j = 0; j < 34; ++j) { const float nr = ar * sr - ai * si + xr[j], ni = ar * si + ai * sr + xi[j]; sr = nr; si = ni; }
        __syncthreads();
        sh[seg * 64 + p] = (f32x2){sr, si};
        float pr = ar, pi = ai, p2r, p2i;
        { const float tr = pr * pr - pi * pi, ti = 2.f * pr * pi; pr = tr; pi = ti; } p2r = pr; p2i = pi;
#pragma unroll
        for (int k = 0; k < 4; ++k) { const float tr = pr * pr - pi * pi, ti = 2.f * pr * pi; pr = tr; pi = ti; }
        { const float tr = pr * p2r - pi * p2i, ti = pr * p2i + pi * p2r; pr = tr; pi = ti; }
        __syncthreads();
        sr = 0.f; si = 0.f;
        for (int s2 = 0; s2 < seg; ++s2) { const f32x2 tt = sh[s2 * 64 + p]; const float nr = pr * sr - pi * si + tt.x, ni = pr * si + pi * sr + tt.y; sr = nr; si = ni; }
#pragma unroll
        for (int j = 0; j < 34; ++j) { const size_t rowc = gbase + scan_chunk(b, dir, seg * 34 + j);
            SSMA[rowc * 512 + 256 + dir * 128 + p] = f2bf(sr); SSMA[rowc * 512 + 256 + dir * 128 + 64 + p] = f2bf(si);
            const float nr = ar * sr - ai * si + xr[j], ni = ar * si + ai * sr + xi[j]; sr = nr; si = ni; }
    }
    __syncthreads();
}

#ifndef MK_MULTI
#define MK_MULTI 0
#endif
constexpr size_t WS_BAR = 195 * MiB + 131072;
constexpr int LDS_BARST_OFF = 131072 + 64;
#define XB_TMO      128
#define XB_XCNT(j)  (256  + 64 * (j))
#define XB_XSUB(j)  (1280 + 64 * (j))
#define XB_XGEN(j)  (2304 + 64 * (j))
#define XB_TOP      3328
#define XB_TOPGEN   3392
#define XCD_BAR_WORDS 3456
#define XB_SPIN_CAP (1u << 20)
__device__ __forceinline__ unsigned xb_ld(unsigned* p)              { return __hip_atomic_load(p, __ATOMIC_RELAXED, __HIP_MEMORY_SCOPE_AGENT); }
__device__ __forceinline__ unsigned xb_add(unsigned* p, unsigned v) { return __hip_atomic_fetch_add(p, v, __ATOMIC_RELAXED, __HIP_MEMORY_SCOPE_AGENT); }
__device__ __forceinline__ unsigned xb_xcc_id() { return (unsigned)__builtin_amdgcn_s_getreg((3 << 11) | 20) & 0xFu; }
#define XB_SPIN(cond, bar) do { unsigned _sp = 0; while (cond) { __builtin_amdgcn_s_sleep(1); \
    if ((++_sp & 255u) == 0u) { if (xb_ld(&(bar)[XB_TMO])) break; if (_sp > XB_SPIN_CAP) { atomicAdd(&(bar)[XB_TMO], 1u); break; } } } } while (0)
struct XcdBarrier { unsigned* bar; unsigned x; volatile LAS unsigned* st; };
__device__ __forceinline__ void xcd_barrier_complete(unsigned* bar, unsigned x, unsigned& nloc, unsigned& nx) {
    const unsigned G = gridDim.x * gridDim.y * gridDim.z;
    unsigned sum, cnt, mine, sp = 0u;
    for (;;) {
        sum = 0u; cnt = 0u; mine = 0u;
#pragma unroll
        for (unsigned j = 0; j < 16; ++j) { const unsigned c = xb_ld(&bar[XB_XCNT(j)]); sum += c; cnt += (c > 0u) ? 1u : 0u; mine = (j == x) ? c : mine; }
        if (sum == G) break;
        __builtin_amdgcn_s_sleep(1);
        if ((++sp & 255u) == 0u) { if (xb_ld(&bar[XB_TMO])) break; if (sp > XB_SPIN_CAP) { atomicAdd(&bar[XB_TMO], 1u); break; } }
    }
    nloc = mine > 0u ? mine : 1u; nx = cnt > 0u ? cnt : 1u;
}
__device__ __forceinline__ void xcd_barrier(const XcdBarrier& b, int tid) {
    asm volatile("s_waitcnt vmcnt(0)" ::: "memory");
    __syncthreads();
    if (tid == 0) {
        unsigned* bar = b.bar;
        __builtin_amdgcn_s_waitcnt(0);
        unsigned nloc = b.st[0], nx = b.st[1];
        if (nloc == 0u) { xcd_barrier_complete(bar, b.x, nloc, nx); b.st[0] = nloc; b.st[1] = nx; }
        const unsigned old = xb_add(&bar[XB_XSUB(b.x)], 1u);
        const unsigned gen = old / nloc;
        if (old + 1u == (gen + 1u) * nloc) {
            __builtin_amdgcn_fence(__ATOMIC_RELEASE, "agent");
            asm volatile("s_waitcnt vmcnt(0)" ::: "memory");
            const unsigned og = xb_add(&bar[XB_TOP], 1u);
            const unsigned tg = og / nx;
            if (og + 1u == (tg + 1u) * nx) xb_add(&bar[XB_TOPGEN], 1u);
            else XB_SPIN(xb_ld(&bar[XB_TOPGEN]) == tg, bar);
            __builtin_amdgcn_fence(__ATOMIC_ACQUIRE, "agent");
            xb_add(&bar[XB_XGEN(b.x)], 1u);
            asm volatile("s_waitcnt vmcnt(0)" ::: "memory");
        } else {
            XB_SPIN(xb_ld(&bar[XB_XGEN(b.x)]) == gen, bar);
            __builtin_amdgcn_fence(__ATOMIC_ACQUIRE, "agent");
            asm volatile("s_waitcnt vmcnt(0)" ::: "memory");
        }
    }
    __syncthreads();
}

#ifndef PROBE_DUP
#define PROBE_DUP 0
#endif
__global__ void __launch_bounds__(NTHR, 2) fwd_megakernel(Args args) {
    extern __shared__ __attribute__((aligned(16))) unsigned char lds_raw[];
    cg::grid_group grid = cg::this_grid();
    Ctx F;
    F.lds = (LAS unsigned char*)lds_raw;
    const int wave_s = __builtin_amdgcn_readfirstlane((int)threadIdx.x >> 6);
#if !MK_MULTI
    {
        volatile LAS unsigned* st0 = (volatile LAS unsigned*)(F.lds + LDS_BARST_OFF);
        if (threadIdx.x == 0) { st0[0] = 0u; st0[1] = 0u; (void)xb_add((unsigned*)(args.ws + WS_BAR) + XB_XCNT(xb_xcc_id()), 1u); }
        __syncthreads();
    }
#endif
    const int lo = args.ph_lo, hi = args.ph_hi < NPHASES ? args.ph_hi : NPHASES;
    for (int ph2 = 2 * lo; ph2 < 2 * hi; ++ph2) {
        const int ph = ph2 >> 1;
        if (ph2 & 1) { if (ph < 3 || !((PROBE_DUP >> ((ph - 3) % 13)) & 1)) continue; }
        const bool seam = ph2 > 2 * lo;
        { CArgs* ap_ = (CArgs*)__builtin_amdgcn_kernarg_segment_ptr(); asm volatile("" : "+s"(ap_)); F.in.ap = ap_; F.out = ap_->out; F.ws = ap_->ws; }
        { int l_ = (int)__builtin_amdgcn_mbcnt_hi(~0u, __builtin_amdgcn_mbcnt_lo(~0u, 0u)); asm volatile("" : "+v"(l_)); int w_ = wave_s, b_ = blockIdx.x, g_ = gridDim.x; asm volatile("" : "+s"(w_), "+s"(b_), "+s"(g_));
          F.lane = l_; F.wave = w_; F.tid = w_ * 64 + l_; F.bid = b_; F.G = g_; }
        if (seam) {
            if (ph == 1 && !(ph2 & 1)) grid.sync();
            else { XcdBarrier xb; xb.bar = (unsigned*)(F.ws + WS_BAR); xb.x = xb_xcc_id(); xb.st = (volatile LAS unsigned*)(F.lds + LDS_BARST_OFF); xcd_barrier(xb, F.tid); }
        }
        bf16_t* H = (bf16_t*)(F.ws + WS_H); bf16_t* Gh = (bf16_t*)(F.ws + WS_G); float* Y = (float*)(F.ws + WS_Y);
        const float* MOD = (const float*)(F.ws + WS_MOD);
        if (ph == 0) { phase_prologue(F); continue; }
        if (ph == 1) { phase_prologue2(F); continue; }
        if (ph == 2) { phase_prologue3(F); phase_rowwise(F, true, false, false, true, MT, 0.f, nullptr, nullptr, 0, F.in[6] + 0, MOD, 0, 1); continue; }
        const int q = ph - 3, l = q / 13, kind = q % 13;
        const bool lastl = (l == DEPTH - 1);
        const float* modl = MOD + (size_t)l * 17 * NMOD;
        const float* npre = F.in[6] + (size_t)l * 3 * DM; const float* npost = F.in[7] + (size_t)l * 3 * DM;
        if (kind == 0 || kind == 10) {
            const int s = kind == 0 ? 0 : 1; const int Mff = (lastl && s == 1) ? ML : MT;
            pg8::Gemm g{H, (const bf16_t*)(F.ws + WS_WGU) + (size_t)(l * 2 + s) * 5632 * DM, Mff, 5632, DM, DM, DM, 0, 0, 1};
            pg8::StaticOrder S; S.init(Mff, 5632, 1, F.G, F.bid);
            pg8::EpiSwiGLU E{Gh};
            pg8::gemm_phase<pg8::EpiSwiGLU, true, true, false>(F.lds, F.tid, g, S, E);
        } else if (kind == 1 || kind == 11) {
            const int s = kind == 1 ? 0 : 1; const int Mff = (lastl && s == 1) ? ML : MT;
            pg8::Gemm g{Gh, (const bf16_t*)(F.ws + WS_WD) + (size_t)(l * 2 + s) * DM * DFF, Mff, DM, DFF, DFF, DFF, 0, 0, 1};
            pg8::StaticOrder S; S.init(ML, DM, 1, F.G, F.bid);
            pg8::EpiBf16Y E{(bf16_t*)Y, nullptr};
            pg8::gemm_phase<pg8::EpiBf16Y, true, true, false>(F.lds, F.tid, g, S, E);
            if (Mff == MT) {
                pg8::Gemm g2{Gh + (size_t)ML * DFF, g.Bt, MC, DM, DFF / 2, DFF, DFF, (size_t)(DFF / 2) * 2, (size_t)(DFF / 2) * 2, 2};
                pg8::StaticOrder S2; S2.init(MC, DM, 2, F.G, F.bid);
                pg8::EpiBf16Y E2{(bf16_t*)Y + (size_t)ML * DM, (bf16_t*)(F.ws + WS_Y2)};
                pg8::gemm_phase<pg8::EpiBf16Y, true, true, true>(F.lds, F.tid, g2, S2, E2);
            }
        } else if (kind == 2) {
            phase_rowwise(F, l == 0, true, true, true, MT, 0.5f, npost, modl, 2, npre + DM, modl, 3, 4);
        } else if (kind == 3) {
            pg8::Gemm g{H, (const bf16_t*)(F.ws + WS_WIN) + (size_t)l * INC * DM, MT, INC, DM, DM, DM, 0, 0, 1};
            pg8::StaticOrder S; S.init(MT, INC, 1, F.G, F.bid);
            pg8::EpiWin E{(bf16_t*)(F.ws + WS_Q), (bf16_t*)(F.ws + WS_K), (bf16_t*)(F.ws + WS_VT), (bf16_t*)(F.ws + WS_SSMA), (bf16_t*)(F.ws + WS_CZ), (const f32x2*)(F.ws + WS_CS)};
            pg8::gemm_phase<pg8::EpiWin, true, true, false>(F.lds, F.tid, g, S, E);
        } else if (kind == 4) {
            {
            pg8::Gemm g{(const bf16_t*)(F.ws + WS_SSMA), (const bf16_t*)(F.ws + WS_SST) + (size_t)l * 16 * 256 * 256, NCHUNK, 256, 256, 512, 256, (size_t)NCHUNK * 512 * 2, (size_t)256 * 256 * 2, 16};
            pg8::StaticOrder S; S.init(NCHUNK, 256, 16, F.G, F.bid);
            pg8::EpiF32 E{(float*)(F.ws + WS_SL), 256, (size_t)NCHUNK * 256};
            pg8::gemm_phase<pg8::EpiF32, true, true, true>(F.lds, F.tid, g, S, E);
            }
            __syncthreads();
            if (F.bid & 1) { phase_conv(F, l, lastl ? ML : MT); phase_attn(F, l, lastl); }
            else { phase_attn(F, l, lastl); phase_conv(F, l, lastl ? ML : MT); }
        } else if (kind == 5) {
            phase_scan(F, l);
        } else if (kind == 6) {
            pg8::Gemm g{(const bf16_t*)(F.ws + WS_SSMA), (const bf16_t*)(F.ws + WS_SOUT) + (size_t)l * 16 * 256 * 512, NCHUNK, 256, 512, 512, 512, (size_t)NCHUNK * 512 * 2, (size_t)256 * 512 * 2, 16};
            pg8::StaticOrder S; S.init(NCHUNK, 256, 16, F.G, F.bid);
            pg8::EpiSsmOut E{(bf16_t*)(F.ws + WS_YG)};
            pg8::gemm_phase<pg8::EpiSsmOut, true, true, true>(F.lds, F.tid, g, S, E);
        } else if (kind == 7) {
            const int Mg = lastl ? ML : MT;
            pg8::Gemm g{(const bf16_t*)(F.ws + WS_YG), (const bf16_t*)(F.ws + WS_WGLU) + (size_t)l * 256 * 256, Mg, 256, 256, 256, 256, 0, 0, 1};
            pg8::StaticOrder S; S.init(Mg, 256, 1, F.G, F.bid);
            pg8::EpiGlu E{(const bf16_t*)(F.ws + WS_YG), F.in[23] + l * 256, H};
            pg8::gemm_phase<pg8::EpiGlu, true, true, false>(F.lds, F.tid, g, S, E);
        } else if (kind == 8) {
            const int Mg = lastl ? ML : MT;
            pg8::Gemm g{H, (const bf16_t*)(F.ws + WS_WOUT) + (size_t)l * DM * DM, Mg, DM, DM, DM, DM, 0, 0, 1};
            pg8::StaticOrder S; S.init(Mg, DM, 1, F.G, F.bid);
            pg8::EpiBf16Y E{(bf16_t*)Y, nullptr};
            pg8::gemm_phase<pg8::EpiBf16Y, true, true, false>(F.lds, F.tid, g, S, E);
        } else if (kind == 9) {
            phase_rowwise(F, false, true, false, true, lastl ? ML : MT, 1.0f, npost + DM, modl, 5, npre + 2 * DM, modl, 6, 7);
        } else {
            phase_rowwise(F, false, true, !lastl, !lastl, lastl ? ML : MT, 0.5f, npost + 2 * DM, modl, 8, lastl ? npre : npre + 3 * DM, lastl ? modl : modl + 17 * NMOD, 0, 1);
        }
    }
}

extern "C" void kernel_launch(void* const* d_in, const int* in_sizes, int n_in, void* d_out, int out_size, void* d_ws, size_t ws_size, hipStream_t stream) {
    static int grid = 0;
    if (grid == 0) {
        if (n_in != 25 || out_size != ML * DM || ws_size < WS_END) { fprintf(stderr, "kernel_launch: unexpected shapes: n_in %d out %d ws %zu\n", n_in, out_size, ws_size); grid = -1; return; }
        int dev = 0, cus = 0, per_cu = 0;
        hipGetDevice(&dev); hipDeviceGetAttribute(&cus, hipDeviceAttributeMultiprocessorCount, dev);
        if (hipFuncSetAttribute((const void*)fwd_megakernel, hipFuncAttributeMaxDynamicSharedMemorySize, LDS_BYTES) != hipSuccess) { fprintf(stderr, "kernel_launch: hipFuncSetAttribute failed\n"); grid = -1; return; }
        if (hipOccupancyMaxActiveBlocksPerMultiprocessor(&per_cu, (const void*)fwd_megakernel, NTHR, LDS_BYTES) != hipSuccess || per_cu < 1) { fprintf(stderr, "kernel_launch: occupancy query says %d\n", per_cu); per_cu = 1; }
        (void)hipGetLastError();
        grid = cus * per_cu;
        fprintf(stderr, "kernel_launch: grid %d (cus %d x %d)\n", grid, cus, per_cu);
    }
    if (grid < 0) return;
    Args a{};
    for (int i = 0; i < 25; ++i) a.in[i] = (const float*)d_in[i];
    a.out = (float*)d_out; a.ws = (unsigned char*)d_ws;
#if MK_MULTI
    for (int p = 0; p < NPHASES; ++p) { a.ph_lo = p; a.ph_hi = p + 1; hipLaunchKernelGGL(fwd_megakernel, dim3(grid), dim3(NTHR), LDS_BYTES, stream, a); }
#else
    a.ph_lo = 0; a.ph_hi = 1 << 20;
    if (hipMemsetAsync((char*)d_ws + WS_BAR, 0, 16384, stream) != hipSuccess) { fprintf(stderr, "kernel_launch: memset of the barrier words failed\n"); return; }
    void* kargs[] = {&a};
    hipError_t e = hipLaunchCooperativeKernel((const void*)fwd_megakernel, dim3(grid), dim3(NTHR), kargs, LDS_BYTES, stream);
    if (e != hipSuccess) fprintf(stderr, "cooperative launch failed: %s (grid %d)\n", hipGetErrorString(e), grid);
#endif
}
```

```cpp
#include <hip/hip_runtime.h>
#include <hip/hip_cooperative_groups.h>
#include <cstdio>
#include <cstdint>
namespace cg = cooperative_groups;

#define LAS __attribute__((address_space(3)))
typedef unsigned short bf16_t;
typedef short bf16x8 __attribute__((ext_vector_type(8)));
typedef short s16x4 __attribute__((ext_vector_type(4)));
typedef float f32x4 __attribute__((ext_vector_type(4)));
typedef float f32x16 __attribute__((ext_vector_type(16)));
typedef float f32x2 __attribute__((ext_vector_type(2)));
typedef __bf16 bf16x2_t __attribute__((ext_vector_type(2)));
typedef unsigned u32x4 __attribute__((ext_vector_type(4)));
typedef unsigned u32x2 __attribute__((ext_vector_type(2)));

constexpr int NB = 16, SEQL = 4096, NCTX = 256, DM = 1024, DEPTH = 4;
constexpr int ML = NB * SEQL;
constexpr int MC = NB * NCTX;
constexpr int MT = ML + MC;
constexpr int DFF = 2816, INC = 1792, NMOD = 9 * DM;
constexpr int NCHUNK = MT / 16;
constexpr int VTP = SEQL + NCTX;
constexpr float EPS = 1e-6f;
constexpr float LOG2E = 1.4426950408889634f;
constexpr float QSCALE = 0.125f * LOG2E;

constexpr size_t MiB = 1u << 20;
constexpr size_t WS_WGU = 0;
constexpr size_t WS_WD = 88 * MiB;
constexpr size_t WS_WIN = 132 * MiB;
constexpr size_t WS_WOUT = 146 * MiB;
constexpr size_t WS_WGLU = 154 * MiB;
constexpr size_t WS_SOUT = 155 * MiB;
constexpr size_t WS_SST = 171 * MiB;
constexpr size_t WS_MOD = 179 * MiB;
constexpr size_t WS_MODP = 620 * MiB;
constexpr size_t WS_KT = 660 * MiB;
constexpr size_t WS_APOW = 192 * MiB;
constexpr size_t WS_BBAR = 194 * MiB;
constexpr size_t WS_CS = 195 * MiB;
constexpr size_t WS_XC = 196 * MiB;
constexpr size_t WS_H = 212 * MiB;
constexpr size_t WS_Y = 348 * MiB;
constexpr size_t WS_Y2 = WS_Y + 136 * MiB;
constexpr size_t WS_G = 620 * MiB;
constexpr size_t WS_Q = WS_G;
constexpr size_t WS_K = WS_Q + 68 * MiB;
constexpr size_t WS_VT = WS_K + 17 * MiB;
constexpr size_t WS_SSMA = WS_VT + 17 * MiB;
constexpr size_t WS_SL = WS_SSMA + 68 * MiB;
constexpr size_t WS_CZ = WS_SL + 68 * MiB;
constexpr size_t WS_YG = WS_CZ + 102 * MiB;
constexpr size_t WS_END = 994 * MiB;
static_assert(WS_YG + 34 * MiB <= WS_END, "ws map");
static_assert((size_t)MT * DFF * 2 <= 374 * MiB, "G fits");

__device__ __forceinline__ unsigned pk2(float lo, float hi) { f32x2 v = {lo, hi}; bf16x2_t b = __builtin_convertvector(v, bf16x2_t); return __builtin_bit_cast(unsigned, b); }
__device__ __forceinline__ unsigned short f2bf(float f) { unsigned u = __builtin_bit_cast(unsigned, f); return (unsigned short)((u + 0x7fffu + ((u >> 16) & 1u)) >> 16); }
__device__ __forceinline__ float bf2f(unsigned short b) { return __builtin_bit_cast(float, (unsigned)b << 16); }
__device__ __forceinline__ float silu_f(float g) { return g * __builtin_amdgcn_rcpf(1.0f + __builtin_amdgcn_exp2f(-g * LOG2E)); }
__device__ __forceinline__ float sigmoid_f(float g) { return __builtin_amdgcn_rcpf(1.0f + __builtin_amdgcn_exp2f(-g * LOG2E)); }
__device__ __forceinline__ float gelu_tanh_f(float y) { const float t = 0.7978845608028654f * (y + 0.044715f * y * y * y); return y * __builtin_amdgcn_rcpf(1.0f + __builtin_amdgcn_exp2f(-2.0f * LOG2E * t)); }
__device__ __forceinline__ float shx(float v, int lane, int o) { return __builtin_bit_cast(float, __builtin_amdgcn_ds_bpermute((lane ^ o) << 2, __builtin_bit_cast(int, v))); }
__device__ __forceinline__ float wave_sum(float v, int lane) {
#pragma unroll
    for (int o = 1; o < 64; o <<= 1) v += shx(v, lane, o);
    return v;
}
__device__ __forceinline__ float exp_f(float x) { return __builtin_amdgcn_exp2f(x * LOG2E); }

namespace pg8 {
constexpr int BM = 256, BK = 64, HALF = 128, HTB = HALF * BK * 2, STAGE_BYTES = 8 * HTB, NXCD = 8, WGM = 4;
__host__ __device__ __forceinline__ int lds_byte(int r, int c) { const int st = (r >> 4) * 2 + (c >> 5), rr = r & 15, cc = c & 31, ob = rr * 64 + cc * 2; return st * 1024 + (ob ^ (((ob >> 9) & 1) << 5)); }
__host__ __device__ __forceinline__ void stage_rc(int b, int& R, int& C) { const int st = b / 1024, sb = b % 1024, swz = sb ^ (((sb >> 9) & 1) << 5); R = (st >> 1) * 16 + swz / 64; C = (st & 1) * 32 + (swz % 64) / 2; }
__host__ __device__ __forceinline__ int perm32(int rho) { const int n = rho >> 4, i = rho & 15; return 8 * (i >> 2) + 4 * n + (i & 3); }

struct Unit { int pm, pn, z; };
struct Gemm { const bf16_t* A; const bf16_t* Bt; int M, N, K, lda, ldb; size_t zsA, zsB; int nz; };

struct StaticOrder {
    int nM, nN, nwg, G, c, nz;
    __device__ void init(int M, int N, int nz_, int G_, int c_) { nM = M / BM; nN = N / BM; nwg = nM * nN; G = G_; c = c_; nz = nz_; }
    __device__ bool next(int i, Unit& u) const {
        const long L = (long)i * G + c; if (L >= (long)nwg * nz) return false;
        u.z = (int)(L / nwg);
        int wgid = (int)(L % nwg); { const int q = nwg / NXCD, r = nwg % NXCD, xcd = wgid % NXCD, off = wgid / NXCD; wgid = (xcd < r ? xcd * (q + 1) : r * (q + 1) + (xcd - r) * q) + off; }
        const int nig = WGM * nN, gid = wgid / nig, fm = gid * WGM, gsz = (nM - fm) < WGM ? (nM - fm) : WGM;
        u.pm = fm + ((wgid % nig) % gsz); u.pn = (wgid % nig) / gsz; return true;
    }
};

template <class Epi, bool ALIGN_EPI, bool SP2, bool ZB>
__device__ __forceinline__ void gemm_phase(LAS unsigned char* lds, const int tid, const Gemm g, const StaticOrder& S, const Epi& E) {
    const int wid = __builtin_amdgcn_readfirstlane(tid >> 6), lane = tid & 63, wr = wid >> 2, wc = wid & 3, fr = lane & 15, fq = lane >> 4;
    const int K = g.K, nt = K / BK, lda = g.lda, ldb = g.ldb;
    unsigned voffA[2], voffB[2];
#pragma unroll
    for (int i = 0; i < 2; ++i) { int R, C; stage_rc(tid * 16 + i * 8192, R, C); const int Rb = Epi::PERM ? ((R & ~31) + perm32(R & 31)) : R;
        voffA[i] = (unsigned)(R * lda + C) * 2u; voffB[i] = (unsigned)(Rb * ldb + C) * 2u; }
    const size_t kstep = (size_t)(BK * 2);
    const size_t hstepA = (size_t)HALF * lda * 2, hstepB = (size_t)HALF * ldb * 2;
    const size_t tstepA = 2 * hstepA, tstepB = 2 * hstepB;
    const unsigned ldsw = (unsigned)wid * 1024u;
    const int aoff = lds_byte(wr * 64 + fr, fq * 8), boff = lds_byte(wc * 32 + fr, fq * 8);
#define PG8_SA(b, h) (((b) * 2 + (h)) * HTB)
#define PG8_SB(b, h) ((4 + (b) * 2 + (h)) * HTB)
#define PG8_STAGE(bufoff, gbase, voff) do { _Pragma("unroll") for (int _i = 0; _i < 2; ++_i) { unsigned _vo = (voff)[_i]; asm volatile("" : "+v"(_vo)); \
        __builtin_amdgcn_global_load_lds((const unsigned*)((const char*)(gbase) + _vo), (LAS unsigned*)(lds + (bufoff) + ldsw + _i * 8192), 16, 0, 0); } } while (0)
#define PG8_LDA(dst, b, h) do { _Pragma("unroll") for (int m = 0; m < 4; ++m) _Pragma("unroll") for (int k = 0; k < 2; ++k) dst[m][k] = *(const LAS bf16x8*)(lds + PG8_SA(b, h) + aoff + m * 2048 + k * 1024); } while (0)
#define PG8_LDB(dst, b, h) do { _Pragma("unroll") for (int n = 0; n < 2; ++n) _Pragma("unroll") for (int k = 0; k < 2; ++k) dst[n][k] = *(const LAS bf16x8*)(lds + PG8_SB(b, h) + boff + n * 2048 + k * 1024); } while (0)
#define PG8_MMA(ai, bj, At, Bt) do { __builtin_amdgcn_s_setprio(1); _Pragma("unroll") for (int m = 0; m < 4; ++m) _Pragma("unroll") for (int n = 0; n < 2; ++n) _Pragma("unroll") for (int k = 0; k < 2; ++k) \
        acc[ai][bj][m][n] = __builtin_amdgcn_mfma_f32_16x16x32_bf16(Bt[n][k], At[m][k], acc[ai][bj][m][n], 0, 0, 0); __builtin_amdgcn_s_setprio(0); } while (0)
#define PG8_WAIT_V(n) asm volatile("s_waitcnt vmcnt(" #n ")" ::: "memory")
#define PG8_WAIT_L(n) asm volatile("s_waitcnt lgkmcnt(" #n ")" ::: "memory")
#define PG8_BAR __builtin_amdgcn_s_barrier()
#define PG8_SCHED __builtin_amdgcn_sched_barrier(0)
    Unit cur, nxt; int ui = 0;
    if (!S.next(0, cur)) return;
    f32x4 acc[2][2][4][2];
#pragma unroll
    for (int a = 0; a < 2; ++a)
#pragma unroll
        for (int b = 0; b < 2; ++b)
#pragma unroll
            for (int m = 0; m < 4; ++m)
#pragma unroll
                for (int n = 0; n < 2; ++n) acc[a][b][m][n] = (f32x4){0.f, 0.f, 0.f, 0.f};
    bf16x8 At[4][2], B0[2][2], B1[2][2];
    const char* cA = (const char*)g.A + (ZB ? (size_t)cur.z * g.zsA : (size_t)0) + (size_t)cur.pm * tstepA; const char* cB = (const char*)g.Bt + (ZB ? (size_t)cur.z * g.zsB : (size_t)0) + (size_t)cur.pn * tstepB;
    if constexpr (SP2) {
        PG8_STAGE(PG8_SB(0, 0), cB, voffB); PG8_STAGE(PG8_SB(0, 1), cB + hstepB, voffB); PG8_STAGE(PG8_SA(0, 0), cA, voffA); PG8_STAGE(PG8_SA(0, 1), cA + hstepA, voffA);
        if (wr == 1) PG8_BAR;
        PG8_WAIT_V(2); PG8_BAR;
        PG8_STAGE(PG8_SB(1, 0), cB + kstep, voffB); PG8_STAGE(PG8_SA(1, 0), cA + kstep, voffA); PG8_STAGE(PG8_SB(1, 1), cB + hstepB + kstep, voffB);
        PG8_WAIT_V(6); PG8_BAR;
    } else {
        PG8_STAGE(PG8_SB(0, 0), cB, voffB); PG8_STAGE(PG8_SA(0, 0), cA, voffA); PG8_STAGE(PG8_SB(0, 1), cB + hstepB, voffB); PG8_STAGE(PG8_SA(0, 1), cA + hstepA, voffA);
        if (wr == 1) PG8_BAR;
        PG8_WAIT_V(4); PG8_BAR;
        PG8_STAGE(PG8_SB(1, 0), cB + kstep, voffB); PG8_STAGE(PG8_SA(1, 0), cA + kstep, voffA); PG8_STAGE(PG8_SB(1, 1), cB + hstepB + kstep, voffB);
        PG8_WAIT_V(6); PG8_BAR;
    }
    for (;;) {
        const bool has_next = S.next(ui + 1, nxt);
        const char* nA = has_next ? (const char*)g.A + (ZB ? (size_t)nxt.z * g.zsA : (size_t)0) + (size_t)nxt.pm * tstepA : cA; const char* nB = has_next ? (const char*)g.Bt + (ZB ? (size_t)nxt.z * g.zsB : (size_t)0) + (size_t)nxt.pn * tstepB : cB;
        for (int t = 0; t < nt; t += 2) {
            const bool last = (t == nt - 2);
            const char* a1 = cA + (size_t)(t + 1) * kstep;
            const char* a2 = last ? nA : cA + (size_t)(t + 2) * kstep; const char* b2 = last ? nB : cB + (size_t)(t + 2) * kstep;
            const char* a3 = a2 + kstep; const char* b3 = b2 + kstep;
            if constexpr (SP2) {
            PG8_LDB(B0, 0, 0); PG8_LDB(B1, 0, 1); PG8_SCHED; PG8_LDA(At, 0, 0); PG8_STAGE(PG8_SA(1, 1), a1 + hstepA, voffA);
            PG8_WAIT_V(8); PG8_WAIT_L(0); PG8_BAR; PG8_MMA(0, 0, At, B0); PG8_MMA(0, 1, At, B1); PG8_BAR; PG8_SCHED;
            PG8_LDA(At, 0, 1); PG8_STAGE(PG8_SB(0, 0), b2, voffB); PG8_STAGE(PG8_SB(0, 1), b2 + hstepB, voffB); PG8_STAGE(PG8_SA(0, 0), a2, voffA);
            PG8_WAIT_V(8); PG8_WAIT_L(0); PG8_BAR; PG8_MMA(1, 0, At, B0); PG8_MMA(1, 1, At, B1); PG8_BAR; PG8_SCHED;
            PG8_LDB(B0, 1, 0); PG8_LDB(B1, 1, 1); PG8_SCHED; PG8_LDA(At, 1, 0); PG8_STAGE(PG8_SA(0, 1), a2 + hstepA, voffA);
            PG8_WAIT_V(8); PG8_WAIT_L(0); PG8_BAR; PG8_MMA(0, 0, At, B0); PG8_MMA(0, 1, At, B1); PG8_BAR; PG8_SCHED;
            PG8_LDA(At, 1, 1); PG8_STAGE(PG8_SB(1, 0), b3, voffB); PG8_STAGE(PG8_SB(1, 1), b3 + hstepB, voffB); PG8_STAGE(PG8_SA(1, 0), a3, voffA);
            PG8_WAIT_V(8); PG8_WAIT_L(0); PG8_BAR; PG8_MMA(1, 0, At, B0); PG8_MMA(1, 1, At, B1); PG8_BAR; PG8_SCHED;
            } else {
            PG8_LDB(B0, 0, 0); PG8_SCHED; PG8_LDA(At, 0, 0); PG8_STAGE(PG8_SA(1, 1), a1 + hstepA, voffA);
            PG8_WAIT_L(8); PG8_BAR; PG8_WAIT_L(0); PG8_MMA(0, 0, At, B0); PG8_BAR; PG8_SCHED;
            PG8_LDB(B1, 0, 1); PG8_STAGE(PG8_SB(0, 0), b2, voffB);
            PG8_BAR; PG8_WAIT_L(0); PG8_MMA(0, 1, At, B1); PG8_BAR;
            PG8_LDA(At, 0, 1); PG8_STAGE(PG8_SA(0, 0), a2, voffA);
            PG8_BAR; PG8_WAIT_L(0); PG8_MMA(1, 0, At, B0); PG8_BAR; PG8_SCHED;
            PG8_STAGE(PG8_SB(0, 1), b2 + hstepB, voffB);
            PG8_WAIT_V(6); PG8_BAR; PG8_MMA(1, 1, At, B1); PG8_BAR;
            PG8_LDB(B0, 1, 0); PG8_SCHED; PG8_LDA(At, 1, 0); PG8_STAGE(PG8_SA(0, 1), a2 + hstepA, voffA);
            PG8_WAIT_L(8); PG8_BAR; PG8_WAIT_L(0); PG8_MMA(0, 0, At, B0); PG8_BAR; PG8_SCHED;
            PG8_LDB(B1, 1, 1); PG8_STAGE(PG8_SB(1, 0), b3, voffB);
            PG8_BAR; PG8_WAIT_L(0); PG8_MMA(0, 1, At, B1); PG8_BAR;
            PG8_LDA(At, 1, 1); PG8_STAGE(PG8_SA(1, 0), a3, voffA);
            PG8_BAR; PG8_WAIT_L(0); PG8_MMA(1, 0, At, B0); PG8_BAR; PG8_SCHED;
            PG8_STAGE(PG8_SB(1, 1), b3 + hstepB, voffB);
            PG8_WAIT_V(6); PG8_BAR; PG8_MMA(1, 1, At, B1); PG8_BAR;
            }
        }
        if constexpr (ALIGN_EPI) { if (wr == 0) PG8_BAR; }
        { const int lane_e = (int)__builtin_amdgcn_mbcnt_hi(~0u, __builtin_amdgcn_mbcnt_lo(~0u, 0u)); E(acc, cur, wr, wc, lane_e); }
        if (!has_next) break;
#pragma unroll
        for (int a = 0; a < 2; ++a)
#pragma unroll
            for (int b = 0; b < 2; ++b)
#pragma unroll
                for (int m = 0; m < 4; ++m)
#pragma unroll
                    for (int n = 0; n < 2; ++n) acc[a][b][m][n] = (f32x4){0.f, 0.f, 0.f, 0.f};
        cur = nxt; cA = nA; cB = nB; ++ui;
        if constexpr (ALIGN_EPI) { if (wr == 1) PG8_BAR; }
    }
    PG8_WAIT_V(0);
    if constexpr (!ALIGN_EPI) { if (wr == 0) PG8_BAR; }
    PG8_BAR;
#undef PG8_SA
#undef PG8_SB
#undef PG8_STAGE
#undef PG8_LDA
#undef PG8_LDB
#undef PG8_MMA
#undef PG8_WAIT_V
#undef PG8_WAIT_L
#undef PG8_BAR
#undef PG8_SCHED
}

typedef f32x4 Acc[2][2][4][2];

struct EpiSwiGLU {
    static constexpr bool PERM = true;
    bf16_t* G;
    __device__ __forceinline__ void operator()(const Acc& acc, const Unit& u, int wr, int wc, int lane) const {
        asm volatile("" : "+v"(lane)); const int fr = lane & 15, fq = lane >> 4;
        const int row0 = u.pm * BM + wr * 64 + fr, col0 = u.pn * 128 + wc * 32 + 8 * fq;
#pragma unroll
        for (int ai = 0; ai < 2; ++ai)
#pragma unroll
            for (int m = 0; m < 4; ++m) {
                const f32x4 g0 = acc[ai][0][m][0], g1 = acc[ai][0][m][1], u0 = acc[ai][1][m][0], u1 = acc[ai][1][m][1];
                u32x4 w;
                w.x = pk2(silu_f(g0[0]) * u0[0], silu_f(g0[1]) * u0[1]); w.y = pk2(silu_f(g0[2]) * u0[2], silu_f(g0[3]) * u0[3]);
                w.z = pk2(silu_f(g1[0]) * u1[0], silu_f(g1[1]) * u1[1]); w.w = pk2(silu_f(g1[2]) * u1[2], silu_f(g1[3]) * u1[3]);
                *(u32x4*)(G + (size_t)(row0 + ai * HALF + m * 16) * DFF + col0) = w;
            }
    }
};

struct EpiF32 {
    static constexpr bool PERM = false;
    float* Y; int ldc; size_t zs;
    __device__ __forceinline__ void operator()(const Acc& acc, const Unit& u, int wr, int wc, int lane) const {
        asm volatile("" : "+v"(lane)); const int fr = lane & 15, fq = lane >> 4;
        float* base = Y + (size_t)u.z * zs;
        const int row0 = u.pm * BM + wr * 64 + fr, col0 = u.pn * BM + wc * 32 + 4 * fq;
#pragma unroll
        for (int ai = 0; ai < 2; ++ai)
#pragma unroll
            for (int m = 0; m < 4; ++m) { float* rp = base + (size_t)(row0 + ai * HALF + m * 16) * ldc + col0;
#pragma unroll
                for (int bj = 0; bj < 2; ++bj)
#pragma unroll
                    for (int n = 0; n < 2; ++n) *(f32x4*)(rp + bj * HALF + n * 16) = acc[ai][bj][m][n]; }
    }
};

struct EpiBf16Y {
    static constexpr bool PERM = true;
    bf16_t* Y; bf16_t* Yz1;
    __device__ __forceinline__ void operator()(const Acc& acc, const Unit& u, int wr, int wc, int lane) const {
        asm volatile("" : "+v"(lane)); const int fr = lane & 15, fq = lane >> 4;
        const int row0 = u.pm * BM + wr * 64 + fr, col0 = u.pn * BM + wc * 32 + 8 * fq;
        bf16_t* Yb = u.z ? Yz1 : Y;
#pragma unroll
        for (int ai = 0; ai < 2; ++ai)
#pragma unroll
            for (int m = 0; m < 4; ++m) { bf16_t* rp = Yb + (size_t)(row0 + ai * HALF + m * 16) * DM + col0;
#pragma unroll
                for (int bj = 0; bj < 2; ++bj) { const f32x4 a0 = acc[ai][bj][m][0], a1 = acc[ai][bj][m][1];
                    *(u32x4*)(rp + bj * HALF) = (u32x4){pk2(a0[0], a0[1]), pk2(a0[2], a0[3]), pk2(a1[0], a1[1]), pk2(a1[2], a1[3])}; } }
    }
};

struct EpiWin {
    static constexpr bool PERM = false;
    bf16_t *Q, *Kb, *VT, *SSMA, *CZ; const f32x2* CS;
    __device__ __forceinline__ void operator()(const Acc& acc, const Unit& u, int wr, int wc, int lane) const {
        asm volatile("" : "+v"(lane)); const int fr = lane & 15, fq = lane >> 4;
        const int pn = u.pn; const bool isctx = u.pm >= (ML / BM);
        f32x4 cc = {1.f, 1.f, 1.f, 1.f}, ss = {0.f, 0.f, 0.f, 0.f};
#pragma unroll
        for (int ai = 0; ai < 2; ++ai)
#pragma unroll
            for (int m = 0; m < 4; ++m) {
                const int r = u.pm * BM + ai * HALF + wr * 64 + m * 16 + fr;
                int b, pos;
                if (!isctx) { b = r >> 12; pos = r & 4095; } else { const int rc = r - ML; b = rc >> 8; pos = rc & 255; }
                if (pn <= 2 && !isctx) {
                    const int v = (wc & 1) ? (pos & 63) : (pos >> 6);
                    const f32x2* t = CS + v * 16 + 4 * fq;
                    const f32x2 t0 = t[0], t1 = t[1], t2 = t[2], t3 = t[3];
                    cc = (f32x4){t0.x, t1.x, t2.x, t3.x}; ss = (f32x4){t0.y, t1.y, t2.y, t3.y};
                }
#pragma unroll
                for (int bj = 0; bj < 2; ++bj) {
                    const f32x4 a0 = acc[ai][bj][m][0], a1 = acc[ai][bj][m][1];
                    const int cl = 128 * bj + 32 * wc + 4 * fq;
                    if (pn <= 1) {
                        f32x4 o0, o1;
                        if (!isctx) { o0 = a0 * cc - a1 * ss; o1 = a1 * cc + a0 * ss; } else { o0 = a0; o1 = a1; }
                        o0 = o0 * QSCALE; o1 = o1 * QSCALE;
                        bf16_t* p = Q + (size_t)r * 512 + pn * 256 + cl;
                        *(u32x2*)p = (u32x2){pk2(o0[0], o0[1]), pk2(o0[2], o0[3])}; *(u32x2*)(p + 16) = (u32x2){pk2(o1[0], o1[1]), pk2(o1[2], o1[3])};
                    } else if (pn == 2) {
                        if (bj == 0) {
                            f32x4 o0, o1;
                            if (!isctx) { o0 = a0 * cc - a1 * ss; o1 = a1 * cc + a0 * ss; } else { o0 = a0; o1 = a1; }
                            bf16_t* p = Kb + (size_t)r * 128 + 32 * wc + 4 * fq;
                            *(u32x2*)p = (u32x2){pk2(o0[0], o0[1]), pk2(o0[2], o0[3])}; *(u32x2*)(p + 16) = (u32x2){pk2(o1[0], o1[1]), pk2(o1[2], o1[3])};
                        } else {
                            const int vc = 32 * wc + 4 * fq;
                            const int pidx = isctx ? (SEQL + pos) : pos;
                            bf16_t* p = VT + ((size_t)(b * 2 + (vc >> 6)) * 64 + (vc & 63)) * VTP + pidx;
#pragma unroll
                            for (int j = 0; j < 4; ++j) { p[(size_t)j * VTP] = f2bf(a0[j]); p[(size_t)(j + 16) * VTP] = f2bf(a1[j]); }
                        }
                    } else if (pn == 3) {
                        const int g0 = 8 * bj + 2 * wc;
                        bf16_t* p = SSMA + ((size_t)g0 * NCHUNK + (r >> 4)) * 512 + (r & 15) * 16 + 4 * fq;
                        *(u32x2*)p = (u32x2){pk2(a0[0], a0[1]), pk2(a0[2], a0[3])};
                        *(u32x2*)(p + (size_t)NCHUNK * 512) = (u32x2){pk2(a1[0], a1[1]), pk2(a1[2], a1[3])};
                    } else {
                        bf16_t* p = CZ + (size_t)r * 768 + (pn - 4) * 256 + cl;
                        *(u32x2*)p = (u32x2){pk2(a0[0], a0[1]), pk2(a0[2], a0[3])}; *(u32x2*)(p + 16) = (u32x2){pk2(a1[0], a1[1]), pk2(a1[2], a1[3])};
                    }
                }
            }
    }
};

struct EpiSsmOut {
    static constexpr bool PERM = false;
    bf16_t* YG;
    __device__ __forceinline__ void operator()(const Acc& acc, const Unit& u, int wr, int wc, int lane) const {
        asm volatile("" : "+v"(lane)); const int fr = lane & 15, fq = lane >> 4;
#pragma unroll
        for (int ai = 0; ai < 2; ++ai)
#pragma unroll
            for (int m = 0; m < 4; ++m) {
                const int r = u.pm * BM + ai * HALF + wr * 64 + m * 16 + fr;
#pragma unroll
                for (int bj = 0; bj < 2; ++bj)
#pragma unroll
                    for (int n = 0; n < 2; ++n) {
                        const int t = 8 * bj + 2 * wc + n; const f32x4 a = acc[ai][bj][m][n];
                        bf16_t* p = YG + (size_t)(r * 16 + t) * 256 + u.z * 16 + 4 * fq;
                        *(u32x2*)p = (u32x2){pk2(gelu_tanh_f(a[0]), gelu_tanh_f(a[1])), pk2(gelu_tanh_f(a[2]), gelu_tanh_f(a[3]))};
                    }
            }
    }
};

struct EpiGlu {
    static constexpr bool PERM = true;
    const bf16_t* YG; const float* bias; bf16_t* MIX;
    __device__ __forceinline__ void operator()(const Acc& acc, const Unit& u, int wr, int wc, int lane) const {
        asm volatile("" : "+v"(lane)); const int fr = lane & 15, fq = lane >> 4;
        const int row0 = u.pm * BM + wr * 64 + fr;
#pragma unroll
        for (int bj = 0; bj < 2; ++bj) {
            const int col0 = bj * HALF + wc * 32 + 8 * fq;
            const f32x4 b0 = *(const f32x4*)(bias + col0), b1 = *(const f32x4*)(bias + col0 + 4);
#pragma unroll
            for (int ai = 0; ai < 2; ++ai)
#pragma unroll
                for (int m = 0; m < 4; ++m) {
                    const size_t r = (size_t)(row0 + ai * HALF + m * 16);
                    const u32x4 gv = *(const u32x4*)(YG + r * 256 + col0);
                    const f32x4 a0 = acc[ai][bj][m][0] + b0, a1 = acc[ai][bj][m][1] + b1;
                    float gg[8];
                    gg[0] = bf2f((unsigned short)(gv.x & 0xffff)); gg[1] = bf2f((unsigned short)(gv.x >> 16)); gg[2] = bf2f((unsigned short)(gv.y & 0xffff)); gg[3] = bf2f((unsigned short)(gv.y >> 16));
                    gg[4] = bf2f((unsigned short)(gv.z & 0xffff)); gg[5] = bf2f((unsigned short)(gv.z >> 16)); gg[6] = bf2f((unsigned short)(gv.w & 0xffff)); gg[7] = bf2f((unsigned short)(gv.w >> 16));
                    u32x4 w;
                    w.x = pk2(gg[0] * sigmoid_f(a0[0]), gg[1] * sigmoid_f(a0[1])); w.y = pk2(gg[2] * sigmoid_f(a0[2]), gg[3] * sigmoid_f(a0[3]));
                    w.z = pk2(gg[4] * sigmoid_f(a1[0]), gg[5] * sigmoid_f(a1[1])); w.w = pk2(gg[6] * sigmoid_f(a1[2]), gg[7] * sigmoid_f(a1[3]));
                    *(u32x4*)(MIX + r * 1024 + 512 + col0) = w;
                }
        }
    }
};
}

constexpr int NWAVES = 8, NTHR = 512;
constexpr int NPHASES = 3 + 13 * DEPTH;
constexpr int LDS_BYTES = 147456;
struct Args { const float* in[25]; float* out; unsigned char* ws; int ph_lo, ph_hi; };

typedef __attribute__((address_space(4))) const Args CArgs;
struct InView { CArgs* ap; __device__ __forceinline__ const float* operator[](int i) const { return ap->in[i]; } };
struct Ctx {
    LAS unsigned char* lds;
    int tid, lane, wave, G, bid;
    InView in;
    float* out; unsigned char* ws;
};

__device__ __forceinline__ float* xrow_ptr(const Ctx& F, int r) { return r < ML ? F.out + (size_t)r * DM : (float*)(F.ws + WS_XC) + (size_t)(r - ML) * DM; }

__device__ __forceinline__ void transpose_item(const float* W, int Nsrc, int k0, int n0, bf16_t* WT, int Kd, int drow0, LAS float* scr, int lane) {
#pragma unroll 8
    for (int i = 0; i < 32; ++i) { const int kk = 2 * i + (lane >> 5); scr[kk * 33 + (lane & 31)] = W[(size_t)(k0 + kk) * Nsrc + n0 + (lane & 31)]; }
    asm volatile("s_waitcnt lgkmcnt(0)" ::: "memory");
    const int c = lane & 7;
#pragma unroll
    for (int j = 0; j < 4; ++j) { const int n = (lane >> 3) + 8 * j; const LAS float* s = scr + (8 * c) * 33 + n;
        u32x4 o; o.x = pk2(s[0 * 33], s[1 * 33]); o.y = pk2(s[2 * 33], s[3 * 33]); o.z = pk2(s[4 * 33], s[5 * 33]); o.w = pk2(s[6 * 33], s[7 * 33]);
        *(u32x4*)(WT + (size_t)(drow0 + n) * Kd + k0 + 8 * c) = o; }
    asm volatile("s_waitcnt lgkmcnt(0)" ::: "memory");
}

__device__ __forceinline__ void phase_prologue(const Ctx& F) {
    const float* c_in = F.in[1]; const float* cctx = F.in[3]; const float* w_ada = F.in[4];
    {
        LAS float* sl = (LAS float*)F.lds;
        float* MODP = (float*)(F.ws + WS_MODP);
        for (int item = F.bid; item < 576; item += F.G) {
            const int l = item / 144, r2 = item % 144, kq = r2 / 18, nb = r2 % 18;
            __syncthreads();
            for (int idx = F.tid; idx < 17 * 128; idx += NTHR) { const int rr = idx >> 7, kk = idx & 127; const float v = rr < 16 ? c_in[rr * DM + kq * 128 + kk] : cctx[kq * 128 + kk]; sl[idx] = v / (1.0f + exp_f(-v)); }
            __syncthreads();
            const int n = nb * 512 + F.tid;
            float acc[17];
#pragma unroll
            for (int r = 0; r < 17; ++r) acc[r] = 0.f;
            const float* wp = w_ada + ((size_t)l * DM + kq * 128) * NMOD + n;
            for (int k0 = 0; k0 < 128; k0 += 16) {
                float w[16];
#pragma unroll
                for (int k = 0; k < 16; ++k) w[k] = __builtin_nontemporal_load(wp + (size_t)(k0 + k) * NMOD);
#pragma unroll
                for (int k = 0; k < 16; ++k) {
#pragma unroll
                    for (int r = 0; r < 17; ++r) acc[r] += sl[r * 128 + k0 + k] * w[k]; }
            }
#pragma unroll
            for (int r = 0; r < 17; ++r) MODP[(((size_t)kq * 4 + l) * 17 + r) * NMOD + n] = acc[r];
        }
        __syncthreads();
    }
    {
        LAS float* scr = (LAS float*)(F.lds + F.wave * 16384);
        const int gw = F.bid * NWAVES + F.wave, NGW = F.G * NWAVES;
        bf16_t* WGU = (bf16_t*)(F.ws + WS_WGU); bf16_t* WD = (bf16_t*)(F.ws + WS_WD); bf16_t* WIN = (bf16_t*)(F.ws + WS_WIN); bf16_t* WOUT = (bf16_t*)(F.ws + WS_WOUT); bf16_t* WGLU = (bf16_t*)(F.ws + WS_WGLU);
        constexpr int I_GU = 16 * 88, I_D = 44 * 32, I_IN = 16 * 56, I_OUT = 16 * 32, I_GLU = 4 * 8;
        constexpr int NITEMS = I_GU * 16 + I_D * 8 + I_IN * 4 + I_OUT * 4 + I_GLU * 4;
        for (int it = gw; it < NITEMS; it += NGW) {
            int r = it;
            if (r < I_GU * 16) { const int up = r / (I_GU * 8); r -= up * I_GU * 8; const int ls = r / I_GU; r %= I_GU; const int kb = r / 88, nb = r % 88, n0 = nb * 32;
                transpose_item(F.in[up ? 9 : 8] + (size_t)ls * DM * DFF, DFF, kb * 64, n0, WGU + (size_t)ls * 5632 * DM, DM, (n0 / 128) * 256 + (n0 % 128) + up * 128, scr, F.lane); continue; }
            r -= I_GU * 16;
            if (r < I_D * 8) { const int ls = r / I_D; r %= I_D; const int kb = r / 32, nb = r % 32;
                transpose_item(F.in[10] + (size_t)ls * DFF * DM, DM, kb * 64, nb * 32, WD + (size_t)ls * DM * DFF, DFF, nb * 32, scr, F.lane); continue; }
            r -= I_D * 8;
            if (r < I_IN * 4) { const int l = r / I_IN; r %= I_IN; const int kb = r / 56, nb = r % 56;
                transpose_item(F.in[11] + (size_t)l * DM * INC, INC, kb * 64, nb * 32, WIN + (size_t)l * INC * DM, DM, nb * 32, scr, F.lane); continue; }
            r -= I_IN * 4;
            if (r < I_OUT * 4) { const int l = r / I_OUT; r %= I_OUT; const int kb = r / 32, nb = r % 32;
                transpose_item(F.in[12] + (size_t)l * DM * DM, DM, kb * 64, nb * 32, WOUT + (size_t)l * DM * DM, DM, nb * 32, scr, F.lane); continue; }
            r -= I_OUT * 4;
            { const int l = r / I_GLU; r %= I_GLU; const int kb = r / 8, nb = r % 8;
                transpose_item(F.in[22] + (size_t)l * 256 * 256, 256, kb * 64, nb * 32, WGLU + (size_t)l * 256 * 256, 256, nb * 32, scr, F.lane); }
        }
    }
    const int gt = F.bid * NTHR + F.tid;
    if (gt < 1024) {
        const int v = gt >> 4, i = gt & 15;
        const float inv = __builtin_amdgcn_exp2f(-13.287712379549449f * (float)i * 0.0625f);
        float rev = (float)v * inv * 0.15915494309189535f; rev -= __builtin_rintf(rev);
        ((f32x2*)(F.ws + WS_CS))[gt] = (f32x2){__builtin_amdgcn_cosf(rev), __builtin_amdgcn_sinf(rev)};
    }
    if (gt >= 1024 && gt < 1024 + 8192) {
        const int id = gt - 1024, ldg = id >> 6, p = id & 63;
        const float lr = F.in[14][id], li = F.in[15][id]; const float dt = exp_f(F.in[16][ldg]);
        f32x2* AP = (f32x2*)(F.ws + WS_APOW) + (size_t)ldg * 17 * 64 + p;
        float a1r = 1.f, a1i = 0.f;
        for (int n = 0; n <= 16; ++n) {
            const float mag = exp_f((float)n * lr * dt);
            double a = (double)n * (double)li * (double)dt * 0.15915494309189535; a -= rint(a);
            const float rev = (float)a; const float cr = mag * __builtin_amdgcn_cosf(rev), ci = mag * __builtin_amdgcn_sinf(rev);
            AP[n * 64] = (f32x2){cr, ci};
            if (n == 1) { a1r = cr; a1i = ci; }
        }
        const float den = lr * lr + li * li;
        const float gr = ((a1r - 1.f) * lr + a1i * li) / den, gi = (a1i * lr - (a1r - 1.f) * li) / den;
        f32x2* BB = (f32x2*)(F.ws + WS_BBAR) + (size_t)id * 16;
        for (int h = 0; h < 16; ++h) { const float br = F.in[17][(size_t)id * 16 + h], bi = F.in[18][(size_t)id * 16 + h]; BB[h] = (f32x2){gr * br - gi * bi, gr * bi + gi * br}; }
    }
}

__device__ __forceinline__ float ssm_kval(const Ctx& F, int ldg, int tau, int h, int h2) {
    const float* cr = F.in[19] + ((size_t)ldg * 16 + h) * 64; const float* ci = F.in[20] + ((size_t)ldg * 16 + h) * 64;
    const f32x2* AP = (const f32x2*)(F.ws + WS_APOW) + ((size_t)ldg * 17 + tau) * 64;
    const f32x2* BB = (const f32x2*)(F.ws + WS_BBAR) + (size_t)ldg * 64 * 16 + h2;
    float s = 0.f;
    for (int p = 0; p < 64; ++p) { const f32x2 a = AP[p], b = BB[p * 16]; const float c_r = cr[p], c_i = ci[p];
        const float er = c_r * a.x - c_i * a.y, ei = c_r * a.y + c_i * a.x; s += er * b.x - ei * b.y; }
    return s;
}
__device__ __forceinline__ void phase_prologue2(const Ctx& F) {
    const int gt = F.bid * NTHR + F.tid, NT = F.G * NTHR;
    float* MOD = (float*)(F.ws + WS_MOD); const float* MODP = (const float*)(F.ws + WS_MODP);
    for (int idx = gt; idx < 4 * 17 * NMOD; idx += NT) {
        const int l = idx / (17 * NMOD), n = idx % NMOD;
        float s = F.in[5][l * NMOD + n];
#pragma unroll
        for (int kq = 0; kq < 8; ++kq) s += MODP[(size_t)kq * 4 * 17 * NMOD + idx];
        MOD[idx] = s;
    }
    float* KT = (float*)(F.ws + WS_KT);
    for (int idx = gt; idx < 4 * 2 * 16 * 16 * 256; idx += NT) {
        const int h2 = idx & 15, h = (idx >> 4) & 15, tau = (idx >> 8) & 15, g = (idx >> 12) & 15, dir = (idx >> 16) & 1, l = idx >> 17;
        KT[idx] = ssm_kval(F, (l * 2 + dir) * 16 + g, tau, h, h2);
    }
    bf16_t* SST = (bf16_t*)(F.ws + WS_SST);
    for (int idx = gt; idx < 4 * 16 * 256 * 256; idx += NT) {
        const int k = idx & 255, n = (idx >> 8) & 255, g = (idx >> 16) & 15, l = idx >> 20;
        const int dir = n >> 7, ri = (n >> 6) & 1, p = n & 63, j = k >> 4, h2 = k & 15, pw = dir == 0 ? 15 - j : j, ldg = (l * 2 + dir) * 16 + g;
        const f32x2 a = ((const f32x2*)(F.ws + WS_APOW))[((size_t)ldg * 17 + pw) * 64 + p];
        const f32x2 b = ((const f32x2*)(F.ws + WS_BBAR))[((size_t)ldg * 64 + p) * 16 + h2];
        SST[idx] = f2bf(ri == 0 ? (a.x * b.x - a.y * b.y) : (a.x * b.y + a.y * b.x));
    }
}
__device__ __forceinline__ void phase_prologue3(const Ctx& F) {
    const int gt = F.bid * NTHR + F.tid, NT = F.G * NTHR;
    bf16_t* SOUT = (bf16_t*)(F.ws + WS_SOUT); const float* KT = (const float*)(F.ws + WS_KT);
    for (int idx = gt; idx < 4 * 16 * 256 * 512; idx += NT) {
        const int k = idx & 511, row = (idx >> 9) & 255, g = (idx >> 17) & 15, l = idx >> 21, t = row >> 4, h = row & 15;
        float val = 0.f;
        if (k < 256) { const int j = k >> 4, h2 = k & 15;
            if (j <= t) val += KT[(((((size_t)l * 2 + 0) * 16 + g) * 16 + (t - j)) * 16 + h) * 16 + h2];
            if (j >= t) val += KT[(((((size_t)l * 2 + 1) * 16 + g) * 16 + (j - t)) * 16 + h) * 16 + h2];
            if (j == t && h == h2) val += F.in[21][l * 256 + g * 16 + h];
        } else { const int kk = k - 256, dir = kk >> 7, ri = (kk >> 6) & 1, p = kk & 63, n = dir == 0 ? t + 1 : 16 - t, ldg = (l * 2 + dir) * 16 + g;
            const float c_r = F.in[19][((size_t)ldg * 16 + h) * 64 + p], c_i = F.in[20][((size_t)ldg * 16 + h) * 64 + p];
            const f32x2 a = ((const f32x2*)(F.ws + WS_APOW))[((size_t)ldg * 17 + n) * 64 + p];
            const float er = c_r * a.x - c_i * a.y, ei = c_r * a.y + c_i * a.x; val = ri == 0 ? er : -ei; }
        SOUT[idx] = f2bf(val);
    }
}

__device__ __forceinline__ void phase_rowwise(const Ctx& F, bool first, bool has_y, bool y2, bool write_h, int nrows, float fac,
                                              const float* gpost, const float* modg  , int gate_idx,
                                              const float* gpre, const float* modh  , int shift_idx, int scale_idx) {
    const int gw = F.bid * NWAVES + F.wave, NGW = F.G * NWAVES, lane = F.lane;
    const bf16_t* Y = (const bf16_t*)(F.ws + WS_Y); bf16_t* H = (bf16_t*)(F.ws + WS_H);
    constexpr int NR = 2;
    for (int rb = gw; rb < nrows; rb += NR * NGW) {
        f32x4 xv[NR][4], yv[NR][4]; float* xr[NR]; int b17[NR]; bool ok[NR]; int rr[NR];
#pragma unroll
        for (int k = 0; k < NR; ++k) {
            const int r0 = rb + k * NGW; ok[k] = r0 < nrows; const int r = ok[k] ? r0 : rb; rr[k] = r;
            b17[k] = r < ML ? (r >> 12) : 16; xr[k] = xrow_ptr(F, r);
            const float* xs = first ? (r < ML ? F.in[0] + (size_t)r * DM : F.in[2] + (size_t)(r - ML) * DM) : xr[k];
#pragma unroll
            for (int j = 0; j < 4; ++j) xv[k][j] = __builtin_nontemporal_load((const f32x4*)(xs + 4 * lane + 256 * j));
            if (has_y) {
#pragma unroll
                for (int j = 0; j < 4; ++j) { const u32x2 w = __builtin_nontemporal_load((const u32x2*)(Y + (size_t)r * DM + 4 * lane + 256 * j));
                    yv[k][j] = (f32x4){bf2f((unsigned short)(w.x & 0xffff)), bf2f((unsigned short)(w.x >> 16)), bf2f((unsigned short)(w.y & 0xffff)), bf2f((unsigned short)(w.y >> 16))}; }
                if (y2 && r >= ML) {
#pragma unroll
                    for (int j = 0; j < 4; ++j) { const u32x2 w = __builtin_nontemporal_load((const u32x2*)((const bf16_t*)(F.ws + WS_Y2) + (size_t)(r - ML) * DM + 4 * lane + 256 * j));
                        yv[k][j] = yv[k][j] + (f32x4){bf2f((unsigned short)(w.x & 0xffff)), bf2f((unsigned short)(w.x >> 16)), bf2f((unsigned short)(w.y & 0xffff)), bf2f((unsigned short)(w.y >> 16))}; }
                }
            }
        }
        if (has_y) {
            float s[NR];
#pragma unroll
            for (int k = 0; k < NR; ++k) { s[k] = 0.f;
#pragma unroll
                for (int j = 0; j < 4; ++j) s[k] += (yv[k][j][0] * yv[k][j][0] + yv[k][j][1] * yv[k][j][1]) + (yv[k][j][2] * yv[k][j][2] + yv[k][j][3] * yv[k][j][3]); }
#pragma unroll
            for (int o = 1; o < 64; o <<= 1) {
#pragma unroll
                for (int k = 0; k < NR; ++k) s[k] += shx(s[k], lane, o);
            }
#pragma unroll
            for (int k = 0; k < NR; ++k) { const float rs = fac * __builtin_amdgcn_rsqf(s[k] * (1.0f / DM) + EPS);
#pragma unroll
                for (int j = 0; j < 4; ++j) { const f32x4 gp = *(const f32x4*)(gpost + 4 * lane + 256 * j); const f32x4 gt = *(const f32x4*)(modg + (size_t)b17[k] * NMOD + gate_idx * DM + 4 * lane + 256 * j);
                    xv[k][j] = xv[k][j] + gt * (yv[k][j] * rs * gp); } }
        }
        if (has_y || first) {
#pragma unroll
            for (int k = 0; k < NR; ++k) if (ok[k]) {
#pragma unroll
                for (int j = 0; j < 4; ++j) __builtin_nontemporal_store(xv[k][j], (f32x4*)(xr[k] + 4 * lane + 256 * j)); }
        }
        if (write_h) {
            float s[NR];
#pragma unroll
            for (int k = 0; k < NR; ++k) { s[k] = 0.f;
#pragma unroll
                for (int j = 0; j < 4; ++j) s[k] += (xv[k][j][0] * xv[k][j][0] + xv[k][j][1] * xv[k][j][1]) + (xv[k][j][2] * xv[k][j][2] + xv[k][j][3] * xv[k][j][3]); }
#pragma unroll
            for (int o = 1; o < 64; o <<= 1) {
#pragma unroll
                for (int k = 0; k < NR; ++k) s[k] += shx(s[k], lane, o);
            }
#pragma unroll
            for (int k = 0; k < NR; ++k) if (ok[k]) { const float rs = __builtin_amdgcn_rsqf(s[k] * (1.0f / DM) + EPS);
#pragma unroll
                for (int j = 0; j < 4; ++j) { const int c0 = 4 * lane + 256 * j; const f32x4 gp = *(const f32x4*)(gpre + c0);
                    const f32x4 sh = *(const f32x4*)(modh + (size_t)b17[k] * NMOD + shift_idx * DM + c0), sc = *(const f32x4*)(modh + (size_t)b17[k] * NMOD + scale_idx * DM + c0);
                    const f32x4 hv = (xv[k][j] * rs * gp) * (sc + 1.0f) + sh;
                    *(u32x2*)(H + (size_t)rr[k] * DM + c0) = (u32x2){pk2(hv[0], hv[1]), pk2(hv[2], hv[3])}; } }
        }
    }
}

__device__ __forceinline__ int crow(int r, int hi) { return (r & 3) + 8 * (r >> 2) + 4 * hi; }
__device__ __forceinline__ void attn_tile(LAS unsigned char* lb, bool local, int kvstart, int qpos, int q, int hi, int lane, const bf16x8 (&qf)[4], float& mrun, float& lsum, f32x16 (&ot)[2]) {
    f32x16 p0, p1;
#pragma unroll
    for (int i = 0; i < 16; ++i) { p0[i] = 0.f; p1[i] = 0.f; }
#pragma unroll
    for (int s = 0; s < 4; ++s) {
        const bf16x8 a0 = *(const LAS bf16x8*)(lb + q * 144 + 32 * s + 16 * hi);
        const bf16x8 a1 = *(const LAS bf16x8*)(lb + (32 + q) * 144 + 32 * s + 16 * hi);
        p0 = __builtin_amdgcn_mfma_f32_32x32x16_bf16(a0, qf[s], p0, 0, 0, 0);
        p1 = __builtin_amdgcn_mfma_f32_32x32x16_bf16(a1, qf[s], p1, 0, 0, 0);
    }
    if (local) {
#pragma unroll
        for (int i = 0; i < 16; ++i) { const int d0 = kvstart + crow(i, hi) - qpos; if (d0 > 128 || d0 < -128) p0[i] = -1e30f; const int d1 = d0 + 32; if (d1 > 128 || d1 < -128) p1[i] = -1e30f; }
    }
    float mx = p0[0];
#pragma unroll
    for (int i = 1; i < 16; ++i) mx = fmaxf(mx, p0[i]);
#pragma unroll
    for (int i = 0; i < 16; ++i) mx = fmaxf(mx, p1[i]);
    mx = fmaxf(mx, shx(mx, lane, 32));
    const float mnew = fmaxf(mrun, mx), sc = __builtin_amdgcn_exp2f(mrun - mnew); mrun = mnew;
    float ps = 0.f;
#pragma unroll
    for (int i = 0; i < 16; ++i) { p0[i] = __builtin_amdgcn_exp2f(p0[i] - mnew); p1[i] = __builtin_amdgcn_exp2f(p1[i] - mnew); ps += p0[i] + p1[i]; }
    lsum = lsum * sc + ps;
#pragma unroll
    for (int i = 0; i < 16; ++i) { ot[0][i] *= sc; ot[1][i] *= sc; }
    bf16x8 pb[4];
#pragma unroll
    for (int ks = 0; ks < 4; ++ks) {
        u32x4 w;
        if (ks < 2) { w.x = pk2(p0[8 * ks + 0], p0[8 * ks + 1]); w.y = pk2(p0[8 * ks + 2], p0[8 * ks + 3]); w.z = pk2(p0[8 * ks + 4], p0[8 * ks + 5]); w.w = pk2(p0[8 * ks + 6], p0[8 * ks + 7]); }
        else { const int k2 = ks - 2; w.x = pk2(p1[8 * k2 + 0], p1[8 * k2 + 1]); w.y = pk2(p1[8 * k2 + 2], p1[8 * k2 + 3]); w.z = pk2(p1[8 * k2 + 4], p1[8 * k2 + 5]); w.w = pk2(p1[8 * k2 + 6], p1[8 * k2 + 7]); }
        pb[ks] = __builtin_bit_cast(bf16x8, w);
    }
#pragma unroll
    for (int dh = 0; dh < 2; ++dh)
#pragma unroll
        for (int ks = 0; ks < 4; ++ks) {
            const s16x4 lo = *(const LAS s16x4*)(lb + 9216 + (32 * dh + q) * 144 + (16 * ks + 4 * hi) * 2);
            const s16x4 h4 = *(const LAS s16x4*)(lb + 9216 + (32 * dh + q) * 144 + (16 * ks + 8 + 4 * hi) * 2);
            const bf16x8 va = __builtin_shufflevector(lo, h4, 0, 1, 2, 3, 4, 5, 6, 7);
            ot[dh] = __builtin_amdgcn_mfma_f32_32x32x16_bf16(va, pb[ks], ot[dh], 0, 0, 0);
        }
}
__device__ __forceinline__ void attn_unit(const Ctx& F, int b, int kh, int qc, const float* sink  ) {
    const bf16_t* Qb = (const bf16_t*)(F.ws + WS_Q); const bf16_t* Kb = (const bf16_t*)(F.ws + WS_K); const bf16_t* VT = (const bf16_t*)(F.ws + WS_VT); bf16_t* MIX = (bf16_t*)(F.ws + WS_H);
    LAS unsigned char* lds = F.lds;
    const int lane = F.lane, q = lane & 31, hi = lane >> 5, hq = kh * 4 + (F.wave >> 1), qs = F.wave & 1;
    const bool isctx = qc >= 64;
    int qpos; size_t qrow;
    if (!isctx) { qpos = qc * 64 + qs * 32 + q; qrow = (size_t)b * SEQL + qpos; } else { qpos = (qc - 64) * 64 + qs * 32 + q; qrow = (size_t)ML + b * NCTX + qpos; }
    const int ilo = isctx ? 0 : (qc < 2 ? 2 - qc : 0), ihi = isctx ? -1 : (65 - qc < 4 ? 65 - qc : 4), nloc = ihi - ilo + 1, nt = nloc + 4;
    const int row = F.tid >> 3, ch = F.tid & 7;
    const bf16_t* kbase = Kb + (size_t)row * 128 + kh * 64 + ch * 8;
    const bf16_t* vbase = VT + ((size_t)(b * 2 + kh) * 64 + row) * VTP + ch * 8;
#define ATT_LOAD(t, kk, vv) do { const int t_ = (t); size_t kr_; int vi_; \
        if (t_ < nloc) { const int ks_ = qc * 64 - 128 + 64 * (ilo + t_); kr_ = (size_t)b * SEQL + ks_; vi_ = ks_; } else { const int c_ = t_ - nloc; kr_ = (size_t)ML + b * NCTX + 64 * c_; vi_ = SEQL + 64 * c_; } \
        kk = *(const u32x4*)(kbase + kr_ * 128); vv = *(const u32x4*)(vbase + vi_); } while (0)
#define ATT_STORE(bo, kk, vv) do { *(LAS u32x4*)(lds + (bo) + row * 144 + ch * 16) = kk; *(LAS u32x4*)(lds + (bo) + 9216 + row * 144 + ch * 16) = vv; } while (0)
    u32x4 kA, vA, kB, vB;
    ATT_LOAD(0, kA, vA); ATT_LOAD(1, kB, vB);
    bf16x8 qf[4];
#pragma unroll
    for (int s = 0; s < 4; ++s) qf[s] = *(const bf16x8*)(Qb + qrow * 512 + hq * 64 + 16 * s + 8 * hi);
    float mrun = sink[hq] * LOG2E, lsum = hi == 0 ? 1.0f : 0.0f;
    f32x16 ot[2];
#pragma unroll
    for (int i = 0; i < 16; ++i) { ot[0][i] = 0.f; ot[1][i] = 0.f; }
    __syncthreads();
    for (int t = 0; t < nt; t += 2) {
        ATT_STORE(0, kA, vA);
        __syncthreads();
        if (t + 2 < nt) ATT_LOAD(t + 2, kA, vA);
        attn_tile(lds, t < nloc, qc * 64 - 128 + 64 * (ilo + t), qpos, q, hi, lane, qf, mrun, lsum, ot);
        if (t + 1 < nt) {
            ATT_STORE(18432, kB, vB);
            __syncthreads();
            if (t + 3 < nt) ATT_LOAD(t + 3, kB, vB);
            attn_tile(lds + 18432, t + 1 < nloc, qc * 64 - 128 + 64 * (ilo + t + 1), qpos, q, hi, lane, qf, mrun, lsum, ot);
        }
    }
#undef ATT_LOAD
#undef ATT_STORE
    lsum += shx(lsum, lane, 32);
    const float inv = 1.0f / lsum;
#pragma unroll
    for (int dh = 0; dh < 2; ++dh)
#pragma unroll
        for (int g4 = 0; g4 < 4; ++g4) {
            const int d0 = 32 * dh + 8 * g4 + 4 * hi;
            *(u32x2*)(MIX + qrow * 1024 + hq * 64 + d0) = (u32x2){pk2(ot[dh][4 * g4] * inv, ot[dh][4 * g4 + 1] * inv), pk2(ot[dh][4 * g4 + 2] * inv, ot[dh][4 * g4 + 3] * inv)};
        }
}
__device__ __forceinline__ void phase_attn(const Ctx& F, int l, bool lastl) {
    const int nq = lastl ? 64 : 68, nunits = NB * 2 * nq;
    for (int id = F.bid; id < nunits; id += F.G) { const int bk = id / nq, qc = id % nq; attn_unit(F, bk >> 1, bk & 1, qc, F.in[13] + l * 8); }
    __syncthreads();
}

__device__ __forceinline__ void unpack8(const u32x4 v, float* f) {
    f[0] = bf2f((unsigned short)(v.x & 0xffff)); f[1] = bf2f((unsigned short)(v.x >> 16)); f[2] = bf2f((unsigned short)(v.y & 0xffff)); f[3] = bf2f((unsigned short)(v.y >> 16));
    f[4] = bf2f((unsigned short)(v.z & 0xffff)); f[5] = bf2f((unsigned short)(v.z >> 16)); f[6] = bf2f((unsigned short)(v.w & 0xffff)); f[7] = bf2f((unsigned short)(v.w >> 16));
}
__device__ __forceinline__ void phase_conv(const Ctx& F, int l, int nrows) {
    const bf16_t* CZ = (const bf16_t*)(F.ws + WS_CZ); bf16_t* MIX = (bf16_t*)(F.ws + WS_H); const float* cw = F.in[24] + l * 768;
    const int gt = F.bid * NTHR + F.tid, NT = F.G * NTHR;
    for (int idx = gt; idx < nrows * 32; idx += NT) {
        const int r = idx >> 5, c0 = (idx & 31) * 8;
        int pos, len; if (r < ML) { pos = r & 4095; len = SEQL; } else { pos = (r - ML) & 255; len = NCTX; }
        const bf16_t* p = CZ + (size_t)r * 768 + c0;
        float gb[8], gc[8], z[8], tp[8], tn[8], a[8], b2[8];
        unpack8(*(const u32x4*)p, gb); unpack8(*(const u32x4*)(p + 256), gc); unpack8(*(const u32x4*)(p + 512), z);
        if (pos > 0) { unpack8(*(const u32x4*)(p - 768 + 256), a); unpack8(*(const u32x4*)(p - 768 + 512), b2);
#pragma unroll
            for (int i = 0; i < 8; ++i) tp[i] = a[i] * b2[i]; }
        else {
#pragma unroll
            for (int i = 0; i < 8; ++i) tp[i] = 0.f; }
        if (pos < len - 1) { unpack8(*(const u32x4*)(p + 768 + 256), a); unpack8(*(const u32x4*)(p + 768 + 512), b2);
#pragma unroll
            for (int i = 0; i < 8; ++i) tn[i] = a[i] * b2[i]; }
        else {
#pragma unroll
            for (int i = 0; i < 8; ++i) tn[i] = 0.f; }
        float o[8];
#pragma unroll
        for (int i = 0; i < 8; ++i) o[i] = gb[i] * (tp[i] * cw[c0 + i] + (gc[i] * z[i]) * cw[256 + c0 + i] + tn[i] * cw[512 + c0 + i]);
        *(u32x4*)(MIX + (size_t)r * 1024 + 768 + c0) = (u32x4){pk2(o[0], o[1]), pk2(o[2], o[3]), pk2(o[4], o[5]), pk2(o[6], o[7])};
    }
}

__device__ __forceinline__ int scan_chunk(int b, int dir, int step) {
    return step < 16 ? NB * 256 + b * 16 + (dir == 0 ? step : 15 - step) : b * 256 + (dir == 0 ? step - 16 : 271 - step);
}
__device__ __forceinline__ void phase_scan(const Ctx& F, int l) {
    const float* SL = (const float*)(F.ws + WS_SL); bf16_t* SSMA = (bf16_t*)(F.ws + WS_SSMA);
    LAS f32x2* sh = (LAS f32x2*)F.lds;
    for (int id = F.bid; id < 512; id += F.G) {
        const int b = id >> 5, g = (id >> 1) & 15, dir = id & 1, p = F.lane, seg = F.wave, ldg = (l * 2 + dir) * 16 + g;
        const f32x2 a16 = ((const f32x2*)(F.ws + WS_APOW))[((size_t)ldg * 17 + 16) * 64 + p];
        const float ar = a16.x, ai = a16.y;
        const size_t gbase = (size_t)g * NCHUNK;
        float xr[34], xi[34];
#pragma unroll
        for (int j = 0; j < 34; ++j) { const size_t rowc = gbase + scan_chunk(b, dir, seg * 34 + j); xr[j] = SL[rowc * 256 + dir * 128 + p]; xi[j] = SL[rowc * 256 + dir * 128 + 64 + p]; }
        float sr = 0.f, si = 0.f;
#pragma unroll
        for (int j = 0; j < 34; ++j) { const float nr = ar * sr - ai * si + xr[j], ni = ar * si + ai * sr + xi[j]; sr = nr; si = ni; }
        __syncthreads();
        sh[seg * 64 + p] = (f32x2){sr, si};
        float pr = ar, pi = ai, p2r, p2i;
        { const float tr = pr * pr - pi * pi, ti = 2.f * pr * pi; pr = tr; pi = ti; } p2r = pr; p2i = pi;
#pragma unroll
        for (int k = 0; k < 4; ++k) { const float tr = pr * pr - pi * pi, ti = 2.f * pr * pi; pr = tr; pi = ti; }
        { const float tr = pr * p2r - pi * p2i, ti = pr * p2i + pi * p2r; pr = tr; pi = ti; }
        __syncthreads();
        sr = 0.f; si = 0.f;
        for (int s2 = 0; s2 < seg; ++s2) { const f32x2 tt = sh[s2 * 64 + p]; const float nr = pr * sr - pi * si + tt.x, ni = pr * si + pi * sr + tt.y; sr = nr; si = ni; }
#pragma unroll
        for (int j = 0; j < 34; ++j) { const size_t rowc = gbase + scan_chunk(b, dir, seg * 34 + j);
            SSMA[rowc * 512 + 256 + dir * 128 + p] = f2bf(sr); SSMA[rowc * 512 + 256 + dir * 128 + 64 + p] = f2bf(si);
            const float nr = ar * sr - ai * si + xr[j], ni = ar * si + ai * sr + xi[j]; sr = nr; si = ni; }
    }
    __syncthreads();
}

#ifndef MK_MULTI
#define MK_MULTI 0
#endif
constexpr size_t WS_BAR = 195 * MiB + 131072;
constexpr int LDS_BARST_OFF = 131072 + 64;
#define XB_TMO      128
#define XB_XCNT(j)  (256  + 64 * (j))
#define XB_XSUB(j)  (1280 + 64 * (j))
#define XB_XGEN(j)  (2304 + 64 * (j))
#define XB_TOP      3328
#define XB_TOPGEN   3392
#define XCD_BAR_WORDS 3456
#define XB_SPIN_CAP (1u << 20)
__device__ __forceinline__ unsigned xb_ld(unsigned* p)              { return __hip_atomic_load(p, __ATOMIC_RELAXED, __HIP_MEMORY_SCOPE_AGENT); }
__device__ __forceinline__ unsigned xb_add(unsigned* p, unsigned v) { return __hip_atomic_fetch_add(p, v, __ATOMIC_RELAXED, __HIP_MEMORY_SCOPE_AGENT); }
__device__ __forceinline__ unsigned xb_xcc_id() { return (unsigned)__builtin_amdgcn_s_getreg((3 << 11) | 20) & 0xFu; }
#define XB_SPIN(cond, bar) do { unsigned _sp = 0; while (cond) { __builtin_amdgcn_s_sleep(1); \
    if ((++_sp & 255u) == 0u) { if (xb_ld(&(bar)[XB_TMO])) break; if (_sp > XB_SPIN_CAP) { atomicAdd(&(bar)[XB_TMO], 1u); break; } } } } while (0)
struct XcdBarrier { unsigned* bar; unsigned x; volatile LAS unsigned* st; };
__device__ __forceinline__ void xcd_barrier_complete(unsigned* bar, unsigned x, unsigned& nloc, unsigned& nx) {
    const unsigned G = gridDim.x * gridDim.y * gridDim.z;
    unsigned sum, cnt, mine, sp = 0u;
    for (;;) {
        sum = 0u; cnt = 0u; mine = 0u;
#pragma unroll
        for (unsigned j = 0; j < 16; ++j) { const unsigned c = xb_ld(&bar[XB_XCNT(j)]); sum += c; cnt += (c > 0u) ? 1u : 0u; mine = (j == x) ? c : mine; }
        if (sum == G) break;
        __builtin_amdgcn_s_sleep(1);
        if ((++sp & 255u) == 0u) { if (xb_ld(&bar[XB_TMO])) break; if (sp > XB_SPIN_CAP) { atomicAdd(&bar[XB_TMO], 1u); break; } }
    }
    nloc = mine > 0u ? mine : 1u; nx = cnt > 0u ? cnt : 1u;
}
__device__ __forceinline__ void xcd_barrier(const XcdBarrier& b, int tid) {
    asm volatile("s_waitcnt vmcnt(0)" ::: "memory");
    __syncthreads();
    if (tid == 0) {
        unsigned* bar = b.bar;
        __builtin_amdgcn_s_waitcnt(0);
        unsigned nloc = b.st[0], nx = b.st[1];
        if (nloc == 0u) { xcd_barrier_complete(bar, b.x, nloc, nx); b.st[0] = nloc; b.st[1] = nx; }
        const unsigned old = xb_add(&bar[XB_XSUB(b.x)], 1u);
        const unsigned gen = old / nloc;
        if (old + 1u == (gen + 1u) * nloc) {
            __builtin_amdgcn_fence(__ATOMIC_RELEASE, "agent");
            asm volatile("s_waitcnt vmcnt(0)" ::: "memory");
            const unsigned og = xb_add(&bar[XB_TOP], 1u);
            const unsigned tg = og / nx;
            if (og + 1u == (tg + 1u) * nx) xb_add(&bar[XB_TOPGEN], 1u);
            else XB_SPIN(xb_ld(&bar[XB_TOPGEN]) == tg, bar);
            __builtin_amdgcn_fence(__ATOMIC_ACQUIRE, "agent");
            xb_add(&bar[XB_XGEN(b.x)], 1u);
            asm volatile("s_waitcnt vmcnt(0)" ::: "memory");
        } else {
            XB_SPIN(xb_ld(&bar[XB_XGEN(b.x)]) == gen, bar);
            __builtin_amdgcn_fence(__ATOMIC_ACQUIRE, "agent");
            asm volatile("s_waitcnt vmcnt(0)" ::: "memory");
        }
    }
    __syncthreads();
}

#ifndef PROBE_DUP
#define PROBE_DUP 0
#endif
__global__ void __launch_bounds__(NTHR, 2) fwd_megakernel(Args args) {
    extern __shared__ __attribute__((aligned(16))) unsigned char lds_raw[];
    cg::grid_group grid = cg::this_grid();
    Ctx F;
    F.lds = (LAS unsigned char*)lds_raw;
    const int wave_s = __builtin_amdgcn_readfirstlane((int)threadIdx.x >> 6);
#if !MK_MULTI
    {
        volatile LAS unsigned* st0 = (volatile LAS unsigned*)(F.lds + LDS_BARST_OFF);
        if (threadIdx.x == 0) { st0[0] = 0u; st0[1] = 0u; (void)xb_add((unsigned*)(args.ws + WS_BAR) + XB_XCNT(xb_xcc_id()), 1u); }
        __syncthreads();
    }
#endif
    const int lo = args.ph_lo, hi = args.ph_hi < NPHASES ? args.ph_hi : NPHASES;
    for (int ph2 = 2 * lo; ph2 < 2 * hi; ++ph2) {
        const int ph = ph2 >> 1;
        if (ph2 & 1) { if (ph < 3 || !((PROBE_DUP >> ((ph - 3) % 13)) & 1)) continue; }
        const bool seam = ph2 > 2 * lo;
        { CArgs* ap_ = (CArgs*)__builtin_amdgcn_kernarg_segment_ptr(); asm volatile("" : "+s"(ap_)); F.in.ap = ap_; F.out = ap_->out; F.ws = ap_->ws; }
        { int l_ = (int)__builtin_amdgcn_mbcnt_hi(~0u, __builtin_amdgcn_mbcnt_lo(~0u, 0u)); asm volatile("" : "+v"(l_)); int w_ = wave_s, b_ = blockIdx.x, g_ = gridDim.x; asm volatile("" : "+s"(w_), "+s"(b_), "+s"(g_));
          F.lane = l_; F.wave = w_; F.tid = w_ * 64 + l_; F.bid = b_; F.G = g_; }
        if (seam) {
            if (ph == 1 && !(ph2 & 1)) grid.sync();
            else { XcdBarrier xb; xb.bar = (unsigned*)(F.ws + WS_BAR); xb.x = xb_xcc_id(); xb.st = (volatile LAS unsigned*)(F.lds + LDS_BARST_OFF); xcd_barrier(xb, F.tid); }
        }
        bf16_t* H = (bf16_t*)(F.ws + WS_H); bf16_t* Gh = (bf16_t*)(F.ws + WS_G); float* Y = (float*)(F.ws + WS_Y);
        const float* MOD = (const float*)(F.ws + WS_MOD);
        if (ph == 0) { phase_prologue(F); continue; }
        if (ph == 1) { phase_prologue2(F); continue; }
        if (ph == 2) { phase_prologue3(F); phase_rowwise(F, true, false, false, true, MT, 0.f, nullptr, nullptr, 0, F.in[6] + 0, MOD, 0, 1); continue; }
        const int q = ph - 3, l = q / 13, kind = q % 13;
        const bool lastl = (l == DEPTH - 1);
        const float* modl = MOD + (size_t)l * 17 * NMOD;
        const float* npre = F.in[6] + (size_t)l * 3 * DM; const float* npost = F.in[7] + (size_t)l * 3 * DM;
        if (kind == 0 || kind == 10) {
            const int s = kind == 0 ? 0 : 1; const int Mff = (lastl && s == 1) ? ML : MT;
            pg8::Gemm g{H, (const bf16_t*)(F.ws + WS_WGU) + (size_t)(l * 2 + s) * 5632 * DM, Mff, 5632, DM, DM, DM, 0, 0, 1};
            pg8::StaticOrder S; S.init(Mff, 5632, 1, F.G, F.bid);
            pg8::EpiSwiGLU E{Gh};
            pg8::gemm_phase<pg8::EpiSwiGLU, true, true, false>(F.lds, F.tid, g, S, E);
        } else if (kind == 1 || kind == 11) {
            const int s = kind == 1 ? 0 : 1; const int Mff = (lastl && s == 1) ? ML : MT;
            pg8::Gemm g{Gh, (const bf16_t*)(F.ws + WS_WD) + (size_t)(l * 2 + s) * DM * DFF, Mff, DM, DFF, DFF, DFF, 0, 0, 1};
            pg8::StaticOrder S; S.init(ML, DM, 1, F.G, F.bid);
            pg8::EpiBf16Y E{(bf16_t*)Y, nullptr};
            pg8::gemm_phase<pg8::EpiBf16Y, true, true, false>(F.lds, F.tid, g, S, E);
            if (Mff == MT) {
                pg8::Gemm g2{Gh + (size_t)ML * DFF, g.Bt, MC, DM, DFF / 2, DFF, DFF, (size_t)(DFF / 2) * 2, (size_t)(DFF / 2) * 2, 2};
                pg8::StaticOrder S2; S2.init(MC, DM, 2, F.G, F.bid);
                pg8::EpiBf16Y E2{(bf16_t*)Y + (size_t)ML * DM, (bf16_t*)(F.ws + WS_Y2)};
                pg8::gemm_phase<pg8::EpiBf16Y, true, true, true>(F.lds, F.tid, g2, S2, E2);
            }
        } else if (kind == 2) {
            phase_rowwise(F, false, true, true, true, MT, 0.5f, npost, modl, 2, npre + DM, modl, 3, 4);
        } else if (kind == 3) {
            pg8::Gemm g{H, (const bf16_t*)(F.ws + WS_WIN) + (size_t)l * INC * DM, MT, INC, DM, DM, DM, 0, 0, 1};
            pg8::StaticOrder S; S.init(MT, INC, 1, F.G, F.bid);
            pg8::EpiWin E{(bf16_t*)(F.ws + WS_Q), (bf16_t*)(F.ws + WS_K), (bf16_t*)(F.ws + WS_VT), (bf16_t*)(F.ws + WS_SSMA), (bf16_t*)(F.ws + WS_CZ), (const f32x2*)(F.ws + WS_CS)};
            pg8::gemm_phase<pg8::EpiWin, true, true, false>(F.lds, F.tid, g, S, E);
        } else if (kind == 4) {
            {
            pg8::Gemm g{(const bf16_t*)(F.ws + WS_SSMA), (const bf16_t*)(F.ws + WS_SST) + (size_t)l * 16 * 256 * 256, NCHUNK, 256, 256, 512, 256, (size_t)NCHUNK * 512 * 2, (size_t)256 * 256 * 2, 16};
            pg8::StaticOrder S; S.init(NCHUNK, 256, 16, F.G, F.bid);
            pg8::EpiF32 E{(float*)(F.ws + WS_SL), 256, (size_t)NCHUNK * 256};
            pg8::gemm_phase<pg8::EpiF32, true, true, true>(F.lds, F.tid, g, S, E);
            }
            __syncthreads();
            if (F.bid & 1) { phase_conv(F, l, lastl ? ML : MT); phase_attn(F, l, lastl); }
            else { phase_attn(F, l, lastl); phase_conv(F, l, lastl ? ML : MT); }
        } else if (kind == 5) {
            phase_scan(F, l);
        } else if (kind == 6) {
            pg8::Gemm g{(const bf16_t*)(F.ws + WS_SSMA), (const bf16_t*)(F.ws + WS_SOUT) + (size_t)l * 16 * 256 * 512, NCHUNK, 256, 512, 512, 512, (size_t)NCHUNK * 512 * 2, (size_t)256 * 512 * 2, 16};
            pg8::StaticOrder S; S.init(NCHUNK, 256, 16, F.G, F.bid);
            pg8::EpiSsmOut E{(bf16_t*)(F.ws + WS_YG)};
            pg8::gemm_phase<pg8::EpiSsmOut, true, true, true>(F.lds, F.tid, g, S, E);
        } else if (kind == 7) {
            const int Mg = lastl ? ML : MT;
            pg8::Gemm g{(const bf16_t*)(F.ws + WS_YG), (const bf16_t*)(F.ws + WS_WGLU) + (size_t)l * 256 * 256, Mg, 256, 256, 256, 256, 0, 0, 1};
            pg8::StaticOrder S; S.init(Mg, 256, 1, F.G, F.bid);
            pg8::EpiGlu E{(const bf16_t*)(F.ws + WS_YG), F.in[23] + l * 256, H};
            pg8::gemm_phase<pg8::EpiGlu, true, true, false>(F.lds, F.tid, g, S, E);
        } else if (kind == 8) {
            const int Mg = lastl ? ML : MT;
            pg8::Gemm g{H, (const bf16_t*)(F.ws + WS_WOUT) + (size_t)l * DM * DM, Mg, DM, DM, DM, DM, 0, 0, 1};
            pg8::StaticOrder S; S.init(Mg, DM, 1, F.G, F.bid);
            pg8::EpiBf16Y E{(bf16_t*)Y, nullptr};
            pg8::gemm_phase<pg8::EpiBf16Y, true, true, false>(F.lds, F.tid, g, S, E);
        } else if (kind == 9) {
            phase_rowwise(F, false, true, false, true, lastl ? ML : MT, 1.0f, npost + DM, modl, 5, npre + 2 * DM, modl, 6, 7);
        } else {
            phase_rowwise(F, false, true, !lastl, !lastl, lastl ? ML : MT, 0.5f, npost + 2 * DM, modl, 8, lastl ? npre : npre + 3 * DM, lastl ? modl : modl + 17 * NMOD, 0, 1);
        }
    }
}

extern "C" void kernel_launch(void* const* d_in, const int* in_sizes, int n_in, void* d_out, int out_size, void* d_ws, size_t ws_size, hipStream_t stream) {
    static int grid = 0;
    if (grid == 0) {
        if (n_in != 25 || out_size != ML * DM || ws_size < WS_END) { fprintf(stderr, "kernel_launch: unexpected shapes: n_in %d out %d ws %zu\n", n_in, out_size, ws_size); grid = -1; return; }
        int dev = 0, cus = 0, per_cu = 0;
        hipGetDevice(&dev); hipDeviceGetAttribute(&cus, hipDeviceAttributeMultiprocessorCount, dev);
        if (hipFuncSetAttribute((const void*)fwd_megakernel, hipFuncAttributeMaxDynamicSharedMemorySize, LDS_BYTES) != hipSuccess) { fprintf(stderr, "kernel_launch: hipFuncSetAttribute failed\n"); grid = -1; return; }
        if (hipOccupancyMaxActiveBlocksPerMultiprocessor(&per_cu, (const void*)fwd_megakernel, NTHR, LDS_BYTES) != hipSuccess || per_cu < 1) { fprintf(stderr, "kernel_launch: occupancy query says %d\n", per_cu); per_cu = 1; }
        (void)hipGetLastError();
        grid = cus * per_cu;
        fprintf(stderr, "kernel_launch: grid %d (cus %d x %d)\n", grid, cus, per_cu);
    }
    if (grid < 0) return;
    Args a{};
    for (int i = 0; i < 25; ++i) a.in[i] = (const float*)d_in[i];
    a.out = (float*)d_out; a.ws = (unsigned char*)d_ws;
#if MK_MULTI
    for (int p = 0; p < NPHASES; ++p) { a.ph_lo = p; a.ph_hi = p + 1; hipLaunchKernelGGL(fwd_megakernel, dim3(grid), dim3(NTHR), LDS_BYTES, stream, a); }
#else
    a.ph_lo = 0; a.ph_hi = 1 << 20;
    if (hipMemsetAsync((char*)d_ws + WS_BAR, 0, 16384, stream) != hipSuccess) { fprintf(stderr, "kernel_launch: memset of the barrier words failed\n"); return; }
    void* kargs[] = {&a};
    hipError_t e = hipLaunchCooperativeKernel((const void*)fwd_megakernel, dim3(grid), dim3(NTHR), kargs, LDS_BYTES, stream);
    if (e != hipSuccess) fprintf(stderr, "cooperative launch failed: %s (grid %d)\n", hipGetErrorString(e), grid);
#endif
}
```

```cpp
#include <hip/hip_runtime.h>
#include <hip/hip_cooperative_groups.h>
#include <cstdio>
#include <cstdint>
namespace cg = cooperative_groups;

#define LAS __attribute__((address_space(3)))
typedef unsigned short bf16_t;
typedef short bf16x8 __attribute__((ext_vector_type(8)));
typedef short s16x4 __attribute__((ext_vector_type(4)));
typedef float f32x4 __attribute__((ext_vector_type(4)));
typedef float f32x16 __attribute__((ext_vector_type(16)));
typedef float f32x2 __attribute__((ext_vector_type(2)));
typedef __bf16 bf16x2_t __attribute__((ext_vector_type(2)));
typedef unsigned u32x4 __attribute__((ext_vector_type(4)));
typedef unsigned u32x2 __attribute__((ext_vector_type(2)));

constexpr int NB = 16, SEQL = 4096, NCTX = 256, DM = 1024, DEPTH = 4;
constexpr int ML = NB * SEQL;
constexpr int MC = NB * NCTX;
constexpr int MT = ML + MC;
constexpr int DFF = 2816, INC = 1792, NMOD = 9 * DM;
constexpr int NCHUNK = MT / 16;
constexpr int VTP = SEQL + NCTX;
constexpr float EPS = 1e-6f;
constexpr float LOG2E = 1.4426950408889634f;
constexpr float QSCALE = 0.125f * LOG2E;

constexpr size_t MiB = 1u << 20;
constexpr size_t WS_WGU = 0;
constexpr size_t WS_WD = 88 * MiB;
constexpr size_t WS_WIN = 132 * MiB;
constexpr size_t WS_WOUT = 146 * MiB;
constexpr size_t WS_WGLU = 154 * MiB;
constexpr size_t WS_SOUT = 155 * MiB;
constexpr size_t WS_SST = 171 * MiB;
constexpr size_t WS_MOD = 179 * MiB;
constexpr size_t WS_MODP = 620 * MiB;
constexpr size_t WS_KT = 660 * MiB;
constexpr size_t WS_APOW = 192 * MiB;
constexpr size_t WS_BBAR = 194 * MiB;
constexpr size_t WS_CS = 195 * MiB;
constexpr size_t WS_XC = 196 * MiB;
constexpr size_t WS_H = 212 * MiB;
constexpr size_t WS_Y = 348 * MiB;
constexpr size_t WS_Y2 = WS_Y + 136 * MiB;
constexpr size_t WS_G = 620 * MiB;
constexpr size_t WS_Q = WS_G;
constexpr size_t WS_K = WS_Q + 68 * MiB;
constexpr size_t WS_VT = WS_K + 17 * MiB;
constexpr size_t WS_SSMA = WS_VT + 17 * MiB;
constexpr size_t WS_SL = WS_SSMA + 68 * MiB;
constexpr size_t WS_CZ = WS_SL + 68 * MiB;
constexpr size_t WS_YG = WS_CZ + 102 * MiB;
constexpr size_t WS_END = 994 * MiB;
static_assert(WS_YG + 34 * MiB <= WS_END, "ws map");
static_assert((size_t)MT * DFF * 2 <= 374 * MiB, "G fits");

__device__ __forceinline__ unsigned pk2(float lo, float hi) { f32x2 v = {lo, hi}; bf16x2_t b = __builtin_convertvector(v, bf16x2_t); return __builtin_bit_cast(unsigned, b); }
__device__ __forceinline__ unsigned short f2bf(float f) { unsigned u = __builtin_bit_cast(unsigned, f); return (unsigned short)((u + 0x7fffu + ((u >> 16) & 1u)) >> 16); }
__device__ __forceinline__ float bf2f(unsigned short b) { return __builtin_bit_cast(float, (unsigned)b << 16); }
__device__ __forceinline__ float silu_f(float g) { return g * __builtin_amdgcn_rcpf(1.0f + __builtin_amdgcn_exp2f(-g * LOG2E)); }
__device__ __forceinline__ float sigmoid_f(float g) { return __builtin_amdgcn_rcpf(1.0f + __builtin_amdgcn_exp2f(-g * LOG2E)); }
__device__ __forceinline__ float gelu_tanh_f(float y) { const float t = 0.7978845608028654f * (y + 0.044715f * y * y * y); return y * __builtin_amdgcn_rcpf(1.0f + __builtin_amdgcn_exp2f(-2.0f * LOG2E * t)); }
__device__ __forceinline__ float shx(float v, int lane, int o) { return __builtin_bit_cast(float, __builtin_amdgcn_ds_bpermute((lane ^ o) << 2, __builtin_bit_cast(int, v))); }
__device__ __forceinline__ float wave_sum(float v, int lane) {
#pragma unroll
    for (int o = 1; o < 64; o <<= 1) v += shx(v, lane, o);
    return v;
}
__device__ __forceinline__ float exp_f(float x) { return __builtin_amdgcn_exp2f(x * LOG2E); }

struct Args { const float* in[25]; float* out; unsigned char* ws; int ph_lo, ph_hi; };
typedef __attribute__((address_space(4))) const Args CArgs;
#define RLXA __ATOMIC_RELAXED, __HIP_MEMORY_SCOPE_AGENT
constexpr size_t WS_CTL = 195 * MiB + 262144;
constexpr int LDS_FLAG_OFF = 131072;
constexpr int Q_CNT = 0, Q_QUEUE = 320, Q_TAIL = 640, Q_HEAD = 704, Q_SLOT_WORDS = 1024;

__device__ __forceinline__ void rowwise_quarter(CArgs* ap, int l, int which, bool y2, int pm, int quarter, int wid, int lane) {
    unsigned char* ws = ap->ws; float* outp = ap->out;
    const bf16_t* Y = (const bf16_t*)(ws + WS_Y); bf16_t* H = (bf16_t*)(ws + WS_H);
    const float* modg = (const float*)(ws + WS_MOD) + (size_t)l * 17 * NMOD;
    const float* npost = ap->in[7] + (size_t)l * 3 * DM + which * DM;
    const bool write_h = !(which == 2 && l == DEPTH - 1);
    const int lh = (which == 2 && l < DEPTH - 1) ? l + 1 : l;
    const float* modh = (const float*)(ws + WS_MOD) + (size_t)lh * 17 * NMOD;
    const float* npre = ap->in[6] + (size_t)lh * 3 * DM + (which == 2 ? 0 : (which + 1) * DM);
    const int shift_idx = which == 2 ? 0 : 3 * (which + 1);
    const float fac = which == 1 ? 1.0f : 0.5f;
    const int b17 = pm < (ML / 256) ? (pm >> 4) : 16;
    const bool add2 = y2 && pm >= (ML / 256);
    f32x4 ca[4], cb[4], cc[4];
#pragma unroll
    for (int j = 0; j < 4; ++j) { const int c0 = 4 * lane + 256 * j;
        ca[j] = *(const f32x4*)(npost + c0) * *(const f32x4*)(modg + (size_t)b17 * NMOD + (2 + 3 * which) * DM + c0) * fac;
        cb[j] = *(const f32x4*)(npre + c0) * (*(const f32x4*)(modh + (size_t)b17 * NMOD + (shift_idx + 1) * DM + c0) + 1.0f);
        cc[j] = *(const f32x4*)(modh + (size_t)b17 * NMOD + shift_idx * DM + c0); }
    constexpr int NR = 2;
    for (int i = 0; i < 8; i += NR) {
        const int r0 = pm * 256 + quarter * 64 + wid * 8 + i;
        f32x4 xv[NR][4], yv[NR][4]; float* xr[NR];
#pragma unroll
        for (int k = 0; k < NR; ++k) { const int r = r0 + k; xr[k] = r < ML ? outp + (size_t)r * DM : (float*)(ws + WS_XC) + (size_t)(r - ML) * DM;
#pragma unroll
            for (int j = 0; j < 4; ++j) {
                const u32x2 w = __builtin_nontemporal_load((const u32x2*)(Y + (size_t)r * DM + 4 * lane + 256 * j));
                yv[k][j] = (f32x4){bf2f((unsigned short)(w.x & 0xffff)), bf2f((unsigned short)(w.x >> 16)), bf2f((unsigned short)(w.y & 0xffff)), bf2f((unsigned short)(w.y >> 16))};
                xv[k][j] = __builtin_nontemporal_load((const f32x4*)(xr[k] + 4 * lane + 256 * j)); }
            if (add2) {
#pragma unroll
                for (int j = 0; j < 4; ++j) { const u32x2 w = __builtin_nontemporal_load((const u32x2*)((const bf16_t*)(ws + WS_Y2) + (size_t)(r - ML) * DM + 4 * lane + 256 * j));
                    yv[k][j] = yv[k][j] + (f32x4){bf2f((unsigned short)(w.x & 0xffff)), bf2f((unsigned short)(w.x >> 16)), bf2f((unsigned short)(w.y & 0xffff)), bf2f((unsigned short)(w.y >> 16))}; }
            } }
        float rs[NR], rs2[NR];
#pragma unroll
        for (int k = 0; k < NR; ++k) { float s = 0.f;
#pragma unroll
            for (int j = 0; j < 4; ++j) s += (yv[k][j][0] * yv[k][j][0] + yv[k][j][1] * yv[k][j][1]) + (yv[k][j][2] * yv[k][j][2] + yv[k][j][3] * yv[k][j][3]);
            rs[k] = s; }
#pragma unroll
        for (int o = 1; o < 64; o <<= 1) {
#pragma unroll
            for (int k = 0; k < NR; ++k) rs[k] += shx(rs[k], lane, o);
        }
#pragma unroll
        for (int k = 0; k < NR; ++k) {
            const float r1 = __builtin_amdgcn_rsqf(rs[k] * (1.0f / DM) + EPS);
            float s2 = 0.f;
#pragma unroll
            for (int j = 0; j < 4; ++j) { xv[k][j] = xv[k][j] + ca[j] * (yv[k][j] * r1); __builtin_nontemporal_store(xv[k][j], (f32x4*)(xr[k] + 4 * lane + 256 * j));
                s2 += (xv[k][j][0] * xv[k][j][0] + xv[k][j][1] * xv[k][j][1]) + (xv[k][j][2] * xv[k][j][2] + xv[k][j][3] * xv[k][j][3]); }
            rs2[k] = s2;
        }
        if (write_h) {
#pragma unroll
            for (int o = 1; o < 64; o <<= 1) {
#pragma unroll
                for (int k = 0; k < NR; ++k) rs2[k] += shx(rs2[k], lane, o);
            }
#pragma unroll
            for (int k = 0; k < NR; ++k) {
                const float r2 = __builtin_amdgcn_rsqf(rs2[k] * (1.0f / DM) + EPS);
#pragma unroll
                for (int j = 0; j < 4; ++j) { const f32x4 hv = (xv[k][j] * r2) * cb[j] + cc[j];
                    *(u32x2*)(H + (size_t)(r0 + k) * DM + 4 * lane + 256 * j) = (u32x2){pk2(hv[0], hv[1]), pk2(hv[2], hv[3])}; }
            }
        }
    }
}
constexpr int LDS_PEND_OFF = LDS_FLAG_OFF + 4;
__device__ __forceinline__ int rowq_step(unsigned* ctl, int total, LAS int* pend) {
    int p = *pend;
    if (p == -1) { const unsigned h = __hip_atomic_fetch_add(ctl + Q_HEAD, 1u, RLXA); p = ((int)h < total) ? (int)h : -2; }
    int item = -1;
    if (p >= 0) { const unsigned qe = __hip_atomic_load(ctl + Q_QUEUE + (p >> 2), RLXA); if (qe != 0u) { item = (int)(((qe - 1u) << 2) | ((unsigned)p & 3u)); p = -1; } }
    *pend = p;
    return item;
}
__device__ __forceinline__ void rowq_drain(LAS unsigned char* lds, unsigned* ctl, int total, CArgs* ap, int l, int which, bool y2, int tid, int wid) {
    LAS int* lflag = (LAS int*)(lds + LDS_FLAG_OFF); LAS int* pend = (LAS int*)(lds + LDS_PEND_OFF);
    for (;;) {
        __builtin_amdgcn_s_barrier();
        if (tid == 0) {
            int item = -1; int p = *pend;
            if (p == -1) { const unsigned h = __hip_atomic_fetch_add(ctl + Q_HEAD, 1u, RLXA); p = ((int)h < total) ? (int)h : -2; }
            if (p >= 0) {
                unsigned qe = 0u, spins = 0u;
                for (;;) { qe = __hip_atomic_load(ctl + Q_QUEUE + (p >> 2), RLXA); if (qe != 0u) break; __builtin_amdgcn_s_sleep(16); if (++spins > (1u << 21)) break; }
                if (qe != 0u) { item = (int)(((qe - 1u) << 2) | ((unsigned)p & 3u)); p = -1; } else p = -2;
            }
            *pend = p;
            if (item >= 0) { __builtin_amdgcn_fence(__ATOMIC_ACQUIRE, "agent"); asm volatile("s_waitcnt vmcnt(0)" ::: "memory"); }
            *lflag = item;
        }
        asm volatile("s_waitcnt lgkmcnt(0)" ::: "memory");
        __builtin_amdgcn_s_barrier();
        const int it = __builtin_amdgcn_readfirstlane(*lflag);
        if (it < 0) break;
        int lane = (int)__builtin_amdgcn_mbcnt_hi(~0u, __builtin_amdgcn_mbcnt_lo(~0u, 0u)); asm volatile("" : "+v"(lane));
        rowwise_quarter(ap, l, which, y2, it >> 2, it & 3, wid, lane);
    }
}

namespace pg8 {
constexpr int BM = 256, BK = 64, HALF = 128, HTB = HALF * BK * 2, STAGE_BYTES = 8 * HTB, NXCD = 8, WGM = 4;
__host__ __device__ __forceinline__ int lds_byte(int r, int c) { const int st = (r >> 4) * 2 + (c >> 5), rr = r & 15, cc = c & 31, ob = rr * 64 + cc * 2; return st * 1024 + (ob ^ (((ob >> 9) & 1) << 5)); }
__host__ __device__ __forceinline__ void stage_rc(int b, int& R, int& C) { const int st = b / 1024, sb = b % 1024, swz = sb ^ (((sb >> 9) & 1) << 5); R = (st >> 1) * 16 + swz / 64; C = (st & 1) * 32 + (swz % 64) / 2; }
__host__ __device__ __forceinline__ int perm32(int rho) { const int n = rho >> 4, i = rho & 15; return 8 * (i >> 2) + 4 * n + (i & 3); }

struct Unit { int pm, pn, z; };
struct Gemm { const bf16_t* A; const bf16_t* Bt; int M, N, K, lda, ldb; size_t zsA, zsB; int nz; };

struct StaticOrder {
    int nM, nN, nwg, G, c, nz;
    __device__ void init(int M, int N, int nz_, int G_, int c_) { nM = M / BM; nN = N / BM; nwg = nM * nN; G = G_; c = c_; nz = nz_; }
    __device__ bool next(int i, Unit& u) const {
        const long L = (long)i * G + c; if (L >= (long)nwg * nz) return false;
        u.z = (int)(L / nwg);
        int wgid = (int)(L % nwg); { const int q = nwg / NXCD, r = nwg % NXCD, xcd = wgid % NXCD, off = wgid / NXCD; wgid = (xcd < r ? xcd * (q + 1) : r * (q + 1) + (xcd - r) * q) + off; }
        const int nig = WGM * nN, gid = wgid / nig, fm = gid * WGM, gsz = (nM - fm) < WGM ? (nM - fm) : WGM;
        u.pm = fm + ((wgid % nig) % gsz); u.pn = (wgid % nig) / gsz; return true;
    }
};

template <class Epi, bool ALIGN_EPI, bool SP2, bool ZB>
__device__ __forceinline__ void gemm_phase(LAS unsigned char* lds, const int tid, const Gemm g, const StaticOrder& S, const Epi& E) {
    const int wid = __builtin_amdgcn_readfirstlane(tid >> 6), lane = tid & 63, wr = wid >> 2, wc = wid & 3, fr = lane & 15, fq = lane >> 4;
    const int K = g.K, nt = K / BK, lda = g.lda, ldb = g.ldb;
    unsigned voffA[2], voffB[2];
#pragma unroll
    for (int i = 0; i < 2; ++i) { int R, C; stage_rc(tid * 16 + i * 8192, R, C); const int Rb = Epi::PERM ? ((R & ~31) + perm32(R & 31)) : R;
        voffA[i] = (unsigned)(R * lda + C) * 2u; voffB[i] = (unsigned)(Rb * ldb + C) * 2u; }
    const size_t kstep = (size_t)(BK * 2);
    const size_t hstepA = (size_t)HALF * lda * 2, hstepB = (size_t)HALF * ldb * 2;
    const size_t tstepA = 2 * hstepA, tstepB = 2 * hstepB;
    const unsigned ldsw = (unsigned)wid * 1024u;
    const int aoff = lds_byte(wr * 64 + fr, fq * 8), boff = lds_byte(wc * 32 + fr, fq * 8);
#define PG8_SA(b, h) (((b) * 2 + (h)) * HTB)
#define PG8_SB(b, h) ((4 + (b) * 2 + (h)) * HTB)
#define PG8_STAGE(bufoff, gbase, voff) do { _Pragma("unroll") for (int _i = 0; _i < 2; ++_i) { unsigned _vo = (voff)[_i]; asm volatile("" : "+v"(_vo)); \
        __builtin_amdgcn_global_load_lds((const unsigned*)((const char*)(gbase) + _vo), (LAS unsigned*)(lds + (bufoff) + ldsw + _i * 8192), 16, 0, 0); } } while (0)
#define PG8_LDA(dst, b, h) do { _Pragma("unroll") for (int m = 0; m < 4; ++m) _Pragma("unroll") for (int k = 0; k < 2; ++k) dst[m][k] = *(const LAS bf16x8*)(lds + PG8_SA(b, h) + aoff + m * 2048 + k * 1024); } while (0)
#define PG8_LDB(dst, b, h) do { _Pragma("unroll") for (int n = 0; n < 2; ++n) _Pragma("unroll") for (int k = 0; k < 2; ++k) dst[n][k] = *(const LAS bf16x8*)(lds + PG8_SB(b, h) + boff + n * 2048 + k * 1024); } while (0)
#define PG8_MMA(ai, bj, At, Bt) do { __builtin_amdgcn_s_setprio(1); _Pragma("unroll") for (int m = 0; m < 4; ++m) _Pragma("unroll") for (int n = 0; n < 2; ++n) _Pragma("unroll") for (int k = 0; k < 2; ++k) \
        acc[ai][bj][m][n] = __builtin_amdgcn_mfma_f32_16x16x32_bf16(Bt[n][k], At[m][k], acc[ai][bj][m][n], 0, 0, 0); __builtin_amdgcn_s_setprio(0); } while (0)
#define PG8_WAIT_V(n) asm volatile("s_waitcnt vmcnt(" #n ")" ::: "memory")
#define PG8_WAIT_L(n) asm volatile("s_waitcnt lgkmcnt(" #n ")" ::: "memory")
#define PG8_BAR __builtin_amdgcn_s_barrier()
#define PG8_SCHED __builtin_amdgcn_sched_barrier(0)
    Unit cur, nxt; int ui = 0;
    if (!S.next(0, cur)) return;
    f32x4 acc[2][2][4][2];
#pragma unroll
    for (int a = 0; a < 2; ++a)
#pragma unroll
        for (int b = 0; b < 2; ++b)
#pragma unroll
            for (int m = 0; m < 4; ++m)
#pragma unroll
                for (int n = 0; n < 2; ++n) acc[a][b][m][n] = (f32x4){0.f, 0.f, 0.f, 0.f};
    bf16x8 At[4][2], B0[2][2], B1[2][2];
    const char* cA = (const char*)g.A + (ZB ? (size_t)cur.z * g.zsA : (size_t)0) + (size_t)cur.pm * tstepA; const char* cB = (const char*)g.Bt + (ZB ? (size_t)cur.z * g.zsB : (size_t)0) + (size_t)cur.pn * tstepB;
    if constexpr (SP2) {
        PG8_STAGE(PG8_SB(0, 0), cB, voffB); PG8_STAGE(PG8_SB(0, 1), cB + hstepB, voffB); PG8_STAGE(PG8_SA(0, 0), cA, voffA); PG8_STAGE(PG8_SA(0, 1), cA + hstepA, voffA);
        if (wr == 1) PG8_BAR;
        PG8_WAIT_V(2); PG8_BAR;
        PG8_STAGE(PG8_SB(1, 0), cB + kstep, voffB); PG8_STAGE(PG8_SA(1, 0), cA + kstep, voffA); PG8_STAGE(PG8_SB(1, 1), cB + hstepB + kstep, voffB);
        PG8_WAIT_V(6); PG8_BAR;
    } else {
        PG8_STAGE(PG8_SB(0, 0), cB, voffB); PG8_STAGE(PG8_SA(0, 0), cA, voffA); PG8_STAGE(PG8_SB(0, 1), cB + hstepB, voffB); PG8_STAGE(PG8_SA(0, 1), cA + hstepA, voffA);
        if (wr == 1) PG8_BAR;
        PG8_WAIT_V(4); PG8_BAR;
        PG8_STAGE(PG8_SB(1, 0), cB + kstep, voffB); PG8_STAGE(PG8_SA(1, 0), cA + kstep, voffA); PG8_STAGE(PG8_SB(1, 1), cB + hstepB + kstep, voffB);
        PG8_WAIT_V(6); PG8_BAR;
    }
    for (;;) {
        const bool has_next = S.next(ui + 1, nxt);
        const char* nA = has_next ? (const char*)g.A + (ZB ? (size_t)nxt.z * g.zsA : (size_t)0) + (size_t)nxt.pm * tstepA : cA; const char* nB = has_next ? (const char*)g.Bt + (ZB ? (size_t)nxt.z * g.zsB : (size_t)0) + (size_t)nxt.pn * tstepB : cB;
        for (int t = 0; t < nt; t += 2) {
            const bool last = (t == nt - 2);
            const char* a1 = cA + (size_t)(t + 1) * kstep;
            const char* a2 = last ? nA : cA + (size_t)(t + 2) * kstep; const char* b2 = last ? nB : cB + (size_t)(t + 2) * kstep;
            const char* a3 = a2 + kstep; const char* b3 = b2 + kstep;
            if constexpr (SP2) {
            PG8_LDB(B0, 0, 0); PG8_LDB(B1, 0, 1); PG8_SCHED; PG8_LDA(At, 0, 0); PG8_STAGE(PG8_SA(1, 1), a1 + hstepA, voffA);
            PG8_WAIT_V(8); PG8_WAIT_L(0); PG8_BAR; PG8_MMA(0, 0, At, B0); PG8_MMA(0, 1, At, B1); PG8_BAR; PG8_SCHED;
            PG8_LDA(At, 0, 1); PG8_STAGE(PG8_SB(0, 0), b2, voffB); PG8_STAGE(PG8_SB(0, 1), b2 + hstepB, voffB); PG8_STAGE(PG8_SA(0, 0), a2, voffA);
            PG8_WAIT_V(8); PG8_WAIT_L(0); PG8_BAR; PG8_MMA(1, 0, At, B0); PG8_MMA(1, 1, At, B1); PG8_BAR; PG8_SCHED;
            PG8_LDB(B0, 1, 0); PG8_LDB(B1, 1, 1); PG8_SCHED; PG8_LDA(At, 1, 0); PG8_STAGE(PG8_SA(0, 1), a2 + hstepA, voffA);
            PG8_WAIT_V(8); PG8_WAIT_L(0); PG8_BAR; PG8_MMA(0, 0, At, B0); PG8_MMA(0, 1, At, B1); PG8_BAR; PG8_SCHED;
            PG8_LDA(At, 1, 1); PG8_STAGE(PG8_SB(1, 0), b3, voffB); PG8_STAGE(PG8_SB(1, 1), b3 + hstepB, voffB); PG8_STAGE(PG8_SA(1, 0), a3, voffA);
            PG8_WAIT_V(8); PG8_WAIT_L(0); PG8_BAR; PG8_MMA(1, 0, At, B0); PG8_MMA(1, 1, At, B1); PG8_BAR; PG8_SCHED;
            } else {
            PG8_LDB(B0, 0, 0); PG8_SCHED; PG8_LDA(At, 0, 0); PG8_STAGE(PG8_SA(1, 1), a1 + hstepA, voffA);
            PG8_WAIT_L(8); PG8_BAR; PG8_WAIT_L(0); PG8_MMA(0, 0, At, B0); PG8_BAR; PG8_SCHED;
            PG8_LDB(B1, 0, 1); PG8_STAGE(PG8_SB(0, 0), b2, voffB);
            PG8_BAR; PG8_WAIT_L(0); PG8_MMA(0, 1, At, B1); PG8_BAR;
            PG8_LDA(At, 0, 1); PG8_STAGE(PG8_SA(0, 0), a2, voffA);
            PG8_BAR; PG8_WAIT_L(0); PG8_MMA(1, 0, At, B0); PG8_BAR; PG8_SCHED;
            PG8_STAGE(PG8_SB(0, 1), b2 + hstepB, voffB);
            PG8_WAIT_V(6); PG8_BAR; PG8_MMA(1, 1, At, B1); PG8_BAR;
            PG8_LDB(B0, 1, 0); PG8_SCHED; PG8_LDA(At, 1, 0); PG8_STAGE(PG8_SA(0, 1), a2 + hstepA, voffA);
            PG8_WAIT_L(8); PG8_BAR; PG8_WAIT_L(0); PG8_MMA(0, 0, At, B0); PG8_BAR; PG8_SCHED;
            PG8_LDB(B1, 1, 1); PG8_STAGE(PG8_SB(1, 0), b3, voffB);
            PG8_BAR; PG8_WAIT_L(0); PG8_MMA(0, 1, At, B1); PG8_BAR;
            PG8_LDA(At, 1, 1); PG8_STAGE(PG8_SA(1, 0), a3, voffA);
            PG8_BAR; PG8_WAIT_L(0); PG8_MMA(1, 0, At, B0); PG8_BAR; PG8_SCHED;
            PG8_STAGE(PG8_SB(1, 1), b3 + hstepB, voffB);
            PG8_WAIT_V(6); PG8_BAR; PG8_MMA(1, 1, At, B1); PG8_BAR;
            }
        }
        if constexpr (ALIGN_EPI) { if (wr == 0) PG8_BAR; }
        { const int lane_e = (int)__builtin_amdgcn_mbcnt_hi(~0u, __builtin_amdgcn_mbcnt_lo(~0u, 0u)); E(acc, cur, wr, wc, lane_e); }
        if constexpr (Epi::HAS_DONE) E.done(cur, lds, tid, wid);
        if (!has_next) break;
#pragma unroll
        for (int a = 0; a < 2; ++a)
#pragma unroll
            for (int b = 0; b < 2; ++b)
#pragma unroll
                for (int m = 0; m < 4; ++m)
#pragma unroll
                    for (int n = 0; n < 2; ++n) acc[a][b][m][n] = (f32x4){0.f, 0.f, 0.f, 0.f};
        cur = nxt; cA = nA; cB = nB; ++ui;
        if constexpr (ALIGN_EPI) { if (wr == 1) PG8_BAR; }
    }
    PG8_WAIT_V(0);
    if constexpr (!ALIGN_EPI) { if (wr == 0) PG8_BAR; }
    PG8_BAR;
#undef PG8_SA
#undef PG8_SB
#undef PG8_STAGE
#undef PG8_LDA
#undef PG8_LDB
#undef PG8_MMA
#undef PG8_WAIT_V
#undef PG8_WAIT_L
#undef PG8_BAR
#undef PG8_SCHED
}

typedef f32x4 Acc[2][2][4][2];

struct EpiSwiGLU {
    static constexpr bool PERM = true, HAS_DONE = false;
    bf16_t* G;
    __device__ __forceinline__ void operator()(const Acc& acc, const Unit& u, int wr, int wc, int lane) const {
        asm volatile("" : "+v"(lane)); const int fr = lane & 15, fq = lane >> 4;
        const int row0 = u.pm * BM + wr * 64 + fr, col0 = u.pn * 128 + wc * 32 + 8 * fq;
#pragma unroll
        for (int ai = 0; ai < 2; ++ai)
#pragma unroll
            for (int m = 0; m < 4; ++m) {
                const f32x4 g0 = acc[ai][0][m][0], g1 = acc[ai][0][m][1], u0 = acc[ai][1][m][0], u1 = acc[ai][1][m][1];
                u32x4 w;
                w.x = pk2(silu_f(g0[0]) * u0[0], silu_f(g0[1]) * u0[1]); w.y = pk2(silu_f(g0[2]) * u0[2], silu_f(g0[3]) * u0[3]);
                w.z = pk2(silu_f(g1[0]) * u1[0], silu_f(g1[1]) * u1[1]); w.w = pk2(silu_f(g1[2]) * u1[2], silu_f(g1[3]) * u1[3]);
                *(u32x4*)(G + (size_t)(row0 + ai * HALF + m * 16) * DFF + col0) = w;
            }
    }
};

struct EpiF32 {
    static constexpr bool PERM = false, HAS_DONE = false;
    float* Y; int ldc; size_t zs;
    __device__ __forceinline__ void operator()(const Acc& acc, const Unit& u, int wr, int wc, int lane) const {
        asm volatile("" : "+v"(lane)); const int fr = lane & 15, fq = lane >> 4;
        float* base = Y + (size_t)u.z * zs;
        const int row0 = u.pm * BM + wr * 64 + fr, col0 = u.pn * BM + wc * 32 + 4 * fq;
#pragma unroll
        for (int ai = 0; ai < 2; ++ai)
#pragma unroll
            for (int m = 0; m < 4; ++m) { float* rp = base + (size_t)(row0 + ai * HALF + m * 16) * ldc + col0;
#pragma unroll
                for (int bj = 0; bj < 2; ++bj)
#pragma unroll
                    for (int n = 0; n < 2; ++n) *(f32x4*)(rp + bj * HALF + n * 16) = acc[ai][bj][m][n]; }
    }
};

struct EpiBf16Y {
    static constexpr bool PERM = true, HAS_DONE = false;
    bf16_t* Y; bf16_t* Yz1;
    __device__ __forceinline__ void operator()(const Acc& acc, const Unit& u, int wr, int wc, int lane) const {
        asm volatile("" : "+v"(lane)); const int fr = lane & 15, fq = lane >> 4;
        const int row0 = u.pm * BM + wr * 64 + fr, col0 = u.pn * BM + wc * 32 + 8 * fq;
        bf16_t* Yb = u.z ? Yz1 : Y;
#pragma unroll
        for (int ai = 0; ai < 2; ++ai)
#pragma unroll
            for (int m = 0; m < 4; ++m) { bf16_t* rp = Yb + (size_t)(row0 + ai * HALF + m * 16) * DM + col0;
#pragma unroll
                for (int bj = 0; bj < 2; ++bj) { const f32x4 a0 = acc[ai][bj][m][0], a1 = acc[ai][bj][m][1];
                    *(u32x4*)(rp + bj * HALF) = (u32x4){pk2(a0[0], a0[1]), pk2(a0[2], a0[3]), pk2(a1[0], a1[1]), pk2(a1[2], a1[3])}; } }
    }
};

struct EpiBf16YQ {
    static constexpr bool PERM = true, HAS_DONE = true;
    bf16_t* Y; bf16_t* Yz1; unsigned* ctl; CArgs* ap; int pm_off, need, total, l, which; bool y2;
    __device__ __forceinline__ void operator()(const Acc& acc, const Unit& u, int wr, int wc, int lane) const {
        asm volatile("" : "+v"(lane)); const int fr = lane & 15, fq = lane >> 4;
        const int row0 = u.pm * BM + wr * 64 + fr, col0 = u.pn * BM + wc * 32 + 8 * fq;
        bf16_t* Yb = u.z ? Yz1 : Y;
#pragma unroll
        for (int ai = 0; ai < 2; ++ai)
#pragma unroll
            for (int m = 0; m < 4; ++m) { bf16_t* rp = Yb + (size_t)(row0 + ai * HALF + m * 16) * DM + col0;
#pragma unroll
                for (int bj = 0; bj < 2; ++bj) { const f32x4 a0 = acc[ai][bj][m][0], a1 = acc[ai][bj][m][1];
                    *(u32x4*)(rp + bj * HALF) = (u32x4){pk2(a0[0], a0[1]), pk2(a0[2], a0[3]), pk2(a1[0], a1[1]), pk2(a1[2], a1[3])}; } }
    }
    __device__ __forceinline__ void done(const Unit& u, LAS unsigned char* lds, int tid, int wid) const {
        asm volatile("s_waitcnt vmcnt(0)" ::: "memory");
        __builtin_amdgcn_s_barrier();
        LAS int* lflag = (LAS int*)(lds + LDS_FLAG_OFF);
        if (tid == 0) {
            __builtin_amdgcn_fence(__ATOMIC_RELEASE, "agent");
            asm volatile("s_waitcnt vmcnt(0)" ::: "memory");
            const int pmg = pm_off + u.pm;
            const unsigned old = __hip_atomic_fetch_add(ctl + Q_CNT + pmg, 1u, RLXA);
            if (old + 1u == (unsigned)need) { const unsigned slot = __hip_atomic_fetch_add(ctl + Q_TAIL, 1u, RLXA); __hip_atomic_store(ctl + Q_QUEUE + slot, (unsigned)pmg + 1u, RLXA); }
            const int item = rowq_step(ctl, total, (LAS int*)(lds + LDS_PEND_OFF));
            if (item >= 0) { __builtin_amdgcn_fence(__ATOMIC_ACQUIRE, "agent"); asm volatile("s_waitcnt vmcnt(0)" ::: "memory"); }
            *lflag = item;
        }
        asm volatile("s_waitcnt lgkmcnt(0)" ::: "memory");
        __builtin_amdgcn_s_barrier();
        const int it = __builtin_amdgcn_readfirstlane(*lflag);
        if (it >= 0) { int lane = (int)__builtin_amdgcn_mbcnt_hi(~0u, __builtin_amdgcn_mbcnt_lo(~0u, 0u)); asm volatile("" : "+v"(lane)); rowwise_quarter(ap, l, which, y2, it >> 2, it & 3, wid, lane); }
    }
};

struct EpiWin {
    static constexpr bool PERM = false, HAS_DONE = false;
    bf16_t *Q, *Kb, *VT, *SSMA, *CZ; const f32x2* CS;
    __device__ __forceinline__ void operator()(const Acc& acc, const Unit& u, int wr, int wc, int lane) const {
        asm volatile("" : "+v"(lane)); const int fr = lane & 15, fq = lane >> 4;
        const int pn = u.pn; const bool isctx = u.pm >= (ML / BM);
        f32x4 cc = {1.f, 1.f, 1.f, 1.f}, ss = {0.f, 0.f, 0.f, 0.f};
#pragma unroll
        for (int ai = 0; ai < 2; ++ai)
#pragma unroll
            for (int m = 0; m < 4; ++m) {
                const int r = u.pm * BM + ai * HALF + wr * 64 + m * 16 + fr;
                int b, pos;
                if (!isctx) { b = r >> 12; pos = r & 4095; } else { const int rc = r - ML; b = rc >> 8; pos = rc & 255; }
                if (pn <= 2 && !isctx) {
                    const int v = (wc & 1) ? (pos & 63) : (pos >> 6);
                    const f32x2* t = CS + v * 16 + 4 * fq;
                    const f32x2 t0 = t[0], t1 = t[1], t2 = t[2], t3 = t[3];
                    cc = (f32x4){t0.x, t1.x, t2.x, t3.x}; ss = (f32x4){t0.y, t1.y, t2.y, t3.y};
                }
#pragma unroll
                for (int bj = 0; bj < 2; ++bj) {
                    const f32x4 a0 = acc[ai][bj][m][0], a1 = acc[ai][bj][m][1];
                    const int cl = 128 * bj + 32 * wc + 4 * fq;
                    if (pn <= 1) {
                        f32x4 o0, o1;
                        if (!isctx) { o0 = a0 * cc - a1 * ss; o1 = a1 * cc + a0 * ss; } else { o0 = a0; o1 = a1; }
                        o0 = o0 * QSCALE; o1 = o1 * QSCALE;
                        bf16_t* p = Q + (size_t)r * 512 + pn * 256 + cl;
                        *(u32x2*)p = (u32x2){pk2(o0[0], o0[1]), pk2(o0[2], o0[3])}; *(u32x2*)(p + 16) = (u32x2){pk2(o1[0], o1[1]), pk2(o1[2], o1[3])};
                    } else if (pn == 2) {
                        if (bj == 0) {
                            f32x4 o0, o1;
                            if (!isctx) { o0 = a0 * cc - a1 * ss; o1 = a1 * cc + a0 * ss; } else { o0 = a0; o1 = a1; }
                            bf16_t* p = Kb + (size_t)r * 128 + 32 * wc + 4 * fq;
                            *(u32x2*)p = (u32x2){pk2(o0[0], o0[1]), pk2(o0[2], o0[3])}; *(u32x2*)(p + 16) = (u32x2){pk2(o1[0], o1[1]), pk2(o1[2], o1[3])};
                        } else {
                            const int vc = 32 * wc + 4 * fq;
                            const int pidx = isctx ? (SEQL + pos) : pos;
                            bf16_t* p = VT + ((size_t)(b * 2 + (vc >> 6)) * 64 + (vc & 63)) * VTP + pidx;
#pragma unroll
                            for (int j = 0; j < 4; ++j) { p[(size_t)j * VTP] = f2bf(a0[j]); p[(size_t)(j + 16) * VTP] = f2bf(a1[j]); }
                        }
                    } else if (pn == 3) {
                        const int g0 = 8 * bj + 2 * wc;
                        bf16_t* p = SSMA + ((size_t)g0 * NCHUNK + (r >> 4)) * 512 + (r & 15) * 16 + 4 * fq;
                        *(u32x2*)p = (u32x2){pk2(a0[0], a0[1]), pk2(a0[2], a0[3])};
                        *(u32x2*)(p + (size_t)NCHUNK * 512) = (u32x2){pk2(a1[0], a1[1]), pk2(a1[2], a1[3])};
                    } else {
                        bf16_t* p = CZ + (size_t)r * 768 + (pn - 4) * 256 + cl;
                        *(u32x2*)p = (u32x2){pk2(a0[0], a0[1]), pk2(a0[2], a0[3])}; *(u32x2*)(p + 16) = (u32x2){pk2(a1[0], a1[1]), pk2(a1[2], a1[3])};
                    }
                }
            }
    }
};

struct EpiSsmOut {
    static constexpr bool PERM = false, HAS_DONE = false;
    bf16_t* YG;
    __device__ __forceinline__ void operator()(const Acc& acc, const Unit& u, int wr, int wc, int lane) const {
        asm volatile("" : "+v"(lane)); const int fr = lane & 15, fq = lane >> 4;
#pragma unroll
        for (int ai = 0; ai < 2; ++ai)
#pragma unroll
            for (int m = 0; m < 4; ++m) {
                const int r = u.pm * BM + ai * HALF + wr * 64 + m * 16 + fr;
#pragma unroll
                for (int bj = 0; bj < 2; ++bj)
#pragma unroll
                    for (int n = 0; n < 2; ++n) {
                        const int t = 8 * bj + 2 * wc + n; const f32x4 a = acc[ai][bj][m][n];
                        bf16_t* p = YG + (size_t)(r * 16 + t) * 256 + u.z * 16 + 4 * fq;
                        *(u32x2*)p = (u32x2){pk2(gelu_tanh_f(a[0]), gelu_tanh_f(a[1])), pk2(gelu_tanh_f(a[2]), gelu_tanh_f(a[3]))};
                    }
            }
    }
};

struct EpiGlu {
    static constexpr bool PERM = true, HAS_DONE = false;
    const bf16_t* YG; const float* bias; bf16_t* MIX;
    __device__ __forceinline__ void operator()(const Acc& acc, const Unit& u, int wr, int wc, int lane) const {
        asm volatile("" : "+v"(lane)); const int fr = lane & 15, fq = lane >> 4;
        const int row0 = u.pm * BM + wr * 64 + fr;
#pragma unroll
        for (int bj = 0; bj < 2; ++bj) {
            const int col0 = bj * HALF + wc * 32 + 8 * fq;
            const f32x4 b0 = *(const f32x4*)(bias + col0), b1 = *(const f32x4*)(bias + col0 + 4);
#pragma unroll
            for (int ai = 0; ai < 2; ++ai)
#pragma unroll
                for (int m = 0; m < 4; ++m) {
                    const size_t r = (size_t)(row0 + ai * HALF + m * 16);
                    const u32x4 gv = *(const u32x4*)(YG + r * 256 + col0);
                    const f32x4 a0 = acc[ai][bj][m][0] + b0, a1 = acc[ai][bj][m][1] + b1;
                    float gg[8];
                    gg[0] = bf2f((unsigned short)(gv.x & 0xffff)); gg[1] = bf2f((unsigned short)(gv.x >> 16)); gg[2] = bf2f((unsigned short)(gv.y & 0xffff)); gg[3] = bf2f((unsigned short)(gv.y >> 16));
                    gg[4] = bf2f((unsigned short)(gv.z & 0xffff)); gg[5] = bf2f((unsigned short)(gv.z >> 16)); gg[6] = bf2f((unsigned short)(gv.w & 0xffff)); gg[7] = bf2f((unsigned short)(gv.w >> 16));
                    u32x4 w;
                    w.x = pk2(gg[0] * sigmoid_f(a0[0]), gg[1] * sigmoid_f(a0[1])); w.y = pk2(gg[2] * sigmoid_f(a0[2]), gg[3] * sigmoid_f(a0[3]));
                    w.z = pk2(gg[4] * sigmoid_f(a1[0]), gg[5] * sigmoid_f(a1[1])); w.w = pk2(gg[6] * sigmoid_f(a1[2]), gg[7] * sigmoid_f(a1[3]));
                    *(u32x4*)(MIX + r * 1024 + 512 + col0) = w;
                }
        }
    }
};
}

constexpr int NWAVES = 8, NTHR = 512;
constexpr int NPHASES = 3 + 10 * DEPTH;
constexpr int LDS_BYTES = 147456;

struct InView { CArgs* ap; __device__ __forceinline__ const float* operator[](int i) const { return ap->in[i]; } };
struct Ctx {
    LAS unsigned char* lds;
    int tid, lane, wave, G, bid;
    InView in;
    float* out; unsigned char* ws;
};

__device__ __forceinline__ float* xrow_ptr(const Ctx& F, int r) { return r < ML ? F.out + (size_t)r * DM : (float*)(F.ws + WS_XC) + (size_t)(r - ML) * DM; }

__device__ __forceinline__ void transpose_item(const float* W, int Nsrc, int k0, int n0, bf16_t* WT, int Kd, int drow0, LAS float* scr, int lane) {
#pragma unroll 8
    for (int i = 0; i < 32; ++i) { const int kk = 2 * i + (lane >> 5); scr[kk * 33 + (lane & 31)] = W[(size_t)(k0 + kk) * Nsrc + n0 + (lane & 31)]; }
    asm volatile("s_waitcnt lgkmcnt(0)" ::: "memory");
    const int c = lane & 7;
#pragma unroll
    for (int j = 0; j < 4; ++j) { const int n = (lane >> 3) + 8 * j; const LAS float* s = scr + (8 * c) * 33 + n;
        u32x4 o; o.x = pk2(s[0 * 33], s[1 * 33]); o.y = pk2(s[2 * 33], s[3 * 33]); o.z = pk2(s[4 * 33], s[5 * 33]); o.w = pk2(s[6 * 33], s[7 * 33]);
        *(u32x4*)(WT + (size_t)(drow0 + n) * Kd + k0 + 8 * c) = o; }
    asm volatile("s_waitcnt lgkmcnt(0)" ::: "memory");
}

__device__ __forceinline__ void phase_prologue(const Ctx& F) {
    const float* c_in = F.in[1]; const float* cctx = F.in[3]; const float* w_ada = F.in[4];
    {
        LAS float* sl = (LAS float*)F.lds;
        float* MODP = (float*)(F.ws + WS_MODP);
        for (int item = F.bid; item < 576; item += F.G) {
            const int l = item / 144, r2 = item % 144, kq = r2 / 18, nb = r2 % 18;
            __syncthreads();
            for (int idx = F.tid; idx < 17 * 128; idx += NTHR) { const int rr = idx >> 7, kk = idx & 127; const float v = rr < 16 ? c_in[rr * DM + kq * 128 + kk] : cctx[kq * 128 + kk]; sl[idx] = v / (1.0f + exp_f(-v)); }
            __syncthreads();
            const int n = nb * 512 + F.tid;
            float acc[17];
#pragma unroll
            for (int r = 0; r < 17; ++r) acc[r] = 0.f;
            const float* wp = w_ada + ((size_t)l * DM + kq * 128) * NMOD + n;
            for (int k0 = 0; k0 < 128; k0 += 16) {
                float w[16];
#pragma unroll
                for (int k = 0; k < 16; ++k) w[k] = __builtin_nontemporal_load(wp + (size_t)(k0 + k) * NMOD);
#pragma unroll
                for (int k = 0; k < 16; ++k) {
#pragma unroll
                    for (int r = 0; r < 17; ++r) acc[r] += sl[r * 128 + k0 + k] * w[k]; }
            }
#pragma unroll
            for (int r = 0; r < 17; ++r) MODP[(((size_t)kq * 4 + l) * 17 + r) * NMOD + n] = acc[r];
        }
        __syncthreads();
    }
    {
        LAS float* scr = (LAS float*)(F.lds + F.wave * 16384);
        const int gw = F.bid * NWAVES + F.wave, NGW = F.G * NWAVES;
        bf16_t* WGU = (bf16_t*)(F.ws + WS_WGU); bf16_t* WD = (bf16_t*)(F.ws + WS_WD); bf16_t* WIN = (bf16_t*)(F.ws + WS_WIN); bf16_t* WOUT = (bf16_t*)(F.ws + WS_WOUT); bf16_t* WGLU = (bf16_t*)(F.ws + WS_WGLU);
        constexpr int I_GU = 16 * 88, I_D = 44 * 32, I_IN = 16 * 56, I_OUT = 16 * 32, I_GLU = 4 * 8;
        constexpr int NITEMS = I_GU * 16 + I_D * 8 + I_IN * 4 + I_OUT * 4 + I_GLU * 4;
        for (int it = gw; it < NITEMS; it += NGW) {
            int r = it;
            if (r < I_GU * 16) { const int up = r / (I_GU * 8); r -= up * I_GU * 8; const int ls = r / I_GU; r %= I_GU; const int kb = r / 88, nb = r % 88, n0 = nb * 32;
                transpose_item(F.in[up ? 9 : 8] + (size_t)ls * DM * DFF, DFF, kb * 64, n0, WGU + (size_t)ls * 5632 * DM, DM, (n0 / 128) * 256 + (n0 % 128) + up * 128, scr, F.lane); continue; }
            r -= I_GU * 16;
            if (r < I_D * 8) { const int ls = r / I_D; r %= I_D; const int kb = r / 32, nb = r % 32;
                transpose_item(F.in[10] + (size_t)ls * DFF * DM, DM, kb * 64, nb * 32, WD + (size_t)ls * DM * DFF, DFF, nb * 32, scr, F.lane); continue; }
            r -= I_D * 8;
            if (r < I_IN * 4) { const int l = r / I_IN; r %= I_IN; const int kb = r / 56, nb = r % 56;
                transpose_item(F.in[11] + (size_t)l * DM * INC, INC, kb * 64, nb * 32, WIN + (size_t)l * INC * DM, DM, nb * 32, scr, F.lane); continue; }
            r -= I_IN * 4;
            if (r < I_OUT * 4) { const int l = r / I_OUT; r %= I_OUT; const int kb = r / 32, nb = r % 32;
                transpose_item(F.in[12] + (size_t)l * DM * DM, DM, kb * 64, nb * 32, WOUT + (size_t)l * DM * DM, DM, nb * 32, scr, F.lane); continue; }
            r -= I_OUT * 4;
            { const int l = r / I_GLU; r %= I_GLU; const int kb = r / 8, nb = r % 8;
                transpose_item(F.in[22] + (size_t)l * 256 * 256, 256, kb * 64, nb * 32, WGLU + (size_t)l * 256 * 256, 256, nb * 32, scr, F.lane); }
        }
    }
    const int gt = F.bid * NTHR + F.tid;
    if (gt < 12 * Q_SLOT_WORDS) ((unsigned*)(F.ws + WS_CTL))[gt] = 0u;
    if (gt < 1024) {
        const int v = gt >> 4, i = gt & 15;
        const float inv = __builtin_amdgcn_exp2f(-13.287712379549449f * (float)i * 0.0625f);
        float rev = (float)v * inv * 0.15915494309189535f; rev -= __builtin_rintf(rev);
        ((f32x2*)(F.ws + WS_CS))[gt] = (f32x2){__builtin_amdgcn_cosf(rev), __builtin_amdgcn_sinf(rev)};
    }
    if (gt >= 1024 && gt < 1024 + 8192) {
        const int id = gt - 1024, ldg = id >> 6, p = id & 63;
        const float lr = F.in[14][id], li = F.in[15][id]; const float dt = exp_f(F.in[16][ldg]);
        f32x2* AP = (f32x2*)(F.ws + WS_APOW) + (size_t)ldg * 17 * 64 + p;
        float a1r = 1.f, a1i = 0.f;
        for (int n = 0; n <= 16; ++n) {
            const float mag = exp_f((float)n * lr * dt);
            double a = (double)n * (double)li * (double)dt * 0.15915494309189535; a -= rint(a);
            const float rev = (float)a; const float cr = mag * __builtin_amdgcn_cosf(rev), ci = mag * __builtin_amdgcn_sinf(rev);
            AP[n * 64] = (f32x2){cr, ci};
            if (n == 1) { a1r = cr; a1i = ci; }
        }
        const float den = lr * lr + li * li;
        const float gr = ((a1r - 1.f) * lr + a1i * li) / den, gi = (a1i * lr - (a1r - 1.f) * li) / den;
        f32x2* BB = (f32x2*)(F.ws + WS_BBAR) + (size_t)id * 16;
        for (int h = 0; h < 16; ++h) { const float br = F.in[17][(size_t)id * 16 + h], bi = F.in[18][(size_t)id * 16 + h]; BB[h] = (f32x2){gr * br - gi * bi, gr * bi + gi * br}; }
    }
}

__device__ __forceinline__ float ssm_kval(const Ctx& F, int ldg, int tau, int h, int h2) {
    const float* cr = F.in[19] + ((size_t)ldg * 16 + h) * 64; const float* ci = F.in[20] + ((size_t)ldg * 16 + h) * 64;
    const f32x2* AP = (const f32x2*)(F.ws + WS_APOW) + ((size_t)ldg * 17 + tau) * 64;
    const f32x2* BB = (const f32x2*)(F.ws + WS_BBAR) + (size_t)ldg * 64 * 16 + h2;
    float s = 0.f;
    for (int p = 0; p < 64; ++p) { const f32x2 a = AP[p], b = BB[p * 16]; const float c_r = cr[p], c_i = ci[p];
        const float er = c_r * a.x - c_i * a.y, ei = c_r * a.y + c_i * a.x; s += er * b.x - ei * b.y; }
    return s;
}
__device__ __forceinline__ void phase_prologue2(const Ctx& F) {
    const int gt = F.bid * NTHR + F.tid, NT = F.G * NTHR;
    float* MOD = (float*)(F.ws + WS_MOD); const float* MODP = (const float*)(F.ws + WS_MODP);
    for (int idx = gt; idx < 4 * 17 * NMOD; idx += NT) {
        const int l = idx / (17 * NMOD), n = idx % NMOD;
        float s = F.in[5][l * NMOD + n];
#pragma unroll
        for (int kq = 0; kq < 8; ++kq) s += MODP[(size_t)kq * 4 * 17 * NMOD + idx];
        MOD[idx] = s;
    }
    float* KT = (float*)(F.ws + WS_KT);
    for (int idx = gt; idx < 4 * 2 * 16 * 16 * 256; idx += NT) {
        const int h2 = idx & 15, h = (idx >> 4) & 15, tau = (idx >> 8) & 15, g = (idx >> 12) & 15, dir = (idx >> 16) & 1, l = idx >> 17;
        KT[idx] = ssm_kval(F, (l * 2 + dir) * 16 + g, tau, h, h2);
    }
    bf16_t* SST = (bf16_t*)(F.ws + WS_SST);
    for (int idx = gt; idx < 4 * 16 * 256 * 256; idx += NT) {
        const int k = idx & 255, n = (idx >> 8) & 255, g = (idx >> 16) & 15, l = idx >> 20;
        const int dir = n >> 7, ri = (n >> 6) & 1, p = n & 63, j = k >> 4, h2 = k & 15, pw = dir == 0 ? 15 - j : j, ldg = (l * 2 + dir) * 16 + g;
        const f32x2 a = ((const f32x2*)(F.ws + WS_APOW))[((size_t)ldg * 17 + pw) * 64 + p];
        const f32x2 b = ((const f32x2*)(F.ws + WS_BBAR))[((size_t)ldg * 64 + p) * 16 + h2];
        SST[idx] = f2bf(ri == 0 ? (a.x * b.x - a.y * b.y) : (a.x * b.y + a.y * b.x));
    }
}
__device__ __forceinline__ void phase_prologue3(const Ctx& F) {
    const int gt = F.bid * NTHR + F.tid, NT = F.G * NTHR;
    bf16_t* SOUT = (bf16_t*)(F.ws + WS_SOUT); const float* KT = (const float*)(F.ws + WS_KT);
    for (int idx = gt; idx < 4 * 16 * 256 * 512; idx += NT) {
        const int k = idx & 511, row = (idx >> 9) & 255, g = (idx >> 17) & 15, l = idx >> 21, t = row >> 4, h = row & 15;
        float val = 0.f;
        if (k < 256) { const int j = k >> 4, h2 = k & 15;
            if (j <= t) val += KT[(((((size_t)l * 2 + 0) * 16 + g) * 16 + (t - j)) * 16 + h) * 16 + h2];
            if (j >= t) val += KT[(((((size_t)l * 2 + 1) * 16 + g) * 16 + (j - t)) * 16 + h) * 16 + h2];
            if (j == t && h == h2) val += F.in[21][l * 256 + g * 16 + h];
        } else { const int kk = k - 256, dir = kk >> 7, ri = (kk >> 6) & 1, p = kk & 63, n = dir == 0 ? t + 1 : 16 - t, ldg = (l * 2 + dir) * 16 + g;
            const float c_r = F.in[19][((size_t)ldg * 16 + h) * 64 + p], c_i = F.in[20][((size_t)ldg * 16 + h) * 64 + p];
            const f32x2 a = ((const f32x2*)(F.ws + WS_APOW))[((size_t)ldg * 17 + n) * 64 + p];
            const float er = c_r * a.x - c_i * a.y, ei = c_r * a.y + c_i * a.x; val = ri == 0 ? er : -ei; }
        SOUT[idx] = f2bf(val);
    }
}

__device__ __forceinline__ void phase_rowwise(const Ctx& F, bool first, bool has_y, bool y2, bool write_h, int nrows, float fac,
                                              const float* gpost, const float* modg  , int gate_idx,
                                              const float* gpre, const float* modh  , int shift_idx, int scale_idx) {
    const int gw = F.bid * NWAVES + F.wave, NGW = F.G * NWAVES, lane = F.lane;
    const bf16_t* Y = (const bf16_t*)(F.ws + WS_Y); bf16_t* H = (bf16_t*)(F.ws + WS_H);
    constexpr int NR = 2;
    for (int rb = gw; rb < nrows; rb += NR * NGW) {
        f32x4 xv[NR][4], yv[NR][4]; float* xr[NR]; int b17[NR]; bool ok[NR]; int rr[NR];
#pragma unroll
        for (int k = 0; k < NR; ++k) {
            const int r0 = rb + k * NGW; ok[k] = r0 < nrows; const int r = ok[k] ? r0 : rb; rr[k] = r;
            b17[k] = r < ML ? (r >> 12) : 16; xr[k] = xrow_ptr(F, r);
            const float* xs = first ? (r < ML ? F.in[0] + (size_t)r * DM : F.in[2] + (size_t)(r - ML) * DM) : xr[k];
#pragma unroll
            for (int j = 0; j < 4; ++j) xv[k][j] = __builtin_nontemporal_load((const f32x4*)(xs + 4 * lane + 256 * j));
            if (has_y) {
#pragma unroll
                for (int j = 0; j < 4; ++j) { const u32x2 w = __builtin_nontemporal_load((const u32x2*)(Y + (size_t)r * DM + 4 * lane + 256 * j));
                    yv[k][j] = (f32x4){bf2f((unsigned short)(w.x & 0xffff)), bf2f((unsigned short)(w.x >> 16)), bf2f((unsigned short)(w.y & 0xffff)), bf2f((unsigned short)(w.y >> 16))}; }
                if (y2 && r >= ML) {
#pragma unroll
                    for (int j = 0; j < 4; ++j) { const u32x2 w = __builtin_nontemporal_load((const u32x2*)((const bf16_t*)(F.ws + WS_Y2) + (size_t)(r - ML) * DM + 4 * lane + 256 * j));
                        yv[k][j] = yv[k][j] + (f32x4){bf2f((unsigned short)(w.x & 0xffff)), bf2f((unsigned short)(w.x >> 16)), bf2f((unsigned short)(w.y & 0xffff)), bf2f((unsigned short)(w.y >> 16))}; }
                }
            }
        }
        if (has_y) {
            float s[NR];
#pragma unroll
            for (int k = 0; k < NR; ++k) { s[k] = 0.f;
#pragma unroll
                for (int j = 0; j < 4; ++j) s[k] += (yv[k][j][0] * yv[k][j][0] + yv[k][j][1] * yv[k][j][1]) + (yv[k][j][2] * yv[k][j][2] + yv[k][j][3] * yv[k][j][3]); }
#pragma unroll
            for (int o = 1; o < 64; o <<= 1) {
#pragma unroll
                for (int k = 0; k < NR; ++k) s[k] += shx(s[k], lane, o);
            }
#pragma unroll
            for (int k = 0; k < NR; ++k) { const float rs = fac * __builtin_amdgcn_rsqf(s[k] * (1.0f / DM) + EPS);
#pragma unroll
                for (int j = 0; j < 4; ++j) { const f32x4 gp = *(const f32x4*)(gpost + 4 * lane + 256 * j); const f32x4 gt = *(const f32x4*)(modg + (size_t)b17[k] * NMOD + gate_idx * DM + 4 * lane + 256 * j);
                    xv[k][j] = xv[k][j] + gt * (yv[k][j] * rs * gp); } }
        }
        if (has_y || first) {
#pragma unroll
            for (int k = 0; k < NR; ++k) if (ok[k]) {
#pragma unroll
                for (int j = 0; j < 4; ++j) __builtin_nontemporal_store(xv[k][j], (f32x4*)(xr[k] + 4 * lane + 256 * j)); }
        }
        if (write_h) {
            float s[NR];
#pragma unroll
            for (int k = 0; k < NR; ++k) { s[k] = 0.f;
#pragma unroll
                for (int j = 0; j < 4; ++j) s[k] += (xv[k][j][0] * xv[k][j][0] + xv[k][j][1] * xv[k][j][1]) + (xv[k][j][2] * xv[k][j][2] + xv[k][j][3] * xv[k][j][3]); }
#pragma unroll
            for (int o = 1; o < 64; o <<= 1) {
#pragma unroll
                for (int k = 0; k < NR; ++k) s[k] += shx(s[k], lane, o);
            }
#pragma unroll
            for (int k = 0; k < NR; ++k) if (ok[k]) { const float rs = __builtin_amdgcn_rsqf(s[k] * (1.0f / DM) + EPS);
#pragma unroll
                for (int j = 0; j < 4; ++j) { const int c0 = 4 * lane + 256 * j; const f32x4 gp = *(const f32x4*)(gpre + c0);
                    const f32x4 sh = *(const f32x4*)(modh + (size_t)b17[k] * NMOD + shift_idx * DM + c0), sc = *(const f32x4*)(modh + (size_t)b17[k] * NMOD + scale_idx * DM + c0);
                    const f32x4 hv = (xv[k][j] * rs * gp) * (sc + 1.0f) + sh;
                    *(u32x2*)(H + (size_t)rr[k] * DM + c0) = (u32x2){pk2(hv[0], hv[1]), pk2(hv[2], hv[3])}; } }
        }
    }
}

__device__ __forceinline__ int crow(int r, int hi) { return (r & 3) + 8 * (r >> 2) + 4 * hi; }
__device__ __forceinline__ void attn_tile(LAS unsigned char* lb, bool local, int kvstart, int qpos, int q, int hi, int lane, const bf16x8 (&qf)[4], float& mrun, float& lsum, f32x16 (&ot)[2]) {
    f32x16 p0, p1;
#pragma unroll
    for (int i = 0; i < 16; ++i) { p0[i] = 0.f; p1[i] = 0.f; }
#pragma unroll
    for (int s = 0; s < 4; ++s) {
        const bf16x8 a0 = *(const LAS bf16x8*)(lb + q * 144 + 32 * s + 16 * hi);
        const bf16x8 a1 = *(const LAS bf16x8*)(lb + (32 + q) * 144 + 32 * s + 16 * hi);
        p0 = __builtin_amdgcn_mfma_f32_32x32x16_bf16(a0, qf[s], p0, 0, 0, 0);
        p1 = __builtin_amdgcn_mfma_f32_32x32x16_bf16(a1, qf[s], p1, 0, 0, 0);
    }
    if (local) {
#pragma unroll
        for (int i = 0; i < 16; ++i) { const int d0 = kvstart + crow(i, hi) - qpos; if (d0 > 128 || d0 < -128) p0[i] = -1e30f; const int d1 = d0 + 32; if (d1 > 128 || d1 < -128) p1[i] = -1e30f; }
    }
    float mx = p0[0];
#pragma unroll
    for (int i = 1; i < 16; ++i) mx = fmaxf(mx, p0[i]);
#pragma unroll
    for (int i = 0; i < 16; ++i) mx = fmaxf(mx, p1[i]);
    mx = fmaxf(mx, shx(mx, lane, 32));
    const float mnew = fmaxf(mrun, mx), sc = __builtin_amdgcn_exp2f(mrun - mnew); mrun = mnew;
    float ps = 0.f;
#pragma unroll
    for (int i = 0; i < 16; ++i) { p0[i] = __builtin_amdgcn_exp2f(p0[i] - mnew); p1[i] = __builtin_amdgcn_exp2f(p1[i] - mnew); ps += p0[i] + p1[i]; }
    lsum = lsum * sc + ps;
#pragma unroll
    for (int i = 0; i < 16; ++i) { ot[0][i] *= sc; ot[1][i] *= sc; }
    bf16x8 pb[4];
#pragma unroll
    for (int ks = 0; ks < 4; ++ks) {
        u32x4 w;
        if (ks < 2) { w.x = pk2(p0[8 * ks + 0], p0[8 * ks + 1]); w.y = pk2(p0[8 * ks + 2], p0[8 * ks + 3]); w.z = pk2(p0[8 * ks + 4], p0[8 * ks + 5]); w.w = pk2(p0[8 * ks + 6], p0[8 * ks + 7]); }
        else { const int k2 = ks - 2; w.x = pk2(p1[8 * k2 + 0], p1[8 * k2 + 1]); w.y = pk2(p1[8 * k2 + 2], p1[8 * k2 + 3]); w.z = pk2(p1[8 * k2 + 4], p1[8 * k2 + 5]); w.w = pk2(p1[8 * k2 + 6], p1[8 * k2 + 7]); }
        pb[ks] = __builtin_bit_cast(bf16x8, w);
    }
#pragma unroll
    for (int dh = 0; dh < 2; ++dh)
#pragma unroll
        for (int ks = 0; ks < 4; ++ks) {
            const s16x4 lo = *(const LAS s16x4*)(lb + 9216 + (32 * dh + q) * 144 + (16 * ks + 4 * hi) * 2);
            const s16x4 h4 = *(const LAS s16x4*)(lb + 9216 + (32 * dh + q) * 144 + (16 * ks + 8 + 4 * hi) * 2);
            const bf16x8 va = __builtin_shufflevector(lo, h4, 0, 1, 2, 3, 4, 5, 6, 7);
            ot[dh] = __builtin_amdgcn_mfma_f32_32x32x16_bf16(va, pb[ks], ot[dh], 0, 0, 0);
        }
}
__device__ __forceinline__ void attn_unit(const Ctx& F, int b, int kh, int qc, const float* sink  ) {
    const bf16_t* Qb = (const bf16_t*)(F.ws + WS_Q); const bf16_t* Kb = (const bf16_t*)(F.ws + WS_K); const bf16_t* VT = (const bf16_t*)(F.ws + WS_VT); bf16_t* MIX = (bf16_t*)(F.ws + WS_H);
    LAS unsigned char* lds = F.lds;
    const int lane = F.lane, q = lane & 31, hi = lane >> 5, hq = kh * 4 + (F.wave >> 1), qs = F.wave & 1;
    const bool isctx = qc >= 64;
    int qpos; size_t qrow;
    if (!isctx) { qpos = qc * 64 + qs * 32 + q; qrow = (size_t)b * SEQL + qpos; } else { qpos = (qc - 64) * 64 + qs * 32 + q; qrow = (size_t)ML + b * NCTX + qpos; }
    const int ilo = isctx ? 0 : (qc < 2 ? 2 - qc : 0), ihi = isctx ? -1 : (65 - qc < 4 ? 65 - qc : 4), nloc = ihi - ilo + 1, nt = nloc + 4;
    const int row = F.tid >> 3, ch = F.tid & 7;
    const bf16_t* kbase = Kb + (size_t)row * 128 + kh * 64 + ch * 8;
    const bf16_t* vbase = VT + ((size_t)(b * 2 + kh) * 64 + row) * VTP + ch * 8;
#define ATT_LOAD(t, kk, vv) do { const int t_ = (t); size_t kr_; int vi_; \
        if (t_ < nloc) { const int ks_ = qc * 64 - 128 + 64 * (ilo + t_); kr_ = (size_t)b * SEQL + ks_; vi_ = ks_; } else { const int c_ = t_ - nloc; kr_ = (size_t)ML + b * NCTX + 64 * c_; vi_ = SEQL + 64 * c_; } \
        kk = *(const u32x4*)(kbase + kr_ * 128); vv = *(const u32x4*)(vbase + vi_); } while (0)
#define ATT_STORE(bo, kk, vv) do { *(LAS u32x4*)(lds + (bo) + row * 144 + ch * 16) = kk; *(LAS u32x4*)(lds + (bo) + 9216 + row * 144 + ch * 16) = vv; } while (0)
    u32x4 kA, vA, kB, vB;
    ATT_LOAD(0, kA, vA); ATT_LOAD(1, kB, vB);
    bf16x8 qf[4];
#pragma unroll
    for (int s = 0; s < 4; ++s) qf[s] = *(const bf16x8*)(Qb + qrow * 512 + hq * 64 + 16 * s + 8 * hi);
    float mrun = sink[hq] * LOG2E, lsum = hi == 0 ? 1.0f : 0.0f;
    f32x16 ot[2];
#pragma unroll
    for (int i = 0; i < 16; ++i) { ot[0][i] = 0.f; ot[1][i] = 0.f; }
    __syncthreads();
    for (int t = 0; t < nt; t += 2) {
        ATT_STORE(0, kA, vA);
        __syncthreads();
        if (t + 2 < nt) ATT_LOAD(t + 2, kA, vA);
        attn_tile(lds, t < nloc, qc * 64 - 128 + 64 * (ilo + t), qpos, q, hi, lane, qf, mrun, lsum, ot);
        if (t + 1 < nt) {
            ATT_STORE(18432, kB, vB);
            __syncthreads();
            if (t + 3 < nt) ATT_LOAD(t + 3, kB, vB);
            attn_tile(lds + 18432, t + 1 < nloc, qc * 64 - 128 + 64 * (ilo + t + 1), qpos, q, hi, lane, qf, mrun, lsum, ot);
        }
    }
#undef ATT_LOAD
#undef ATT_STORE
    lsum += shx(lsum, lane, 32);
    const float inv = 1.0f / lsum;
#pragma unroll
    for (int dh = 0; dh < 2; ++dh)
#pragma unroll
        for (int g4 = 0; g4 < 4; ++g4) {
            const int d0 = 32 * dh + 8 * g4 + 4 * hi;
            *(u32x2*)(MIX + qrow * 1024 + hq * 64 + d0) = (u32x2){pk2(ot[dh][4 * g4] * inv, ot[dh][4 * g4 + 1] * inv), pk2(ot[dh][4 * g4 + 2] * inv, ot[dh][4 * g4 + 3] * inv)};
        }
}
__device__ __forceinline__ void phase_attn(const Ctx& F, int l, bool lastl) {
    const int nq = lastl ? 64 : 68, nunits = NB * 2 * nq;
    for (int id = F.bid; id < nunits; id += F.G) { const int bk = id / nq, qc = id % nq; attn_unit(F, bk >> 1, bk & 1, qc, F.in[13] + l * 8); }
    __syncthreads();
}

__device__ __forceinline__ void unpack8(const u32x4 v, float* f) {
    f[0] = bf2f((unsigned short)(v.x & 0xffff)); f[1] = bf2f((unsigned short)(v.x >> 16)); f[2] = bf2f((unsigned short)(v.y & 0xffff)); f[3] = bf2f((unsigned short)(v.y >> 16));
    f[4] = bf2f((unsigned short)(v.z & 0xffff)); f[5] = bf2f((unsigned short)(v.z >> 16)); f[6] = bf2f((unsigned short)(v.w & 0xffff)); f[7] = bf2f((unsigned short)(v.w >> 16));
}
__device__ __forceinline__ void phase_conv(const Ctx& F, int l, int nrows) {
    const bf16_t* CZ = (const bf16_t*)(F.ws + WS_CZ); bf16_t* MIX = (bf16_t*)(F.ws + WS_H); const float* cw = F.in[24] + l * 768;
    const int gt = F.bid * NTHR + F.tid, NT = F.G * NTHR;
    for (int idx = gt; idx < nrows * 32; idx += NT) {
        const int r = idx >> 5, c0 = (idx & 31) * 8;
        int pos, len; if (r < ML) { pos = r & 4095; len = SEQL; } else { pos = (r - ML) & 255; len = NCTX; }
        const bf16_t* p = CZ + (size_t)r * 768 + c0;
        float gb[8], gc[8], z[8], tp[8], tn[8], a[8], b2[8];
        unpack8(*(const u32x4*)p, gb); unpack8(*(const u32x4*)(p + 256), gc); unpack8(*(const u32x4*)(p + 512), z);
        if (pos > 0) { unpack8(*(const u32x4*)(p - 768 + 256), a); unpack8(*(const u32x4*)(p - 768 + 512), b2);
#pragma unroll
            for (int i = 0; i < 8; ++i) tp[i] = a[i] * b2[i]; }
        else {
#pragma unroll
            for (int i = 0; i < 8; ++i) tp[i] = 0.f; }
        if (pos < len - 1) { unpack8(*(const u32x4*)(p + 768 + 256), a); unpack8(*(const u32x4*)(p + 768 + 512), b2);
#pragma unroll
            for (int i = 0; i < 8; ++i) tn[i] = a[i] * b2[i]; }
        else {
#pragma unroll
            for (int i = 0; i < 8; ++i) tn[i] = 0.f; }
        float o[8];
#pragma unroll
        for (int i = 0; i < 8; ++i) o[i] = gb[i] * (tp[i] * cw[c0 + i] + (gc[i] * z[i]) * cw[256 + c0 + i] + tn[i] * cw[512 + c0 + i]);
        *(u32x4*)(MIX + (size_t)r * 1024 + 768 + c0) = (u32x4){pk2(o[0], o[1]), pk2(o[2], o[3]), pk2(o[4], o[5]), pk2(o[6], o[7])};
    }
}

__device__ __forceinline__ int scan_chunk(int b, int dir, int step) {
    return step < 16 ? NB * 256 + b * 16 + (dir == 0 ? step : 15 - step) : b * 256 + (dir == 0 ? step - 16 : 271 - step);
}
__device__ __forceinline__ void phase_scan(const Ctx& F, int l) {
    const float* SL = (const float*)(F.ws + WS_SL); bf16_t* SSMA = (bf16_t*)(F.ws + WS_SSMA);
    LAS f32x2* sh = (LAS f32x2*)F.lds;
    for (int id = F.bid; id < 512; id += F.G) {
        const int b = id >> 5, g = (id >> 1) & 15, dir = id & 1, p = F.lane, seg = F.wave, ldg = (l * 2 + dir) * 16 + g;
        const f32x2 a16 = ((const f32x2*)(F.ws + WS_APOW))[((size_t)ldg * 17 + 16) * 64 + p];
        const float ar = a16.x, ai = a16.y;
        const size_t gbase = (size_t)g * NCHUNK;
        float xr[34], xi[34];
#pragma unroll
        for (int j = 0; j < 34; ++j) { const size_t rowc = gbase + scan_chunk(b, dir, seg * 34 + j); xr[j] = SL[rowc * 256 + dir * 128 + p]; xi[j] = SL[rowc * 256 + dir * 128 + 64 + p]; }
        float sr = 0.f, si = 0.f;
#pragma unroll
        for (int j = 0; j < 34; ++j) { const float nr = ar * sr - ai * si + xr[j], ni = ar * si + ai * sr + xi[j]; sr = nr; si = ni; }
        __syncthreads();
        sh[seg * 64 + p] = (f32x2){sr, si};
        float pr = ar, pi = ai, p2r, p2i;
        { const float tr = pr * pr - pi * pi, ti = 2.f * pr * pi; pr = tr; pi = ti; } p2r = pr; p2i = pi;
#pragma unroll
        for (int k = 0; k < 4; ++k) { const float tr = pr * pr - pi * pi, ti = 2.f * pr * pi; pr = tr; pi = ti; }
        { const float tr = pr * p2r - pi * p2i, ti = pr * p2i + pi * p2r; pr = tr; pi = ti; }
        __syncthreads();
        sr = 0.f; si = 0.f;
        for (int s2 = 0; s2 < seg; ++s2) { const f32x2 tt = sh[s2 * 64 + p]; const float nr = pr * sr - pi * si + tt.x, ni = pr * si + pi * sr + tt.y; sr = nr; si = ni; }
#pragma unroll
        for (int j = 0; j < 34; ++j) { const size_t rowc = gbase + scan_chunk(b, dir, seg * 34 + j);
            SSMA[rowc * 512 + 256 + dir * 128 + p] = f2bf(sr); SSMA[rowc * 512 + 256 + dir * 128 + 64 + p] = f2bf(si);
            const float nr = ar * sr - ai * si + xr[j], ni = ar * si + ai * sr + xi[j]; sr = nr; si = ni; }
    }
    __syncthreads();
}

#ifndef MK_MULTI
#define MK_MULTI 0
#endif
constexpr size_t WS_BAR = 195 * MiB + 131072;
constexpr int LDS_BARST_OFF = 131072 + 64;
#define XB_TMO      128
#define XB_XCNT(j)  (256  + 64 * (j))
#define XB_XSUB(j)  (1280 + 64 * (j))
#define XB_XGEN(j)  (2304 + 64 * (j))
#define XB_TOP      3328
#define XB_TOPGEN   3392
#define XCD_BAR_WORDS 3456
#define XB_SPIN_CAP (1u << 20)
__device__ __forceinline__ unsigned xb_ld(unsigned* p)              { return __hip_atomic_load(p, __ATOMIC_RELAXED, __HIP_MEMORY_SCOPE_AGENT); }
__device__ __forceinline__ unsigned xb_add(unsigned* p, unsigned v) { return __hip_atomic_fetch_add(p, v, __ATOMIC_RELAXED, __HIP_MEMORY_SCOPE_AGENT); }
__device__ __forceinline__ unsigned xb_xcc_id() { return (unsigned)__builtin_amdgcn_s_getreg((3 << 11) | 20) & 0xFu; }
#define XB_SPIN(cond, bar) do { unsigned _sp = 0; while (cond) { __builtin_amdgcn_s_sleep(1); \
    if ((++_sp & 255u) == 0u) { if (xb_ld(&(bar)[XB_TMO])) break; if (_sp > XB_SPIN_CAP) { atomicAdd(&(bar)[XB_TMO], 1u); break; } } } } while (0)
struct XcdBarrier { unsigned* bar; unsigned x; volatile LAS unsigned* st; };
__device__ __forceinline__ void xcd_barrier_complete(unsigned* bar, unsigned x, unsigned& nloc, unsigned& nx) {
    const unsigned G = gridDim.x * gridDim.y * gridDim.z;
    unsigned sum, cnt, mine, sp = 0u;
    for (;;) {
        sum = 0u; cnt = 0u; mine = 0u;
#pragma unroll
        for (unsigned j = 0; j < 16; ++j) { const unsigned c = xb_ld(&bar[XB_XCNT(j)]); sum += c; cnt += (c > 0u) ? 1u : 0u; mine = (j == x) ? c : mine; }
        if (sum == G) break;
        __builtin_amdgcn_s_sleep(1);
        if ((++sp & 255u) == 0u) { if (xb_ld(&bar[XB_TMO])) break; if (sp > XB_SPIN_CAP) { atomicAdd(&bar[XB_TMO], 1u); break; } }
    }
    nloc = mine > 0u ? mine : 1u; nx = cnt > 0u ? cnt : 1u;
}
__device__ __forceinline__ void xcd_barrier(const XcdBarrier& b, int tid) {
    asm volatile("s_waitcnt vmcnt(0)" ::: "memory");
    __syncthreads();
    if (tid == 0) {
        unsigned* bar = b.bar;
        __builtin_amdgcn_s_waitcnt(0);
        unsigned nloc = b.st[0], nx = b.st[1];
        if (nloc == 0u) { xcd_barrier_complete(bar, b.x, nloc, nx); b.st[0] = nloc; b.st[1] = nx; }
        const unsigned old = xb_add(&bar[XB_XSUB(b.x)], 1u);
        const unsigned gen = old / nloc;
        if (old + 1u == (gen + 1u) * nloc) {
            __builtin_amdgcn_fence(__ATOMIC_RELEASE, "agent");
            asm volatile("s_waitcnt vmcnt(0)" ::: "memory");
            const unsigned og = xb_add(&bar[XB_TOP], 1u);
            const unsigned tg = og / nx;
            if (og + 1u == (tg + 1u) * nx) xb_add(&bar[XB_TOPGEN], 1u);
            else XB_SPIN(xb_ld(&bar[XB_TOPGEN]) == tg, bar);
            __builtin_amdgcn_fence(__ATOMIC_ACQUIRE, "agent");
            xb_add(&bar[XB_XGEN(b.x)], 1u);
            asm volatile("s_waitcnt vmcnt(0)" ::: "memory");
        } else {
            XB_SPIN(xb_ld(&bar[XB_XGEN(b.x)]) == gen, bar);
            __builtin_amdgcn_fence(__ATOMIC_ACQUIRE, "agent");
            asm volatile("s_waitcnt vmcnt(0)" ::: "memory");
        }
    }
    __syncthreads();
}

#ifndef PROBE_DUP
#define PROBE_DUP 0
#endif
__global__ void __launch_bounds__(NTHR, 2) fwd_megakernel(Args args) {
    extern __shared__ __attribute__((aligned(16))) unsigned char lds_raw[];
    cg::grid_group grid = cg::this_grid();
    Ctx F;
    F.lds = (LAS unsigned char*)lds_raw;
    const int wave_s = __builtin_amdgcn_readfirstlane((int)threadIdx.x >> 6);
#if !MK_MULTI
    {
        volatile LAS unsigned* st0 = (volatile LAS unsigned*)(F.lds + LDS_BARST_OFF);
        if (threadIdx.x == 0) { st0[0] = 0u; st0[1] = 0u; (void)xb_add((unsigned*)(args.ws + WS_BAR) + XB_XCNT(xb_xcc_id()), 1u); }
        __syncthreads();
    }
#endif
    const int lo = args.ph_lo, hi = args.ph_hi < NPHASES ? args.ph_hi : NPHASES;
    for (int ph2 = 2 * lo; ph2 < 2 * hi; ++ph2) {
        const int ph = ph2 >> 1;
        if (ph2 & 1) { if (ph < 3 || !((PROBE_DUP >> ((ph - 3) % 10)) & 1)) continue; }
        const bool seam = ph2 > 2 * lo;
        { CArgs* ap_ = (CArgs*)__builtin_amdgcn_kernarg_segment_ptr(); asm volatile("" : "+s"(ap_)); F.in.ap = ap_; F.out = ap_->out; F.ws = ap_->ws; }
        { int l_ = (int)__builtin_amdgcn_mbcnt_hi(~0u, __builtin_amdgcn_mbcnt_lo(~0u, 0u)); asm volatile("" : "+v"(l_)); int w_ = wave_s, b_ = blockIdx.x, g_ = gridDim.x; asm volatile("" : "+s"(w_), "+s"(b_), "+s"(g_));
          F.lane = l_; F.wave = w_; F.tid = w_ * 64 + l_; F.bid = b_; F.G = g_; }
        if (seam) {
            if (ph == 1 && !(ph2 & 1)) grid.sync();
            else { XcdBarrier xb; xb.bar = (unsigned*)(F.ws + WS_BAR); xb.x = xb_xcc_id(); xb.st = (volatile LAS unsigned*)(F.lds + LDS_BARST_OFF); xcd_barrier(xb, F.tid); }
        }
        bf16_t* H = (bf16_t*)(F.ws + WS_H); bf16_t* Gh = (bf16_t*)(F.ws + WS_G); float* Y = (float*)(F.ws + WS_Y);
        const float* MOD = (const float*)(F.ws + WS_MOD);
        if (ph == 0) { phase_prologue(F); continue; }
        if (ph == 1) { phase_prologue2(F); continue; }
        if (ph == 2) { phase_prologue3(F); phase_rowwise(F, true, false, false, true, MT, 0.f, nullptr, nullptr, 0, F.in[6] + 0, MOD, 0, 1); continue; }
        const int q = ph - 3, l = q / 10, kind = q % 10;
        const bool lastl = (l == DEPTH - 1);
        unsigned* CTL = (unsigned*)(F.ws + WS_CTL);
        if (kind == 0 || kind == 8) {
            const int s = kind == 0 ? 0 : 1; const int Mff = (lastl && s == 1) ? ML : MT;
            pg8::Gemm g{H, (const bf16_t*)(F.ws + WS_WGU) + (size_t)(l * 2 + s) * 5632 * DM, Mff, 5632, DM, DM, DM, 0, 0, 1};
            pg8::StaticOrder S; S.init(Mff, 5632, 1, F.G, F.bid);
            pg8::EpiSwiGLU E{Gh};
            pg8::gemm_phase<pg8::EpiSwiGLU, true, true, false>(F.lds, F.tid, g, S, E);
        } else if (kind == 1 || kind == 9) {
            const int s = kind == 1 ? 0 : 1; const int Mff = (lastl && s == 1) ? ML : MT; const int which = s ? 2 : 0;
            const bool split = (Mff == MT); const int total = 4 * (Mff / 256);
            unsigned* ctl = CTL + (l * 3 + which) * Q_SLOT_WORDS;
            if (F.tid == 0) *(LAS int*)(F.lds + LDS_PEND_OFF) = -1;
            __syncthreads();
            pg8::Gemm g{Gh, (const bf16_t*)(F.ws + WS_WD) + (size_t)(l * 2 + s) * DM * DFF, Mff, DM, DFF, DFF, DFF, 0, 0, 1};
            pg8::StaticOrder S; S.init(ML, DM, 1, F.G, F.bid);
            pg8::EpiBf16YQ E{(bf16_t*)Y, nullptr, ctl, F.in.ap, 0, 4, total, l, which, split};
            pg8::gemm_phase<pg8::EpiBf16YQ, true, true, false>(F.lds, F.tid, g, S, E);
            if (split) {
                pg8::Gemm g2{Gh + (size_t)ML * DFF, g.Bt, MC, DM, DFF / 2, DFF, DFF, (size_t)(DFF / 2) * 2, (size_t)(DFF / 2) * 2, 2};
                pg8::StaticOrder S2; S2.init(MC, DM, 2, F.G, F.bid);
                pg8::EpiBf16YQ E2{(bf16_t*)Y + (size_t)ML * DM, (bf16_t*)(F.ws + WS_Y2), ctl, F.in.ap, ML / 256, 8, total, l, which, split};
                pg8::gemm_phase<pg8::EpiBf16YQ, true, true, true>(F.lds, F.tid, g2, S2, E2);
            }
            rowq_drain(F.lds, ctl, total, F.in.ap, l, which, split, F.tid, F.wave);
        } else if (kind == 2) {
            pg8::Gemm g{H, (const bf16_t*)(F.ws + WS_WIN) + (size_t)l * INC * DM, MT, INC, DM, DM, DM, 0, 0, 1};
            pg8::StaticOrder S; S.init(MT, INC, 1, F.G, F.bid);
            pg8::EpiWin E{(bf16_t*)(F.ws + WS_Q), (bf16_t*)(F.ws + WS_K), (bf16_t*)(F.ws + WS_VT), (bf16_t*)(F.ws + WS_SSMA), (bf16_t*)(F.ws + WS_CZ), (const f32x2*)(F.ws + WS_CS)};
            pg8::gemm_phase<pg8::EpiWin, true, true, false>(F.lds, F.tid, g, S, E);
        } else if (kind == 3) {
            {
            pg8::Gemm g{(const bf16_t*)(F.ws + WS_SSMA), (const bf16_t*)(F.ws + WS_SST) + (size_t)l * 16 * 256 * 256, NCHUNK, 256, 256, 512, 256, (size_t)NCHUNK * 512 * 2, (size_t)256 * 256 * 2, 16};
            pg8::StaticOrder S; S.init(NCHUNK, 256, 16, F.G, F.bid);
            pg8::EpiF32 E{(float*)(F.ws + WS_SL), 256, (size_t)NCHUNK * 256};
            pg8::gemm_phase<pg8::EpiF32, true, true, true>(F.lds, F.tid, g, S, E);
            }
            __syncthreads();
            if (F.bid & 1) { phase_conv(F, l, lastl ? ML : MT); phase_attn(F, l, lastl); }
            else { phase_attn(F, l, lastl); phase_conv(F, l, lastl ? ML : MT); }
        } else if (kind == 4) {
            phase_scan(F, l);
        } else if (kind == 5) {
            pg8::Gemm g{(const bf16_t*)(F.ws + WS_SSMA), (const bf16_t*)(F.ws + WS_SOUT) + (size_t)l * 16 * 256 * 512, NCHUNK, 256, 512, 512, 512, (size_t)NCHUNK * 512 * 2, (size_t)256 * 512 * 2, 16};
            pg8::StaticOrder S; S.init(NCHUNK, 256, 16, F.G, F.bid);
            pg8::EpiSsmOut E{(bf16_t*)(F.ws + WS_YG)};
            pg8::gemm_phase<pg8::EpiSsmOut, true, true, true>(F.lds, F.tid, g, S, E);
        } else if (kind == 6) {
            const int Mg = lastl ? ML : MT;
            pg8::Gemm g{(const bf16_t*)(F.ws + WS_YG), (const bf16_t*)(F.ws + WS_WGLU) + (size_t)l * 256 * 256, Mg, 256, 256, 256, 256, 0, 0, 1};
            pg8::StaticOrder S; S.init(Mg, 256, 1, F.G, F.bid);
            pg8::EpiGlu E{(const bf16_t*)(F.ws + WS_YG), F.in[23] + l * 256, H};
            pg8::gemm_phase<pg8::EpiGlu, true, true, false>(F.lds, F.tid, g, S, E);
        } else {
            const int Mg = lastl ? ML : MT; const int total = 4 * (Mg / 256);
            unsigned* ctl = CTL + (l * 3 + 1) * Q_SLOT_WORDS;
            if (F.tid == 0) *(LAS int*)(F.lds + LDS_PEND_OFF) = -1;
            __syncthreads();
            pg8::Gemm g{H, (const bf16_t*)(F.ws + WS_WOUT) + (size_t)l * DM * DM, Mg, DM, DM, DM, DM, 0, 0, 1};
            pg8::StaticOrder S; S.init(Mg, DM, 1, F.G, F.bid);
            pg8::EpiBf16YQ E{(bf16_t*)Y, nullptr, ctl, F.in.ap, 0, 4, total, l, 1, false};
            pg8::gemm_phase<pg8::EpiBf16YQ, true, true, false>(F.lds, F.tid, g, S, E);
            rowq_drain(F.lds, ctl, total, F.in.ap, l, 1, false, F.tid, F.wave);
        }
    }
}

extern "C" void kernel_launch(void* const* d_in, const int* in_sizes, int n_in, void* d_out, int out_size, void* d_ws, size_t ws_size, hipStream_t stream) {
    static int grid = 0;
    if (grid == 0) {
        if (n_in != 25 || out_size != ML * DM || ws_size < WS_END) { fprintf(stderr, "kernel_launch: unexpected shapes: n_in %d out %d ws %zu\n", n_in, out_size, ws_size); grid = -1; return; }
        int dev = 0, cus = 0, per_cu = 0;
        hipGetDevice(&dev); hipDeviceGetAttribute(&cus, hipDeviceAttributeMultiprocessorCount, dev);
        if (hipFuncSetAttribute((const void*)fwd_megakernel, hipFuncAttributeMaxDynamicSharedMemorySize, LDS_BYTES) != hipSuccess) { fprintf(stderr, "kernel_launch: hipFuncSetAttribute failed\n"); grid = -1; return; }
        if (hipOccupancyMaxActiveBlocksPerMultiprocessor(&per_cu, (const void*)fwd_megakernel, NTHR, LDS_BYTES) != hipSuccess || per_cu < 1) { fprintf(stderr, "kernel_launch: occupancy query says %d\n", per_cu); per_cu = 1; }
        (void)hipGetLastError();
        grid = cus * per_cu;
        fprintf(stderr, "kernel_launch: grid %d (cus %d x %d)\n", grid, cus, per_cu);
    }
    if (grid < 0) return;
    Args a{};
    for (int i = 0; i < 25; ++i) a.in[i] = (const float*)d_in[i];
    a.out = (float*)d_out; a.ws = (unsigned char*)d_ws;
#if MK_MULTI
    for (int p = 0; p < NPHASES; ++p) { a.ph_lo = p; a.ph_hi = p + 1; hipLaunchKernelGGL(fwd_megakernel, dim3(grid), dim3(NTHR), LDS_BYTES, stream, a); }
#else
    a.ph_lo = 0; a.ph_hi = 1 << 20;
    if (hipMemsetAsync((char*)d_ws + WS_BAR, 0, 16384, stream) != hipSuccess) { fprintf(stderr, "kernel_launch: memset of the barrier words failed\n"); return; }
    void* kargs[] = {&a};
    hipError_t e = hipLaunchCooperativeKernel((const void*)fwd_megakernel, dim3(grid), dim3(NTHR), kargs, LDS_BYTES, stream);
    if (e != hipSuccess) fprintf(stderr, "cooperative launch failed: %s (grid %d)\n", hipGetErrorString(e), grid);
#endif
}
```

```cpp
#include <hip/hip_runtime.h>
#include <hip/hip_cooperative_groups.h>
#include <cstdio>
#include <cstdint>
namespace cg = cooperative_groups;

#define LAS __attribute__((address_space(3)))
typedef unsigned short bf16_t;
typedef short bf16x8 __attribute__((ext_vector_type(8)));
typedef short s16x4 __attribute__((ext_vector_type(4)));
typedef float f32x4 __attribute__((ext_vector_type(4)));
typedef float f32x16 __attribute__((ext_vector_type(16)));
typedef float f32x2 __attribute__((ext_vector_type(2)));
typedef __bf16 bf16x2_t __attribute__((ext_vector_type(2)));
typedef unsigned u32x4 __attribute__((ext_vector_type(4)));
typedef unsigned u32x2 __attribute__((ext_vector_type(2)));

constexpr int NB = 16, SEQL = 4096, NCTX = 256, DM = 1024, DEPTH = 4;
constexpr int ML = NB * SEQL;
constexpr int MC = NB * NCTX;
constexpr int MT = ML + MC;
constexpr int DFF = 2816, INC = 1792, NMOD = 9 * DM;
constexpr int NCHUNK = MT / 16;
constexpr int VTP = SEQL + NCTX;
constexpr float EPS = 1e-6f;
constexpr float LOG2E = 1.4426950408889634f;
constexpr float QSCALE = 0.125f * LOG2E;

constexpr size_t MiB = 1u << 20;
constexpr size_t WS_WGU = 0;
constexpr size_t WS_WD = 88 * MiB;
constexpr size_t WS_WIN = 132 * MiB;
constexpr size_t WS_WOUT = 146 * MiB;
constexpr size_t WS_WGLU = 154 * MiB;
constexpr size_t WS_SOUT = 155 * MiB;
constexpr size_t WS_SST = 171 * MiB;
constexpr size_t WS_MOD = 179 * MiB;
constexpr size_t WS_MODP = 620 * MiB;
constexpr size_t WS_KT = 660 * MiB;
constexpr size_t WS_APOW = 192 * MiB;
constexpr size_t WS_BBAR = 194 * MiB;
constexpr size_t WS_CS = 195 * MiB;
constexpr size_t WS_XC = 196 * MiB;
constexpr size_t WS_H = 212 * MiB;
constexpr size_t WS_Y = 348 * MiB;
constexpr size_t WS_Y2 = WS_Y + 136 * MiB;
constexpr size_t WS_G = 620 * MiB;
constexpr size_t WS_Q = WS_G;
constexpr size_t WS_K = WS_Q + 68 * MiB;
constexpr size_t WS_VT = WS_K + 17 * MiB;
constexpr size_t WS_SSMA = WS_VT + 17 * MiB;
constexpr size_t WS_SL = WS_SSMA + 68 * MiB;
constexpr size_t WS_CZ = WS_SL + 68 * MiB;
constexpr size_t WS_YG = WS_CZ + 102 * MiB;
constexpr size_t WS_END = 994 * MiB;
static_assert(WS_YG + 34 * MiB <= WS_END, "ws map");
static_assert((size_t)MT * DFF * 2 <= 374 * MiB, "G fits");

__device__ __forceinline__ unsigned pk2(float lo, float hi) { f32x2 v = {lo, hi}; bf16x2_t b = __builtin_convertvector(v, bf16x2_t); return __builtin_bit_cast(unsigned, b); }
__device__ __forceinline__ unsigned short f2bf(float f) { unsigned u = __builtin_bit_cast(unsigned, f); return (unsigned short)((u + 0x7fffu + ((u >> 16) & 1u)) >> 16); }
__device__ __forceinline__ float bf2f(unsigned short b) { return __builtin_bit_cast(float, (unsigned)b << 16); }
__device__ __forceinline__ float silu_f(float g) { return g * __builtin_amdgcn_rcpf(1.0f + __builtin_amdgcn_exp2f(-g * LOG2E)); }
__device__ __forceinline__ float sigmoid_f(float g) { return __builtin_amdgcn_rcpf(1.0f + __builtin_amdgcn_exp2f(-g * LOG2E)); }
__device__ __forceinline__ float gelu_tanh_f(float y) { const float t = 0.7978845608028654f * (y + 0.044715f * y * y * y); return y * __builtin_amdgcn_rcpf(1.0f + __builtin_amdgcn_exp2f(-2.0f * LOG2E * t)); }
__device__ __forceinline__ float shx(float v, int lane, int o) { return __builtin_bit_cast(float, __builtin_amdgcn_ds_bpermute((lane ^ o) << 2, __builtin_bit_cast(int, v))); }
__device__ __forceinline__ float wave_sum(float v, int lane) {
#pragma unroll
    for (int o = 1; o < 64; o <<= 1) v += shx(v, lane, o);
    return v;
}
__device__ __forceinline__ float exp_f(float x) { return __builtin_amdgcn_exp2f(x * LOG2E); }

struct Args { const float* in[25]; float* out; unsigned char* ws; int ph_lo, ph_hi; };
typedef __attribute__((address_space(4))) const Args CArgs;
#define RLXA __ATOMIC_RELAXED, __HIP_MEMORY_SCOPE_AGENT
constexpr size_t WS_CTL = 195 * MiB + 262144;
constexpr int LDS_FLAG_OFF = 131072;
constexpr int Q_CNT = 0, Q_QUEUE = 320, Q_TAIL = 640, Q_HEAD = 704, Q_SLOT_WORDS = 1024;

__device__ __forceinline__ void rowwise_quarter(CArgs* ap, int l, int which, bool y2, int pm, int quarter, int wid, int lane) {
    unsigned char* ws = ap->ws; float* outp = ap->out;
    const bf16_t* Y = (const bf16_t*)(ws + WS_Y); bf16_t* H = (bf16_t*)(ws + WS_H);
    const float* modg = (const float*)(ws + WS_MOD) + (size_t)l * 17 * NMOD;
    const float* npost = ap->in[7] + (size_t)l * 3 * DM + which * DM;
    const bool write_h = !(which == 2 && l == DEPTH - 1);
    const int lh = (which == 2 && l < DEPTH - 1) ? l + 1 : l;
    const float* modh = (const float*)(ws + WS_MOD) + (size_t)lh * 17 * NMOD;
    const float* npre = ap->in[6] + (size_t)lh * 3 * DM + (which == 2 ? 0 : (which + 1) * DM);
    const int shift_idx = which == 2 ? 0 : 3 * (which + 1);
    const float fac = which == 1 ? 1.0f : 0.5f;
    const int b17 = pm < (ML / 256) ? (pm >> 4) : 16;
    const bool add2 = y2 && pm >= (ML / 256);
    f32x4 ca[4], cb[4], cc[4];
#pragma unroll
    for (int j = 0; j < 4; ++j) { const int c0 = 4 * lane + 256 * j;
        ca[j] = *(const f32x4*)(npost + c0) * *(const f32x4*)(modg + (size_t)b17 * NMOD + (2 + 3 * which) * DM + c0) * fac;
        cb[j] = *(const f32x4*)(npre + c0) * (*(const f32x4*)(modh + (size_t)b17 * NMOD + (shift_idx + 1) * DM + c0) + 1.0f);
        cc[j] = *(const f32x4*)(modh + (size_t)b17 * NMOD + shift_idx * DM + c0); }
    constexpr int NR = 4;
    for (int i = 0; i < 8; i += NR) {
        const int r0 = pm * 256 + quarter * 64 + wid * 8 + i;
        f32x4 xv[NR][4], yv[NR][4]; float* xr[NR];
#pragma unroll
        for (int k = 0; k < NR; ++k) { const int r = r0 + k; xr[k] = r < ML ? outp + (size_t)r * DM : (float*)(ws + WS_XC) + (size_t)(r - ML) * DM;
#pragma unroll
            for (int j = 0; j < 4; ++j) {
                const u32x2 w = __builtin_nontemporal_load((const u32x2*)(Y + (size_t)r * DM + 4 * lane + 256 * j));
                yv[k][j] = (f32x4){bf2f((unsigned short)(w.x & 0xffff)), bf2f((unsigned short)(w.x >> 16)), bf2f((unsigned short)(w.y & 0xffff)), bf2f((unsigned short)(w.y >> 16))};
                xv[k][j] = __builtin_nontemporal_load((const f32x4*)(xr[k] + 4 * lane + 256 * j)); }
            if (add2) {
#pragma unroll
                for (int j = 0; j < 4; ++j) { const u32x2 w = __builtin_nontemporal_load((const u32x2*)((const bf16_t*)(ws + WS_Y2) + (size_t)(r - ML) * DM + 4 * lane + 256 * j));
                    yv[k][j] = yv[k][j] + (f32x4){bf2f((unsigned short)(w.x & 0xffff)), bf2f((unsigned short)(w.x >> 16)), bf2f((unsigned short)(w.y & 0xffff)), bf2f((unsigned short)(w.y >> 16))}; }
            } }
        float rs[NR], rs2[NR];
#pragma unroll
        for (int k = 0; k < NR; ++k) { float s = 0.f;
#pragma unroll
            for (int j = 0; j < 4; ++j) s += (yv[k][j][0] * yv[k][j][0] + yv[k][j][1] * yv[k][j][1]) + (yv[k][j][2] * yv[k][j][2] + yv[k][j][3] * yv[k][j][3]);
            rs[k] = s; }
#pragma unroll
        for (int o = 1; o < 64; o <<= 1) {
#pragma unroll
            for (int k = 0; k < NR; ++k) rs[k] += shx(rs[k], lane, o);
        }
#pragma unroll
        for (int k = 0; k < NR; ++k) {
            const float r1 = __builtin_amdgcn_rsqf(rs[k] * (1.0f / DM) + EPS);
            float s2 = 0.f;
#pragma unroll
            for (int j = 0; j < 4; ++j) { xv[k][j] = xv[k][j] + ca[j] * (yv[k][j] * r1); __builtin_nontemporal_store(xv[k][j], (f32x4*)(xr[k] + 4 * lane + 256 * j));
                s2 += (xv[k][j][0] * xv[k][j][0] + xv[k][j][1] * xv[k][j][1]) + (xv[k][j][2] * xv[k][j][2] + xv[k][j][3] * xv[k][j][3]); }
            rs2[k] = s2;
        }
        if (write_h) {
#pragma unroll
            for (int o = 1; o < 64; o <<= 1) {
#pragma unroll
                for (int k = 0; k < NR; ++k) rs2[k] += shx(rs2[k], lane, o);
            }
#pragma unroll
            for (int k = 0; k < NR; ++k) {
                const float r2 = __builtin_amdgcn_rsqf(rs2[k] * (1.0f / DM) + EPS);
#pragma unroll
                for (int j = 0; j < 4; ++j) { const f32x4 hv = (xv[k][j] * r2) * cb[j] + cc[j];
                    *(u32x2*)(H + (size_t)(r0 + k) * DM + 4 * lane + 256 * j) = (u32x2){pk2(hv[0], hv[1]), pk2(hv[2], hv[3])}; }
            }
        }
    }
}
constexpr int LDS_PEND_OFF = LDS_FLAG_OFF + 4;
__device__ __forceinline__ int rowq_step(unsigned* ctl, int total, LAS int* pend) {
    int p = *pend;
    if (p == -1) { const unsigned h = __hip_atomic_fetch_add(ctl + Q_HEAD, 1u, RLXA); p = ((int)h < total) ? (int)h : -2; }
    int item = -1;
    if (p >= 0) { const unsigned qe = __hip_atomic_load(ctl + Q_QUEUE + (p >> 2), RLXA); if (qe != 0u) { item = (int)(((qe - 1u) << 2) | ((unsigned)p & 3u)); p = -1; } }
    *pend = p;
    return item;
}
__device__ __forceinline__ void rowq_drain(LAS unsigned char* lds, unsigned* ctl, int total, CArgs* ap, int l, int which, bool y2, int tid, int wid) {
    LAS int* lflag = (LAS int*)(lds + LDS_FLAG_OFF); LAS int* pend = (LAS int*)(lds + LDS_PEND_OFF);
    for (;;) {
        __builtin_amdgcn_s_barrier();
        if (tid == 0) {
            int item = -1; int p = *pend;
            if (p == -1) { const unsigned h = __hip_atomic_fetch_add(ctl + Q_HEAD, 1u, RLXA); p = ((int)h < total) ? (int)h : -2; }
            if (p >= 0) {
                unsigned qe = 0u, spins = 0u;
                for (;;) { qe = __hip_atomic_load(ctl + Q_QUEUE + (p >> 2), RLXA); if (qe != 0u) break; __builtin_amdgcn_s_sleep(16); if (++spins > (1u << 21)) break; }
                if (qe != 0u) { item = (int)(((qe - 1u) << 2) | ((unsigned)p & 3u)); p = -1; } else p = -2;
            }
            *pend = p;
            if (item >= 0) { __builtin_amdgcn_fence(__ATOMIC_ACQUIRE, "agent"); asm volatile("s_waitcnt vmcnt(0)" ::: "memory"); }
            *lflag = item;
        }
        asm volatile("s_waitcnt lgkmcnt(0)" ::: "memory");
        __builtin_amdgcn_s_barrier();
        const int it = __builtin_amdgcn_readfirstlane(*lflag);
        if (it < 0) break;
        int lane = (int)__builtin_amdgcn_mbcnt_hi(~0u, __builtin_amdgcn_mbcnt_lo(~0u, 0u)); asm volatile("" : "+v"(lane));
        rowwise_quarter(ap, l, which, y2, it >> 2, it & 3, wid, lane);
    }
}

namespace pg8 {
constexpr int BM = 256, BK = 64, HALF = 128, HTB = HALF * BK * 2, STAGE_BYTES = 8 * HTB, NXCD = 8, WGM = 4;
__host__ __device__ __forceinline__ int lds_byte(int r, int c) { const int st = (r >> 4) * 2 + (c >> 5), rr = r & 15, cc = c & 31, ob = rr * 64 + cc * 2; return st * 1024 + (ob ^ (((ob >> 9) & 1) << 5)); }
__host__ __device__ __forceinline__ void stage_rc(int b, int& R, int& C) { const int st = b / 1024, sb = b % 1024, swz = sb ^ (((sb >> 9) & 1) << 5); R = (st >> 1) * 16 + swz / 64; C = (st & 1) * 32 + (swz % 64) / 2; }
__host__ __device__ __forceinline__ int perm32(int rho) { const int n = rho >> 4, i = rho & 15; return 8 * (i >> 2) + 4 * n + (i & 3); }

struct Unit { int pm, pn, z; };
struct Gemm { const bf16_t* A; const bf16_t* Bt; int M, N, K, lda, ldb; size_t zsA, zsB; int nz; };

struct StaticOrder {
    int nM, nN, nwg, G, c, nz;
    __device__ void init(int M, int N, int nz_, int G_, int c_) { nM = M / BM; nN = N / BM; nwg = nM * nN; G = G_; c = c_; nz = nz_; }
    __device__ bool next(int i, Unit& u) const {
        const long L = (long)i * G + c; if (L >= (long)nwg * nz) return false;
        u.z = (int)(L / nwg);
        int wgid = (int)(L % nwg); { const int q = nwg / NXCD, r = nwg % NXCD, xcd = wgid % NXCD, off = wgid / NXCD; wgid = (xcd < r ? xcd * (q + 1) : r * (q + 1) + (xcd - r) * q) + off; }
        const int nig = WGM * nN, gid = wgid / nig, fm = gid * WGM, gsz = (nM - fm) < WGM ? (nM - fm) : WGM;
        u.pm = fm + ((wgid % nig) % gsz); u.pn = (wgid % nig) / gsz; return true;
    }
};

template <class Epi, bool ALIGN_EPI, bool SP2, bool ZB>
__device__ __forceinline__ void gemm_phase(LAS unsigned char* lds, const int tid, const Gemm g, const StaticOrder& S, const Epi& E) {
    const int wid = __builtin_amdgcn_readfirstlane(tid >> 6), lane = tid & 63, wr = wid >> 2, wc = wid & 3, fr = lane & 15, fq = lane >> 4;
    const int K = g.K, nt = K / BK, lda = g.lda, ldb = g.ldb;
    unsigned voffA[2], voffB[2];
#pragma unroll
    for (int i = 0; i < 2; ++i) { int R, C; stage_rc(tid * 16 + i * 8192, R, C); const int Rb = Epi::PERM ? ((R & ~31) + perm32(R & 31)) : R;
        voffA[i] = (unsigned)(R * lda + C) * 2u; voffB[i] = (unsigned)(Rb * ldb + C) * 2u; }
    const size_t kstep = (size_t)(BK * 2);
    const size_t hstepA = (size_t)HALF * lda * 2, hstepB = (size_t)HALF * ldb * 2;
    const size_t tstepA = 2 * hstepA, tstepB = 2 * hstepB;
    const unsigned ldsw = (unsigned)wid * 1024u;
    const int aoff = lds_byte(wr * 64 + fr, fq * 8), boff = lds_byte(wc * 32 + fr, fq * 8);
#define PG8_SA(b, h) (((b) * 2 + (h)) * HTB)
#define PG8_SB(b, h) ((4 + (b) * 2 + (h)) * HTB)
#define PG8_STAGE(bufoff, gbase, voff) do { _Pragma("unroll") for (int _i = 0; _i < 2; ++_i) { unsigned _vo = (voff)[_i]; asm volatile("" : "+v"(_vo)); \
        __builtin_amdgcn_global_load_lds((const unsigned*)((const char*)(gbase) + _vo), (LAS unsigned*)(lds + (bufoff) + ldsw + _i * 8192), 16, 0, 0); } } while (0)
#define PG8_LDA(dst, b, h) do { _Pragma("unroll") for (int m = 0; m < 4; ++m) _Pragma("unroll") for (int k = 0; k < 2; ++k) dst[m][k] = *(const LAS bf16x8*)(lds + PG8_SA(b, h) + aoff + m * 2048 + k * 1024); } while (0)
#define PG8_LDB(dst, b, h) do { _Pragma("unroll") for (int n = 0; n < 2; ++n) _Pragma("unroll") for (int k = 0; k < 2; ++k) dst[n][k] = *(const LAS bf16x8*)(lds + PG8_SB(b, h) + boff + n * 2048 + k * 1024); } while (0)
#define PG8_MMA(ai, bj, At, Bt) do { __builtin_amdgcn_s_setprio(1); _Pragma("unroll") for (int m = 0; m < 4; ++m) _Pragma("unroll") for (int n = 0; n < 2; ++n) _Pragma("unroll") for (int k = 0; k < 2; ++k) \
        acc[ai][bj][m][n] = __builtin_amdgcn_mfma_f32_16x16x32_bf16(Bt[n][k], At[m][k], acc[ai][bj][m][n], 0, 0, 0); __builtin_amdgcn_s_setprio(0); } while (0)
#define PG8_WAIT_V(n) asm volatile("s_waitcnt vmcnt(" #n ")" ::: "memory")
#define PG8_WAIT_L(n) asm volatile("s_waitcnt lgkmcnt(" #n ")" ::: "memory")
#define PG8_BAR __builtin_amdgcn_s_barrier()
#define PG8_SCHED __builtin_amdgcn_sched_barrier(0)
    Unit cur, nxt; int ui = 0;
    if (!S.next(0, cur)) return;
    f32x4 acc[2][2][4][2];
#pragma unroll
    for (int a = 0; a < 2; ++a)
#pragma unroll
        for (int b = 0; b < 2; ++b)
#pragma unroll
            for (int m = 0; m < 4; ++m)
#pragma unroll
                for (int n = 0; n < 2; ++n) acc[a][b][m][n] = (f32x4){0.f, 0.f, 0.f, 0.f};
    bf16x8 At[4][2], B0[2][2], B1[2][2];
    const char* cA = (const char*)g.A + (ZB ? (size_t)cur.z * g.zsA : (size_t)0) + (size_t)cur.pm * tstepA; const char* cB = (const char*)g.Bt + (ZB ? (size_t)cur.z * g.zsB : (size_t)0) + (size_t)cur.pn * tstepB;
    if constexpr (SP2) {
        PG8_STAGE(PG8_SB(0, 0), cB, voffB); PG8_STAGE(PG8_SB(0, 1), cB + hstepB, voffB); PG8_STAGE(PG8_SA(0, 0), cA, voffA); PG8_STAGE(PG8_SA(0, 1), cA + hstepA, voffA);
        if (wr == 1) PG8_BAR;
        PG8_WAIT_V(2); PG8_BAR;
        PG8_STAGE(PG8_SB(1, 0), cB + kstep, voffB); PG8_STAGE(PG8_SA(1, 0), cA + kstep, voffA); PG8_STAGE(PG8_SB(1, 1), cB + hstepB + kstep, voffB);
        PG8_WAIT_V(6); PG8_BAR;
    } else {
        PG8_STAGE(PG8_SB(0, 0), cB, voffB); PG8_STAGE(PG8_SA(0, 0), cA, voffA); PG8_STAGE(PG8_SB(0, 1), cB + hstepB, voffB); PG8_STAGE(PG8_SA(0, 1), cA + hstepA, voffA);
        if (wr == 1) PG8_BAR;
        PG8_WAIT_V(4); PG8_BAR;
        PG8_STAGE(PG8_SB(1, 0), cB + kstep, voffB); PG8_STAGE(PG8_SA(1, 0), cA + kstep, voffA); PG8_STAGE(PG8_SB(1, 1), cB + hstepB + kstep, voffB);
        PG8_WAIT_V(6); PG8_BAR;
    }
    for (;;) {
        const bool has_next = S.next(ui + 1, nxt);
        const char* nA = has_next ? (const char*)g.A + (ZB ? (size_t)nxt.z * g.zsA : (size_t)0) + (size_t)nxt.pm * tstepA : cA; const char* nB = has_next ? (const char*)g.Bt + (ZB ? (size_t)nxt.z * g.zsB : (size_t)0) + (size_t)nxt.pn * tstepB : cB;
        for (int t = 0; t < nt; t += 2) {
            const bool last = (t == nt - 2);
            const char* a1 = cA + (size_t)(t + 1) * kstep;
            const char* a2 = last ? nA : cA + (size_t)(t + 2) * kstep; const char* b2 = last ? nB : cB + (size_t)(t + 2) * kstep;
            const char* a3 = a2 + kstep; const char* b3 = b2 + kstep;
            if constexpr (SP2) {
            PG8_LDB(B0, 0, 0); PG8_LDB(B1, 0, 1); PG8_SCHED; PG8_LDA(At, 0, 0); PG8_STAGE(PG8_SA(1, 1), a1 + hstepA, voffA);
            PG8_WAIT_V(8); PG8_WAIT_L(0); PG8_BAR; PG8_MMA(0, 0, At, B0); PG8_MMA(0, 1, At, B1); PG8_BAR; PG8_SCHED;
            PG8_LDA(At, 0, 1); PG8_STAGE(PG8_SB(0, 0), b2, voffB); PG8_STAGE(PG8_SB(0, 1), b2 + hstepB, voffB); PG8_STAGE(PG8_SA(0, 0), a2, voffA);
            PG8_WAIT_V(8); PG8_WAIT_L(0); PG8_BAR; PG8_MMA(1, 0, At, B0); PG8_MMA(1, 1, At, B1); PG8_BAR; PG8_SCHED;
            PG8_LDB(B0, 1, 0); PG8_LDB(B1, 1, 1); PG8_SCHED; PG8_LDA(At, 1, 0); PG8_STAGE(PG8_SA(0, 1), a2 + hstepA, voffA);
            PG8_WAIT_V(8); PG8_WAIT_L(0); PG8_BAR; PG8_MMA(0, 0, At, B0); PG8_MMA(0, 1, At, B1); PG8_BAR; PG8_SCHED;
            PG8_LDA(At, 1, 1); PG8_STAGE(PG8_SB(1, 0), b3, voffB); PG8_STAGE(PG8_SB(1, 1), b3 + hstepB, voffB); PG8_STAGE(PG8_SA(1, 0), a3, voffA);
            PG8_WAIT_V(8); PG8_WAIT_L(0); PG8_BAR; PG8_MMA(1, 0, At, B0); PG8_MMA(1, 1, At, B1); PG8_BAR; PG8_SCHED;
            } else {
            PG8_LDB(B0, 0, 0); PG8_SCHED; PG8_LDA(At, 0, 0); PG8_STAGE(PG8_SA(1, 1), a1 + hstepA, voffA);
            PG8_WAIT_L(8); PG8_BAR; PG8_WAIT_L(0); PG8_MMA(0, 0, At, B0); PG8_BAR; PG8_SCHED;
            PG8_LDB(B1, 0, 1); PG8_STAGE(PG8_SB(0, 0), b2, voffB);
            PG8_BAR; PG8_WAIT_L(0); PG8_MMA(0, 1, At, B1); PG8_BAR;
            PG8_LDA(At, 0, 1); PG8_STAGE(PG8_SA(0, 0), a2, voffA);
            PG8_BAR; PG8_WAIT_L(0); PG8_MMA(1, 0, At, B0); PG8_BAR; PG8_SCHED;
            PG8_STAGE(PG8_SB(0, 1), b2 + hstepB, voffB);
            PG8_WAIT_V(6); PG8_BAR; PG8_MMA(1, 1, At, B1); PG8_BAR;
            PG8_LDB(B0, 1, 0); PG8_SCHED; PG8_LDA(At, 1, 0); PG8_STAGE(PG8_SA(0, 1), a2 + hstepA, voffA);
            PG8_WAIT_L(8); PG8_BAR; PG8_WAIT_L(0); PG8_MMA(0, 0, At, B0); PG8_BAR; PG8_SCHED;
            PG8_LDB(B1, 1, 1); PG8_STAGE(PG8_SB(1, 0), b3, voffB);
            PG8_BAR; PG8_WAIT_L(0); PG8_MMA(0, 1, At, B1); PG8_BAR;
            PG8_LDA(At, 1, 1); PG8_STAGE(PG8_SA(1, 0), a3, voffA);
            PG8_BAR; PG8_WAIT_L(0); PG8_MMA(1, 0, At, B0); PG8_BAR; PG8_SCHED;
            PG8_STAGE(PG8_SB(1, 1), b3 + hstepB, voffB);
            PG8_WAIT_V(6); PG8_BAR; PG8_MMA(1, 1, At, B1); PG8_BAR;
            }
        }
        if constexpr (ALIGN_EPI) { if (wr == 0) PG8_BAR; }
        { const int lane_e = (int)__builtin_amdgcn_mbcnt_hi(~0u, __builtin_amdgcn_mbcnt_lo(~0u, 0u)); E(acc, cur, wr, wc, lane_e); }
        if constexpr (Epi::HAS_DONE) E.done(cur, lds, tid, wid);
        if (!has_next) break;
#pragma unroll
        for (int a = 0; a < 2; ++a)
#pragma unroll
            for (int b = 0; b < 2; ++b)
#pragma unroll
                for (int m = 0; m < 4; ++m)
#pragma unroll
                    for (int n = 0; n < 2; ++n) acc[a][b][m][n] = (f32x4){0.f, 0.f, 0.f, 0.f};
        cur = nxt; cA = nA; cB = nB; ++ui;
        if constexpr (ALIGN_EPI) { if (wr == 1) PG8_BAR; }
    }
    PG8_WAIT_V(0);
    if constexpr (!ALIGN_EPI) { if (wr == 0) PG8_BAR; }
    PG8_BAR;
#undef PG8_SA
#undef PG8_SB
#undef PG8_STAGE
#undef PG8_LDA
#undef PG8_LDB
#undef PG8_MMA
#undef PG8_WAIT_V
#undef PG8_WAIT_L
#undef PG8_BAR
#undef PG8_SCHED
}

typedef f32x4 Acc[2][2][4][2];

struct EpiSwiGLU {
    static constexpr bool PERM = true, HAS_DONE = false;
    bf16_t* G;
    __device__ __forceinline__ void operator()(const Acc& acc, const Unit& u, int wr, int wc, int lane) const {
        asm volatile("" : "+v"(lane)); const int fr = lane & 15, fq = lane >> 4;
        const int row0 = u.pm * BM + wr * 64 + fr, col0 = u.pn * 128 + wc * 32 + 8 * fq;
#pragma unroll
        for (int ai = 0; ai < 2; ++ai)
#pragma unroll
            for (int m = 0; m < 4; ++m) {
                const f32x4 g0 = acc[ai][0][m][0], g1 = acc[ai][0][m][1], u0 = acc[ai][1][m][0], u1 = acc[ai][1][m][1];
                u32x4 w;
                w.x = pk2(silu_f(g0[0]) * u0[0], silu_f(g0[1]) * u0[1]); w.y = pk2(silu_f(g0[2]) * u0[2], silu_f(g0[3]) * u0[3]);
                w.z = pk2(silu_f(g1[0]) * u1[0], silu_f(g1[1]) * u1[1]); w.w = pk2(silu_f(g1[2]) * u1[2], silu_f(g1[3]) * u1[3]);
                *(u32x4*)(G + (size_t)(row0 + ai * HALF + m * 16) * DFF + col0) = w;
            }
    }
};

struct EpiF32 {
    static constexpr bool PERM = false, HAS_DONE = false;
    float* Y; int ldc; size_t zs;
    __device__ __forceinline__ void operator()(const Acc& acc, const Unit& u, int wr, int wc, int lane) const {
        asm volatile("" : "+v"(lane)); const int fr = lane & 15, fq = lane >> 4;
        float* base = Y + (size_t)u.z * zs;
        const int row0 = u.pm * BM + wr * 64 + fr, col0 = u.pn * BM + wc * 32 + 4 * fq;
#pragma unroll
        for (int ai = 0; ai < 2; ++ai)
#pragma unroll
            for (int m = 0; m < 4; ++m) { float* rp = base + (size_t)(row0 + ai * HALF + m * 16) * ldc + col0;
#pragma unroll
                for (int bj = 0; bj < 2; ++bj)
#pragma unroll
                    for (int n = 0; n < 2; ++n) *(f32x4*)(rp + bj * HALF + n * 16) = acc[ai][bj][m][n]; }
    }
};

struct EpiBf16Y {
    static constexpr bool PERM = true, HAS_DONE = false;
    bf16_t* Y; bf16_t* Yz1;
    __device__ __forceinline__ void operator()(const Acc& acc, const Unit& u, int wr, int wc, int lane) const {
        asm volatile("" : "+v"(lane)); const int fr = lane & 15, fq = lane >> 4;
        const int row0 = u.pm * BM + wr * 64 + fr, col0 = u.pn * BM + wc * 32 + 8 * fq;
        bf16_t* Yb = u.z ? Yz1 : Y;
#pragma unroll
        for (int ai = 0; ai < 2; ++ai)
#pragma unroll
            for (int m = 0; m < 4; ++m) { bf16_t* rp = Yb + (size_t)(row0 + ai * HALF + m * 16) * DM + col0;
#pragma unroll
                for (int bj = 0; bj < 2; ++bj) { const f32x4 a0 = acc[ai][bj][m][0], a1 = acc[ai][bj][m][1];
                    *(u32x4*)(rp + bj * HALF) = (u32x4){pk2(a0[0], a0[1]), pk2(a0[2], a0[3]), pk2(a1[0], a1[1]), pk2(a1[2], a1[3])}; } }
    }
};

#ifndef YQ_STORE_AUX
#define YQ_STORE_AUX "sc0 sc1"
#endif
struct EpiBf16YQ {
    static constexpr bool PERM = true, HAS_DONE = true;
    bf16_t* Y; bf16_t* Yz1; unsigned* ctl; CArgs* ap; int pm_off, need, total, l, which; bool y2;
    __device__ __forceinline__ void operator()(const Acc& acc, const Unit& u, int wr, int wc, int lane) const {
        asm volatile("" : "+v"(lane)); const int fr = lane & 15, fq = lane >> 4;
        const int row0 = u.pm * BM + wr * 64 + fr, col0 = u.pn * BM + wc * 32 + 8 * fq;
        bf16_t* Yb = u.z ? Yz1 : Y;
#pragma unroll
        for (int ai = 0; ai < 2; ++ai)
#pragma unroll
            for (int m = 0; m < 4; ++m) { bf16_t* rp = Yb + (size_t)(row0 + ai * HALF + m * 16) * DM + col0;
#pragma unroll
                for (int bj = 0; bj < 2; ++bj) { const f32x4 a0 = acc[ai][bj][m][0], a1 = acc[ai][bj][m][1];
                    const u32x4 w = (u32x4){pk2(a0[0], a0[1]), pk2(a0[2], a0[3]), pk2(a1[0], a1[1]), pk2(a1[2], a1[3])};
                    asm volatile("global_store_dwordx4 %0, %1, off " YQ_STORE_AUX "\n\ts_nop 1" :: "v"(rp + bj * HALF), "v"(w) : "memory"); } }
    }
    __device__ __forceinline__ void done(const Unit& u, LAS unsigned char* lds, int tid, int wid) const {
        asm volatile("s_waitcnt vmcnt(0)" ::: "memory");
        __builtin_amdgcn_s_barrier();
        LAS int* lflag = (LAS int*)(lds + LDS_FLAG_OFF);
        if (tid == 0) {
            const int pmg = pm_off + u.pm;
            LAS int* pend = (LAS int*)(lds + LDS_PEND_OFF);
            int p = *pend;
            __builtin_amdgcn_fence(__ATOMIC_RELEASE, "agent");
            asm volatile("s_waitcnt vmcnt(0)" ::: "memory");
            const unsigned old = __hip_atomic_fetch_add(ctl + Q_CNT + pmg, 1u, RLXA);
            unsigned h = 0u; if (p == -1) h = __hip_atomic_fetch_add(ctl + Q_HEAD, 1u, RLXA);
            if (p == -1) p = ((int)h < total) ? (int)h : -2;
            unsigned qe = 0u; if (p >= 0) qe = __hip_atomic_load(ctl + Q_QUEUE + (p >> 2), RLXA);
            if (old + 1u == (unsigned)need) { const unsigned slot = __hip_atomic_fetch_add(ctl + Q_TAIL, 1u, RLXA); __hip_atomic_store(ctl + Q_QUEUE + slot, (unsigned)pmg + 1u, RLXA); }
            int item = -1;
            if (p >= 0 && qe != 0u) { item = (int)(((qe - 1u) << 2) | ((unsigned)p & 3u)); p = -1; }
            *pend = p;
            if (item >= 0) { __builtin_amdgcn_fence(__ATOMIC_ACQUIRE, "agent"); asm volatile("s_waitcnt vmcnt(0)" ::: "memory"); }
            *lflag = item;
        }
        asm volatile("s_waitcnt lgkmcnt(0)" ::: "memory");
        __builtin_amdgcn_s_barrier();
        const int it = __builtin_amdgcn_readfirstlane(*lflag);
        if (it >= 0) { int lane = (int)__builtin_amdgcn_mbcnt_hi(~0u, __builtin_amdgcn_mbcnt_lo(~0u, 0u)); asm volatile("" : "+v"(lane)); rowwise_quarter(ap, l, which, y2, it >> 2, it & 3, wid, lane); }
    }
};

struct EpiWin {
    static constexpr bool PERM = false, HAS_DONE = false;
    bf16_t *Q, *Kb, *VT, *SSMA, *CZ; const f32x2* CS;
    __device__ __forceinline__ void operator()(const Acc& acc, const Unit& u, int wr, int wc, int lane) const {
        asm volatile("" : "+v"(lane)); const int fr = lane & 15, fq = lane >> 4;
        const int pn = u.pn; const bool isctx = u.pm >= (ML / BM);
        f32x4 cc = {1.f, 1.f, 1.f, 1.f}, ss = {0.f, 0.f, 0.f, 0.f};
#pragma unroll
        for (int ai = 0; ai < 2; ++ai)
#pragma unroll
            for (int m = 0; m < 4; ++m) {
                const int r = u.pm * BM + ai * HALF + wr * 64 + m * 16 + fr;
                int b, pos;
                if (!isctx) { b = r >> 12; pos = r & 4095; } else { const int rc = r - ML; b = rc >> 8; pos = rc & 255; }
                if (pn <= 2 && !isctx) {
                    const int v = (wc & 1) ? (pos & 63) : (pos >> 6);
                    const f32x2* t = CS + v * 16 + 4 * fq;
                    const f32x2 t0 = t[0], t1 = t[1], t2 = t[2], t3 = t[3];
                    cc = (f32x4){t0.x, t1.x, t2.x, t3.x}; ss = (f32x4){t0.y, t1.y, t2.y, t3.y};
                }
#pragma unroll
                for (int bj = 0; bj < 2; ++bj) {
                    const f32x4 a0 = acc[ai][bj][m][0], a1 = acc[ai][bj][m][1];
                    const int cl = 128 * bj + 32 * wc + 4 * fq;
                    if (pn <= 1) {
                        f32x4 o0, o1;
                        if (!isctx) { o0 = a0 * cc - a1 * ss; o1 = a1 * cc + a0 * ss; } else { o0 = a0; o1 = a1; }
                        o0 = o0 * QSCALE; o1 = o1 * QSCALE;
                        bf16_t* p = Q + (size_t)r * 512 + pn * 256 + cl;
                        *(u32x2*)p = (u32x2){pk2(o0[0], o0[1]), pk2(o0[2], o0[3])}; *(u32x2*)(p + 16) = (u32x2){pk2(o1[0], o1[1]), pk2(o1[2], o1[3])};
                    } else if (pn == 2) {
                        if (bj == 0) {
                            f32x4 o0, o1;
                            if (!isctx) { o0 = a0 * cc - a1 * ss; o1 = a1 * cc + a0 * ss; } else { o0 = a0; o1 = a1; }
                            bf16_t* p = Kb + (size_t)r * 128 + 32 * wc + 4 * fq;
                            *(u32x2*)p = (u32x2){pk2(o0[0], o0[1]), pk2(o0[2], o0[3])}; *(u32x2*)(p + 16) = (u32x2){pk2(o1[0], o1[1]), pk2(o1[2], o1[3])};
                        } else {
                            const int vc = 32 * wc + 4 * fq;
                            const int pidx = isctx ? (SEQL + pos) : pos;
                            bf16_t* p = VT + ((size_t)(b * 2 + (vc >> 6)) * 64 + (vc & 63)) * VTP + pidx;
#pragma unroll
                            for (int j = 0; j < 4; ++j) { p[(size_t)j * VTP] = f2bf(a0[j]); p[(size_t)(j + 16) * VTP] = f2bf(a1[j]); }
                        }
                    } else if (pn == 3) {
                        const int g0 = 8 * bj + 2 * wc;
                        bf16_t* p = SSMA + ((size_t)g0 * NCHUNK + (r >> 4)) * 512 + (r & 15) * 16 + 4 * fq;
                        *(u32x2*)p = (u32x2){pk2(a0[0], a0[1]), pk2(a0[2], a0[3])};
                        *(u32x2*)(p + (size_t)NCHUNK * 512) = (u32x2){pk2(a1[0], a1[1]), pk2(a1[2], a1[3])};
                    } else {
                        bf16_t* p = CZ + (size_t)r * 768 + (pn - 4) * 256 + cl;
                        *(u32x2*)p = (u32x2){pk2(a0[0], a0[1]), pk2(a0[2], a0[3])}; *(u32x2*)(p + 16) = (u32x2){pk2(a1[0], a1[1]), pk2(a1[2], a1[3])};
                    }
                }
            }
    }
};

struct EpiSsmOut {
    static constexpr bool PERM = false, HAS_DONE = false;
    bf16_t* YG;
    __device__ __forceinline__ void operator()(const Acc& acc, const Unit& u, int wr, int wc, int lane) const {
        asm volatile("" : "+v"(lane)); const int fr = lane & 15, fq = lane >> 4;
#pragma unroll
        for (int ai = 0; ai < 2; ++ai)
#pragma unroll
            for (int m = 0; m < 4; ++m) {
                const int r = u.pm * BM + ai * HALF + wr * 64 + m * 16 + fr;
#pragma unroll
                for (int bj = 0; bj < 2; ++bj)
#pragma unroll
                    for (int n = 0; n < 2; ++n) {
                        const int t = 8 * bj + 2 * wc + n; const f32x4 a = acc[ai][bj][m][n];
                        bf16_t* p = YG + (size_t)(r * 16 + t) * 256 + u.z * 16 + 4 * fq;
                        *(u32x2*)p = (u32x2){pk2(gelu_tanh_f(a[0]), gelu_tanh_f(a[1])), pk2(gelu_tanh_f(a[2]), gelu_tanh_f(a[3]))};
                    }
            }
    }
};

struct EpiGlu {
    static constexpr bool PERM = true, HAS_DONE = false;
    const bf16_t* YG; const float* bias; bf16_t* MIX;
    __device__ __forceinline__ void operator()(const Acc& acc, const Unit& u, int wr, int wc, int lane) const {
        asm volatile("" : "+v"(lane)); const int fr = lane & 15, fq = lane >> 4;
        const int row0 = u.pm * BM + wr * 64 + fr;
#pragma unroll
        for (int bj = 0; bj < 2; ++bj) {
            const int col0 = bj * HALF + wc * 32 + 8 * fq;
            const f32x4 b0 = *(const f32x4*)(bias + col0), b1 = *(const f32x4*)(bias + col0 + 4);
#pragma unroll
            for (int ai = 0; ai < 2; ++ai)
#pragma unroll
                for (int m = 0; m < 4; ++m) {
                    const size_t r = (size_t)(row0 + ai * HALF + m * 16);
                    const u32x4 gv = *(const u32x4*)(YG + r * 256 + col0);
                    const f32x4 a0 = acc[ai][bj][m][0] + b0, a1 = acc[ai][bj][m][1] + b1;
                    float gg[8];
                    gg[0] = bf2f((unsigned short)(gv.x & 0xffff)); gg[1] = bf2f((unsigned short)(gv.x >> 16)); gg[2] = bf2f((unsigned short)(gv.y & 0xffff)); gg[3] = bf2f((unsigned short)(gv.y >> 16));
                    gg[4] = bf2f((unsigned short)(gv.z & 0xffff)); gg[5] = bf2f((unsigned short)(gv.z >> 16)); gg[6] = bf2f((unsigned short)(gv.w & 0xffff)); gg[7] = bf2f((unsigned short)(gv.w >> 16));
                    u32x4 w;
                    w.x = pk2(gg[0] * sigmoid_f(a0[0]), gg[1] * sigmoid_f(a0[1])); w.y = pk2(gg[2] * sigmoid_f(a0[2]), gg[3] * sigmoid_f(a0[3]));
                    w.z = pk2(gg[4] * sigmoid_f(a1[0]), gg[5] * sigmoid_f(a1[1])); w.w = pk2(gg[6] * sigmoid_f(a1[2]), gg[7] * sigmoid_f(a1[3]));
                    *(u32x4*)(MIX + r * 1024 + 512 + col0) = w;
                }
        }
    }
};
}

constexpr int NWAVES = 8, NTHR = 512;
constexpr int NPHASES = 3 + 10 * DEPTH;
constexpr int LDS_BYTES = 147456;

struct InView { CArgs* ap; __device__ __forceinline__ const float* operator[](int i) const { return ap->in[i]; } };
struct Ctx {
    LAS unsigned char* lds;
    int tid, lane, wave, G, bid;
    InView in;
    float* out; unsigned char* ws;
};

__device__ __forceinline__ float* xrow_ptr(const Ctx& F, int r) { return r < ML ? F.out + (size_t)r * DM : (float*)(F.ws + WS_XC) + (size_t)(r - ML) * DM; }

__device__ __forceinline__ void transpose_item(const float* W, int Nsrc, int k0, int n0, bf16_t* WT, int Kd, int drow0, LAS float* scr, int lane) {
#pragma unroll 8
    for (int i = 0; i < 32; ++i) { const int kk = 2 * i + (lane >> 5); scr[kk * 33 + (lane & 31)] = W[(size_t)(k0 + kk) * Nsrc + n0 + (lane & 31)]; }
    asm volatile("s_waitcnt lgkmcnt(0)" ::: "memory");
    const int c = lane & 7;
#pragma unroll
    for (int j = 0; j < 4; ++j) { const int n = (lane >> 3) + 8 * j; const LAS float* s = scr + (8 * c) * 33 + n;
        u32x4 o; o.x = pk2(s[0 * 33], s[1 * 33]); o.y = pk2(s[2 * 33], s[3 * 33]); o.z = pk2(s[4 * 33], s[5 * 33]); o.w = pk2(s[6 * 33], s[7 * 33]);
        *(u32x4*)(WT + (size_t)(drow0 + n) * Kd + k0 + 8 * c) = o; }
    asm volatile("s_waitcnt lgkmcnt(0)" ::: "memory");
}

__device__ __forceinline__ void phase_prologue(const Ctx& F) {
    const float* c_in = F.in[1]; const float* cctx = F.in[3]; const float* w_ada = F.in[4];
    {
        LAS float* sl = (LAS float*)F.lds;
        float* MODP = (float*)(F.ws + WS_MODP);
        for (int item = F.bid; item < 576; item += F.G) {
            const int l = item / 144, r2 = item % 144, kq = r2 / 18, nb = r2 % 18;
            __syncthreads();
            for (int idx = F.tid; idx < 17 * 128; idx += NTHR) { const int rr = idx >> 7, kk = idx & 127; const float v = rr < 16 ? c_in[rr * DM + kq * 128 + kk] : cctx[kq * 128 + kk]; sl[idx] = v / (1.0f + exp_f(-v)); }
            __syncthreads();
            const int n = nb * 512 + F.tid;
            float acc[17];
#pragma unroll
            for (int r = 0; r < 17; ++r) acc[r] = 0.f;
            const float* wp = w_ada + ((size_t)l * DM + kq * 128) * NMOD + n;
            for (int k0 = 0; k0 < 128; k0 += 16) {
                float w[16];
#pragma unroll
                for (int k = 0; k < 16; ++k) w[k] = __builtin_nontemporal_load(wp + (size_t)(k0 + k) * NMOD);
#pragma unroll
                for (int k = 0; k < 16; ++k) {
#pragma unroll
                    for (int r = 0; r < 17; ++r) acc[r] += sl[r * 128 + k0 + k] * w[k]; }
            }
#pragma unroll
            for (int r = 0; r < 17; ++r) MODP[(((size_t)kq * 4 + l) * 17 + r) * NMOD + n] = acc[r];
        }
        __syncthreads();
    }
    {
        LAS float* scr = (LAS float*)(F.lds + F.wave * 16384);
        const int gw = F.bid * NWAVES + F.wave, NGW = F.G * NWAVES;
        bf16_t* WGU = (bf16_t*)(F.ws + WS_WGU); bf16_t* WD = (bf16_t*)(F.ws + WS_WD); bf16_t* WIN = (bf16_t*)(F.ws + WS_WIN); bf16_t* WOUT = (bf16_t*)(F.ws + WS_WOUT); bf16_t* WGLU = (bf16_t*)(F.ws + WS_WGLU);
        constexpr int I_GU = 16 * 88, I_D = 44 * 32, I_IN = 16 * 56, I_OUT = 16 * 32, I_GLU = 4 * 8;
        constexpr int NITEMS = I_GU * 16 + I_D * 8 + I_IN * 4 + I_OUT * 4 + I_GLU * 4;
        for (int it = gw; it < NITEMS; it += NGW) {
            int r = it;
            if (r < I_GU * 16) { const int up = r / (I_GU * 8); r -= up * I_GU * 8; const int ls = r / I_GU; r %= I_GU; const int kb = r / 88, nb = r % 88, n0 = nb * 32;
                transpose_item(F.in[up ? 9 : 8] + (size_t)ls * DM * DFF, DFF, kb * 64, n0, WGU + (size_t)ls * 5632 * DM, DM, (n0 / 128) * 256 + (n0 % 128) + up * 128, scr, F.lane); continue; }
            r -= I_GU * 16;
            if (r < I_D * 8) { const int ls = r / I_D; r %= I_D; const int kb = r / 32, nb = r % 32;
                transpose_item(F.in[10] + (size_t)ls * DFF * DM, DM, kb * 64, nb * 32, WD + (size_t)ls * DM * DFF, DFF, nb * 32, scr, F.lane); continue; }
            r -= I_D * 8;
            if (r < I_IN * 4) { const int l = r / I_IN; r %= I_IN; const int kb = r / 56, nb = r % 56;
                transpose_item(F.in[11] + (size_t)l * DM * INC, INC, kb * 64, nb * 32, WIN + (size_t)l * INC * DM, DM, nb * 32, scr, F.lane); continue; }
            r -= I_IN * 4;
            if (r < I_OUT * 4) { const int l = r / I_OUT; r %= I_OUT; const int kb = r / 32, nb = r % 32;
                transpose_item(F.in[12] + (size_t)l * DM * DM, DM, kb * 64, nb * 32, WOUT + (size_t)l * DM * DM, DM, nb * 32, scr, F.lane); continue; }
            r -= I_OUT * 4;
            { const int l = r / I_GLU; r %= I_GLU; const int kb = r / 8, nb = r % 8;
                transpose_item(F.in[22] + (size_t)l * 256 * 256, 256, kb * 64, nb * 32, WGLU + (size_t)l * 256 * 256, 256, nb * 32, scr, F.lane); }
        }
    }
    const int gt = F.bid * NTHR + F.tid;
    if (gt < 12 * Q_SLOT_WORDS) ((unsigned*)(F.ws + WS_CTL))[gt] = 0u;
    if (gt < 1024) {
        const int v = gt >> 4, i = gt & 15;
        const float inv = __builtin_amdgcn_exp2f(-13.287712379549449f * (float)i * 0.0625f);
        float rev = (float)v * inv * 0.15915494309189535f; rev -= __builtin_rintf(rev);
        ((f32x2*)(F.ws + WS_CS))[gt] = (f32x2){__builtin_amdgcn_cosf(rev), __builtin_amdgcn_sinf(rev)};
    }
    if (gt >= 1024 && gt < 1024 + 8192) {
        const int id = gt - 1024, ldg = id >> 6, p = id & 63;
        const float lr = F.in[14][id], li = F.in[15][id]; const float dt = exp_f(F.in[16][ldg]);
        f32x2* AP = (f32x2*)(F.ws + WS_APOW) + (size_t)ldg * 17 * 64 + p;
        float a1r = 1.f, a1i = 0.f;
        for (int n = 0; n <= 16; ++n) {
            const float mag = exp_f((float)n * lr * dt);
            double a = (double)n * (double)li * (double)dt * 0.15915494309189535; a -= rint(a);
            const float rev = (float)a; const float cr = mag * __builtin_amdgcn_cosf(rev), ci = mag * __builtin_amdgcn_sinf(rev);
            AP[n * 64] = (f32x2){cr, ci};
            if (n == 1) { a1r = cr; a1i = ci; }
        }
        const float den = lr * lr + li * li;
        const float gr = ((a1r - 1.f) * lr + a1i * li) / den, gi = (a1i * lr - (a1r - 1.f) * li) / den;
        f32x2* BB = (f32x2*)(F.ws + WS_BBAR) + (size_t)id * 16;
        for (int h = 0; h < 16; ++h) { const float br = F.in[17][(size_t)id * 16 + h], bi = F.in[18][(size_t)id * 16 + h]; BB[h] = (f32x2){gr * br - gi * bi, gr * bi + gi * br}; }
    }
}

__device__ __forceinline__ float ssm_kval(const Ctx& F, int ldg, int tau, int h, int h2) {
    const float* cr = F.in[19] + ((size_t)ldg * 16 + h) * 64; const float* ci = F.in[20] + ((size_t)ldg * 16 + h) * 64;
    const f32x2* AP = (const f32x2*)(F.ws + WS_APOW) + ((size_t)ldg * 17 + tau) * 64;
    const f32x2* BB = (const f32x2*)(F.ws + WS_BBAR) + (size_t)ldg * 64 * 16 + h2;
    float s = 0.f;
    for (int p = 0; p < 64; ++p) { const f32x2 a = AP[p], b = BB[p * 16]; const float c_r = cr[p], c_i = ci[p];
        const float er = c_r * a.x - c_i * a.y, ei = c_r * a.y + c_i * a.x; s += er * b.x - ei * b.y; }
    return s;
}
__device__ __forceinline__ void phase_prologue2(const Ctx& F) {
    const int gt = F.bid * NTHR + F.tid, NT = F.G * NTHR;
    float* MOD = (float*)(F.ws + WS_MOD); const float* MODP = (const float*)(F.ws + WS_MODP);
    for (int idx = gt; idx < 4 * 17 * NMOD; idx += NT) {
        const int l = idx / (17 * NMOD), n = idx % NMOD;
        float s = F.in[5][l * NMOD + n];
#pragma unroll
        for (int kq = 0; kq < 8; ++kq) s += MODP[(size_t)kq * 4 * 17 * NMOD + idx];
        MOD[idx] = s;
    }
    float* KT = (float*)(F.ws + WS_KT);
    for (int idx = gt; idx < 4 * 2 * 16 * 16 * 256; idx += NT) {
        const int h2 = idx & 15, h = (idx >> 4) & 15, tau = (idx >> 8) & 15, g = (idx >> 12) & 15, dir = (idx >> 16) & 1, l = idx >> 17;
        KT[idx] = ssm_kval(F, (l * 2 + dir) * 16 + g, tau, h, h2);
    }
    bf16_t* SST = (bf16_t*)(F.ws + WS_SST);
    for (int idx = gt; idx < 4 * 16 * 256 * 256; idx += NT) {
        const int k = idx & 255, n = (idx >> 8) & 255, g = (idx >> 16) & 15, l = idx >> 20;
        const int dir = n >> 7, ri = (n >> 6) & 1, p = n & 63, j = k >> 4, h2 = k & 15, pw = dir == 0 ? 15 - j : j, ldg = (l * 2 + dir) * 16 + g;
        const f32x2 a = ((const f32x2*)(F.ws + WS_APOW))[((size_t)ldg * 17 + pw) * 64 + p];
        const f32x2 b = ((const f32x2*)(F.ws + WS_BBAR))[((size_t)ldg * 64 + p) * 16 + h2];
        SST[idx] = f2bf(ri == 0 ? (a.x * b.x - a.y * b.y) : (a.x * b.y + a.y * b.x));
    }
}
__device__ __forceinline__ void phase_prologue3(const Ctx& F) {
    const int gt = F.bid * NTHR + F.tid, NT = F.G * NTHR;
    bf16_t* SOUT = (bf16_t*)(F.ws + WS_SOUT); const float* KT = (const float*)(F.ws + WS_KT);
    for (int idx = gt; idx < 4 * 16 * 256 * 512; idx += NT) {
        const int k = idx & 511, row = (idx >> 9) & 255, g = (idx >> 17) & 15, l = idx >> 21, t = row >> 4, h = row & 15;
        float val = 0.f;
        if (k < 256) { const int j = k >> 4, h2 = k & 15;
            if (j <= t) val += KT[(((((size_t)l * 2 + 0) * 16 + g) * 16 + (t - j)) * 16 + h) * 16 + h2];
            if (j >= t) val += KT[(((((size_t)l * 2 + 1) * 16 + g) * 16 + (j - t)) * 16 + h) * 16 + h2];
            if (j == t && h == h2) val += F.in[21][l * 256 + g * 16 + h];
        } else { const int kk = k - 256, dir = kk >> 7, ri = (kk >> 6) & 1, p = kk & 63, n = dir == 0 ? t + 1 : 16 - t, ldg = (l * 2 + dir) * 16 + g;
            const float c_r = F.in[19][((size_t)ldg * 16 + h) * 64 + p], c_i = F.in[20][((size_t)ldg * 16 + h) * 64 + p];
            const f32x2 a = ((const f32x2*)(F.ws + WS_APOW))[((size_t)ldg * 17 + n) * 64 + p];
            const float er = c_r * a.x - c_i * a.y, ei = c_r * a.y + c_i * a.x; val = ri == 0 ? er : -ei; }
        SOUT[idx] = f2bf(val);
    }
}

__device__ __forceinline__ void phase_rowwise(const Ctx& F, bool first, bool has_y, bool y2, bool write_h, int nrows, float fac,
                                              const float* gpost, const float* modg  , int gate_idx,
                                              const float* gpre, const float* modh  , int shift_idx, int scale_idx) {
    const int gw = F.bid * NWAVES + F.wave, NGW = F.G * NWAVES, lane = F.lane;
    const bf16_t* Y = (const bf16_t*)(F.ws + WS_Y); bf16_t* H = (bf16_t*)(F.ws + WS_H);
    constexpr int NR = 2;
    for (int rb = gw; rb < nrows; rb += NR * NGW) {
        f32x4 xv[NR][4], yv[NR][4]; float* xr[NR]; int b17[NR]; bool ok[NR]; int rr[NR];
#pragma unroll
        for (int k = 0; k < NR; ++k) {
            const int r0 = rb + k * NGW; ok[k] = r0 < nrows; const int r = ok[k] ? r0 : rb; rr[k] = r;
            b17[k] = r < ML ? (r >> 12) : 16; xr[k] = xrow_ptr(F, r);
            const float* xs = first ? (r < ML ? F.in[0] + (size_t)r * DM : F.in[2] + (size_t)(r - ML) * DM) : xr[k];
#pragma unroll
            for (int j = 0; j < 4; ++j) xv[k][j] = __builtin_nontemporal_load((const f32x4*)(xs + 4 * lane + 256 * j));
            if (has_y) {
#pragma unroll
                for (int j = 0; j < 4; ++j) { const u32x2 w = __builtin_nontemporal_load((const u32x2*)(Y + (size_t)r * DM + 4 * lane + 256 * j));
                    yv[k][j] = (f32x4){bf2f((unsigned short)(w.x & 0xffff)), bf2f((unsigned short)(w.x >> 16)), bf2f((unsigned short)(w.y & 0xffff)), bf2f((unsigned short)(w.y >> 16))}; }
                if (y2 && r >= ML) {
#pragma unroll
                    for (int j = 0; j < 4; ++j) { const u32x2 w = __builtin_nontemporal_load((const u32x2*)((const bf16_t*)(F.ws + WS_Y2) + (size_t)(r - ML) * DM + 4 * lane + 256 * j));
                        yv[k][j] = yv[k][j] + (f32x4){bf2f((unsigned short)(w.x & 0xffff)), bf2f((unsigned short)(w.x >> 16)), bf2f((unsigned short)(w.y & 0xffff)), bf2f((unsigned short)(w.y >> 16))}; }
                }
            }
        }
        if (has_y) {
            float s[NR];
#pragma unroll
            for (int k = 0; k < NR; ++k) { s[k] = 0.f;
#pragma unroll
                for (int j = 0; j < 4; ++j) s[k] += (yv[k][j][0] * yv[k][j][0] + yv[k][j][1] * yv[k][j][1]) + (yv[k][j][2] * yv[k][j][2] + yv[k][j][3] * yv[k][j][3]); }
#pragma unroll
            for (int o = 1; o < 64; o <<= 1) {
#pragma unroll
                for (int k = 0; k < NR; ++k) s[k] += shx(s[k], lane, o);
            }
#pragma unroll
            for (int k = 0; k < NR; ++k) { const float rs = fac * __builtin_amdgcn_rsqf(s[k] * (1.0f / DM) + EPS);
#pragma unroll
                for (int j = 0; j < 4; ++j) { const f32x4 gp = *(const f32x4*)(gpost + 4 * lane + 256 * j); const f32x4 gt = *(const f32x4*)(modg + (size_t)b17[k] * NMOD + gate_idx * DM + 4 * lane + 256 * j);
                    xv[k][j] = xv[k][j] + gt * (yv[k][j] * rs * gp); } }
        }
        if (has_y || first) {
#pragma unroll
            for (int k = 0; k < NR; ++k) if (ok[k]) {
#pragma unroll
                for (int j = 0; j < 4; ++j) __builtin_nontemporal_store(xv[k][j], (f32x4*)(xr[k] + 4 * lane + 256 * j)); }
        }
        if (write_h) {
            float s[NR];
#pragma unroll
            for (int k = 0; k < NR; ++k) { s[k] = 0.f;
#pragma unroll
                for (int j = 0; j < 4; ++j) s[k] += (xv[k][j][0] * xv[k][j][0] + xv[k][j][1] * xv[k][j][1]) + (xv[k][j][2] * xv[k][j][2] + xv[k][j][3] * xv[k][j][3]); }
#pragma unroll
            for (int o = 1; o < 64; o <<= 1) {
#pragma unroll
                for (int k = 0; k < NR; ++k) s[k] += shx(s[k], lane, o);
            }
#pragma unroll
            for (int k = 0; k < NR; ++k) if (ok[k]) { const float rs = __builtin_amdgcn_rsqf(s[k] * (1.0f / DM) + EPS);
#pragma unroll
                for (int j = 0; j < 4; ++j) { const int c0 = 4 * lane + 256 * j; const f32x4 gp = *(const f32x4*)(gpre + c0);
                    const f32x4 sh = *(const f32x4*)(modh + (size_t)b17[k] * NMOD + shift_idx * DM + c0), sc = *(const f32x4*)(modh + (size_t)b17[k] * NMOD + scale_idx * DM + c0);
                    const f32x4 hv = (xv[k][j] * rs * gp) * (sc + 1.0f) + sh;
                    *(u32x2*)(H + (size_t)rr[k] * DM + c0) = (u32x2){pk2(hv[0], hv[1]), pk2(hv[2], hv[3])}; } }
        }
    }
}

__device__ __forceinline__ int crow(int r, int hi) { return (r & 3) + 8 * (r >> 2) + 4 * hi; }
__device__ __forceinline__ void attn_tile(LAS unsigned char* lb, bool local, int kvstart, int qpos, int q, int hi, int lane, const bf16x8 (&qf)[4], float& mrun, float& lsum, f32x16 (&ot)[2]) {
    f32x16 p0, p1;
#pragma unroll
    for (int i = 0; i < 16; ++i) { p0[i] = 0.f; p1[i] = 0.f; }
#pragma unroll
    for (int s = 0; s < 4; ++s) {
        const bf16x8 a0 = *(const LAS bf16x8*)(lb + q * 144 + 32 * s + 16 * hi);
        const bf16x8 a1 = *(const LAS bf16x8*)(lb + (32 + q) * 144 + 32 * s + 16 * hi);
        p0 = __builtin_amdgcn_mfma_f32_32x32x16_bf16(a0, qf[s], p0, 0, 0, 0);
        p1 = __builtin_amdgcn_mfma_f32_32x32x16_bf16(a1, qf[s], p1, 0, 0, 0);
    }
    if (local) {
#pragma unroll
        for (int i = 0; i < 16; ++i) { const int d0 = kvstart + crow(i, hi) - qpos; if (d0 > 128 || d0 < -128) p0[i] = -1e30f; const int d1 = d0 + 32; if (d1 > 128 || d1 < -128) p1[i] = -1e30f; }
    }
    float mx = p0[0];
#pragma unroll
    for (int i = 1; i < 16; ++i) mx = fmaxf(mx, p0[i]);
#pragma unroll
    for (int i = 0; i < 16; ++i) mx = fmaxf(mx, p1[i]);
    mx = fmaxf(mx, shx(mx, lane, 32));
    const float mnew = fmaxf(mrun, mx), sc = __builtin_amdgcn_exp2f(mrun - mnew); mrun = mnew;
    float ps = 0.f;
#pragma unroll
    for (int i = 0; i < 16; ++i) { p0[i] = __builtin_amdgcn_exp2f(p0[i] - mnew); p1[i] = __builtin_amdgcn_exp2f(p1[i] - mnew); ps += p0[i] + p1[i]; }
    lsum = lsum * sc + ps;
#pragma unroll
    for (int i = 0; i < 16; ++i) { ot[0][i] *= sc; ot[1][i] *= sc; }
    bf16x8 pb[4];
#pragma unroll
    for (int ks = 0; ks < 4; ++ks) {
        u32x4 w;
        if (ks < 2) { w.x = pk2(p0[8 * ks + 0], p0[8 * ks + 1]); w.y = pk2(p0[8 * ks + 2], p0[8 * ks + 3]); w.z = pk2(p0[8 * ks + 4], p0[8 * ks + 5]); w.w = pk2(p0[8 * ks + 6], p0[8 * ks + 7]); }
        else { const int k2 = ks - 2; w.x = pk2(p1[8 * k2 + 0], p1[8 * k2 + 1]); w.y = pk2(p1[8 * k2 + 2], p1[8 * k2 + 3]); w.z = pk2(p1[8 * k2 + 4], p1[8 * k2 + 5]); w.w = pk2(p1[8 * k2 + 6], p1[8 * k2 + 7]); }
        pb[ks] = __builtin_bit_cast(bf16x8, w);
    }
#pragma unroll
    for (int dh = 0; dh < 2; ++dh)
#pragma unroll
        for (int ks = 0; ks < 4; ++ks) {
            const s16x4 lo = *(const LAS s16x4*)(lb + 9216 + (32 * dh + q) * 144 + (16 * ks + 4 * hi) * 2);
            const s16x4 h4 = *(const LAS s16x4*)(lb + 9216 + (32 * dh + q) * 144 + (16 * ks + 8 + 4 * hi) * 2);
            const bf16x8 va = __builtin_shufflevector(lo, h4, 0, 1, 2, 3, 4, 5, 6, 7);
            ot[dh] = __builtin_amdgcn_mfma_f32_32x32x16_bf16(va, pb[ks], ot[dh], 0, 0, 0);
        }
}
__device__ __forceinline__ void attn_unit(const Ctx& F, int b, int kh, int qc, const float* sink  ) {
    const bf16_t* Qb = (const bf16_t*)(F.ws + WS_Q); const bf16_t* Kb = (const bf16_t*)(F.ws + WS_K); const bf16_t* VT = (const bf16_t*)(F.ws + WS_VT); bf16_t* MIX = (bf16_t*)(F.ws + WS_H);
    LAS unsigned char* lds = F.lds;
    const int lane = F.lane, q = lane & 31, hi = lane >> 5, hq = kh * 4 + (F.wave >> 1), qs = F.wave & 1;
    const bool isctx = qc >= 64;
    int qpos; size_t qrow;
    if (!isctx) { qpos = qc * 64 + qs * 32 + q; qrow = (size_t)b * SEQL + qpos; } else { qpos = (qc - 64) * 64 + qs * 32 + q; qrow = (size_t)ML + b * NCTX + qpos; }
    const int ilo = isctx ? 0 : (qc < 2 ? 2 - qc : 0), ihi = isctx ? -1 : (65 - qc < 4 ? 65 - qc : 4), nloc = ihi - ilo + 1, nt = nloc + 4;
    const int row = F.tid >> 3, ch = F.tid & 7;
    const bf16_t* kbase = Kb + (size_t)row * 128 + kh * 64 + ch * 8;
    const bf16_t* vbase = VT + ((size_t)(b * 2 + kh) * 64 + row) * VTP + ch * 8;
#define ATT_LOAD(t, kk, vv) do { const int t_ = (t); size_t kr_; int vi_; \
        if (t_ < nloc) { const int ks_ = qc * 64 - 128 + 64 * (ilo + t_); kr_ = (size_t)b * SEQL + ks_; vi_ = ks_; } else { const int c_ = t_ - nloc; kr_ = (size_t)ML + b * NCTX + 64 * c_; vi_ = SEQL + 64 * c_; } \
        kk = *(const u32x4*)(kbase + kr_ * 128); vv = *(const u32x4*)(vbase + vi_); } while (0)
#define ATT_STORE(bo, kk, vv) do { *(LAS u32x4*)(lds + (bo) + row * 144 + ch * 16) = kk; *(LAS u32x4*)(lds + (bo) + 9216 + row * 144 + ch * 16) = vv; } while (0)
    u32x4 kA, vA, kB, vB;
    ATT_LOAD(0, kA, vA); ATT_LOAD(1, kB, vB);
    bf16x8 qf[4];
#pragma unroll
    for (int s = 0; s < 4; ++s) qf[s] = *(const bf16x8*)(Qb + qrow * 512 + hq * 64 + 16 * s + 8 * hi);
    float mrun = sink[hq] * LOG2E, lsum = hi == 0 ? 1.0f : 0.0f;
    f32x16 ot[2];
#pragma unroll
    for (int i = 0; i < 16; ++i) { ot[0][i] = 0.f; ot[1][i] = 0.f; }
    __syncthreads();
    for (int t = 0; t < nt; t += 2) {
        ATT_STORE(0, kA, vA);
        __syncthreads();
        if (t + 2 < nt) ATT_LOAD(t + 2, kA, vA);
        attn_tile(lds, t < nloc, qc * 64 - 128 + 64 * (ilo + t), qpos, q, hi, lane, qf, mrun, lsum, ot);
        if (t + 1 < nt) {
            ATT_STORE(18432, kB, vB);
            __syncthreads();
            if (t + 3 < nt) ATT_LOAD(t + 3, kB, vB);
            attn_tile(lds + 18432, t + 1 < nloc, qc * 64 - 128 + 64 * (ilo + t + 1), qpos, q, hi, lane, qf, mrun, lsum, ot);
        }
    }
#undef ATT_LOAD
#undef ATT_STORE
    lsum += shx(lsum, lane, 32);
    const float inv = 1.0f / lsum;
#pragma unroll
    for (int dh = 0; dh < 2; ++dh)
#pragma unroll
        for (int g4 = 0; g4 < 4; ++g4) {
            const int d0 = 32 * dh + 8 * g4 + 4 * hi;
            *(u32x2*)(MIX + qrow * 1024 + hq * 64 + d0) = (u32x2){pk2(ot[dh][4 * g4] * inv, ot[dh][4 * g4 + 1] * inv), pk2(ot[dh][4 * g4 + 2] * inv, ot[dh][4 * g4 + 3] * inv)};
        }
}
__device__ __forceinline__ void phase_attn(const Ctx& F, int l, bool lastl) {
    const int nq = lastl ? 64 : 68, nunits = NB * 2 * nq;
    for (int id = F.bid; id < nunits; id += F.G) { const int bk = id / nq, qc = id % nq; attn_unit(F, bk >> 1, bk & 1, qc, F.in[13] + l * 8); }
    __syncthreads();
}

__device__ __forceinline__ void unpack8(const u32x4 v, float* f) {
    f[0] = bf2f((unsigned short)(v.x & 0xffff)); f[1] = bf2f((unsigned short)(v.x >> 16)); f[2] = bf2f((unsigned short)(v.y & 0xffff)); f[3] = bf2f((unsigned short)(v.y >> 16));
    f[4] = bf2f((unsigned short)(v.z & 0xffff)); f[5] = bf2f((unsigned short)(v.z >> 16)); f[6] = bf2f((unsigned short)(v.w & 0xffff)); f[7] = bf2f((unsigned short)(v.w >> 16));
}
__device__ __forceinline__ void phase_conv(const Ctx& F, int l, int nrows) {
    const bf16_t* CZ = (const bf16_t*)(F.ws + WS_CZ); bf16_t* MIX = (bf16_t*)(F.ws + WS_H); const float* cw = F.in[24] + l * 768;
    const int gt = F.bid * NTHR + F.tid, NT = F.G * NTHR;
    for (int idx = gt; idx < nrows * 32; idx += NT) {
        const int r = idx >> 5, c0 = (idx & 31) * 8;
        int pos, len; if (r < ML) { pos = r & 4095; len = SEQL; } else { pos = (r - ML) & 255; len = NCTX; }
        const bf16_t* p = CZ + (size_t)r * 768 + c0;
        float gb[8], gc[8], z[8], tp[8], tn[8], a[8], b2[8];
        unpack8(*(const u32x4*)p, gb); unpack8(*(const u32x4*)(p + 256), gc); unpack8(*(const u32x4*)(p + 512), z);
        if (pos > 0) { unpack8(*(const u32x4*)(p - 768 + 256), a); unpack8(*(const u32x4*)(p - 768 + 512), b2);
#pragma unroll
            for (int i = 0; i < 8; ++i) tp[i] = a[i] * b2[i]; }
        else {
#pragma unroll
            for (int i = 0; i < 8; ++i) tp[i] = 0.f; }
        if (pos < len - 1) { unpack8(*(const u32x4*)(p + 768 + 256), a); unpack8(*(const u32x4*)(p + 768 + 512), b2);
#pragma unroll
            for (int i = 0; i < 8; ++i) tn[i] = a[i] * b2[i]; }
        else {
#pragma unroll
            for (int i = 0; i < 8; ++i) tn[i] = 0.f; }
        float o[8];
#pragma unroll
        for (int i = 0; i < 8; ++i) o[i] = gb[i] * (tp[i] * cw[c0 + i] + (gc[i] * z[i]) * cw[256 + c0 + i] + tn[i] * cw[512 + c0 + i]);
        *(u32x4*)(MIX + (size_t)r * 1024 + 768 + c0) = (u32x4){pk2(o[0], o[1]), pk2(o[2], o[3]), pk2(o[4], o[5]), pk2(o[6], o[7])};
    }
}

__device__ __forceinline__ int scan_chunk(int b, int dir, int step) {
    return step < 16 ? NB * 256 + b * 16 + (dir == 0 ? step : 15 - step) : b * 256 + (dir == 0 ? step - 16 : 271 - step);
}
__device__ __forceinline__ void phase_scan(const Ctx& F, int l) {
    const float* SL = (const float*)(F.ws + WS_SL); bf16_t* SSMA = (bf16_t*)(F.ws + WS_SSMA);
    LAS f32x2* sh = (LAS f32x2*)F.lds;
    for (int id = F.bid; id < 512; id += F.G) {
        const int b = id >> 5, g = (id >> 1) & 15, dir = id & 1, p = F.lane, seg = F.wave, ldg = (l * 2 + dir) * 16 + g;
        const f32x2 a16 = ((const f32x2*)(F.ws + WS_APOW))[((size_t)ldg * 17 + 16) * 64 + p];
        const float ar = a16.x, ai = a16.y;
        const size_t gbase = (size_t)g * NCHUNK;
        float xr[34], xi[34];
#pragma unroll
        for (int j = 0; j < 34; ++j) { const size_t rowc = gbase + scan_chunk(b, dir, seg * 34 + j); xr[j] = SL[rowc * 256 + dir * 128 + p]; xi[j] = SL[rowc * 256 + dir * 128 + 64 + p]; }
        float sr = 0.f, si = 0.f;
#pragma unroll
        for (int j = 0; j < 34; ++j) { const float nr = ar * sr - ai * si + xr[j], ni = ar * si + ai * sr + xi[j]; sr = nr; si = ni; }
        __syncthreads();
        sh[seg * 64 + p] = (f32x2){sr, si};
        float pr = ar, pi = ai, p2r, p2i;
        { const float tr = pr * pr - pi * pi, ti = 2.f * pr * pi; pr = tr; pi = ti; } p2r = pr; p2i = pi;
#pragma unroll
        for (int k = 0; k < 4; ++k) { const float tr = pr * pr - pi * pi, ti = 2.f * pr * pi; pr = tr; pi = ti; }
        { const float tr = pr * p2r - pi * p2i, ti = pr * p2i + pi * p2r; pr = tr; pi = ti; }
        __syncthreads();
        sr = 0.f; si = 0.f;
        for (int s2 = 0; s2 < seg; ++s2) { const f32x2 tt = sh[s2 * 64 + p]; const float nr = pr * sr - pi * si + tt.x, ni = pr * si + pi * sr + tt.y; sr = nr; si = ni; }
#pragma unroll
        for (int j = 0; j < 34; ++j) { const size_t rowc = gbase + scan_chunk(b, dir, seg * 34 + j);
            SSMA[rowc * 512 + 256 + dir * 128 + p] = f2bf(sr); SSMA[rowc * 512 + 256 + dir * 128 + 64 + p] = f2bf(si);
            const float nr = ar * sr - ai * si + xr[j], ni = ar * si + ai * sr + xi[j]; sr = nr; si = ni; }
    }
    __syncthreads();
}

#ifndef MK_MULTI
#define MK_MULTI 0
#endif
constexpr size_t WS_BAR = 195 * MiB + 131072;
constexpr int LDS_BARST_OFF = 131072 + 64;
#define XB_TMO      128
#define XB_XCNT(j)  (256  + 64 * (j))
#define XB_XSUB(j)  (1280 + 64 * (j))
#define XB_XGEN(j)  (2304 + 64 * (j))
#define XB_TOP      3328
#define XB_TOPGEN   3392
#define XCD_BAR_WORDS 3456
#define XB_SPIN_CAP (1u << 20)
__device__ __forceinline__ unsigned xb_ld(unsigned* p)              { return __hip_atomic_load(p, __ATOMIC_RELAXED, __HIP_MEMORY_SCOPE_AGENT); }
__device__ __forceinline__ unsigned xb_add(unsigned* p, unsigned v) { return __hip_atomic_fetch_add(p, v, __ATOMIC_RELAXED, __HIP_MEMORY_SCOPE_AGENT); }
__device__ __forceinline__ unsigned xb_xcc_id() { return (unsigned)__builtin_amdgcn_s_getreg((3 << 11) | 20) & 0xFu; }
#define XB_SPIN(cond, bar) do { unsigned _sp = 0; while (cond) { __builtin_amdgcn_s_sleep(1); \
    if ((++_sp & 255u) == 0u) { if (xb_ld(&(bar)[XB_TMO])) break; if (_sp > XB_SPIN_CAP) { atomicAdd(&(bar)[XB_TMO], 1u); break; } } } } while (0)
struct XcdBarrier { unsigned* bar; unsigned x; volatile LAS unsigned* st; };
__device__ __forceinline__ void xcd_barrier_complete(unsigned* bar, unsigned x, unsigned& nloc, unsigned& nx) {
    const unsigned G = gridDim.x * gridDim.y * gridDim.z;
    unsigned sum, cnt, mine, sp = 0u;
    for (;;) {
        sum = 0u; cnt = 0u; mine = 0u;
#pragma unroll
        for (unsigned j = 0; j < 16; ++j) { const unsigned c = xb_ld(&bar[XB_XCNT(j)]); sum += c; cnt += (c > 0u) ? 1u : 0u; mine = (j == x) ? c : mine; }
        if (sum == G) break;
        __builtin_amdgcn_s_sleep(1);
        if ((++sp & 255u) == 0u) { if (xb_ld(&bar[XB_TMO])) break; if (sp > XB_SPIN_CAP) { atomicAdd(&bar[XB_TMO], 1u); break; } }
    }
    nloc = mine > 0u ? mine : 1u; nx = cnt > 0u ? cnt : 1u;
}
__device__ __forceinline__ void xcd_barrier(const XcdBarrier& b, int tid) {
    asm volatile("s_waitcnt vmcnt(0)" ::: "memory");
    __syncthreads();
    if (tid == 0) {
        unsigned* bar = b.bar;
        __builtin_amdgcn_s_waitcnt(0);
        unsigned nloc = b.st[0], nx = b.st[1];
        if (nloc == 0u) { xcd_barrier_complete(bar, b.x, nloc, nx); b.st[0] = nloc; b.st[1] = nx; }
        const unsigned old = xb_add(&bar[XB_XSUB(b.x)], 1u);
        const unsigned gen = old / nloc;
        if (old + 1u == (gen + 1u) * nloc) {
            __builtin_amdgcn_fence(__ATOMIC_RELEASE, "agent");
            asm volatile("s_waitcnt vmcnt(0)" ::: "memory");
            const unsigned og = xb_add(&bar[XB_TOP], 1u);
            const unsigned tg = og / nx;
            if (og + 1u == (tg + 1u) * nx) xb_add(&bar[XB_TOPGEN], 1u);
            else XB_SPIN(xb_ld(&bar[XB_TOPGEN]) == tg, bar);
            __builtin_amdgcn_fence(__ATOMIC_ACQUIRE, "agent");
            xb_add(&bar[XB_XGEN(b.x)], 1u);
            asm volatile("s_waitcnt vmcnt(0)" ::: "memory");
        } else {
            XB_SPIN(xb_ld(&bar[XB_XGEN(b.x)]) == gen, bar);
            __builtin_amdgcn_fence(__ATOMIC_ACQUIRE, "agent");
            asm volatile("s_waitcnt vmcnt(0)" ::: "memory");
        }
    }
    __syncthreads();
}

#ifndef PROBE_DUP
#define PROBE_DUP 0
#endif
__global__ void __launch_bounds__(NTHR, 2) fwd_megakernel(Args args) {
    extern __shared__ __attribute__((aligned(16))) unsigned char lds_raw[];
    cg::grid_group grid = cg::this_grid();
    Ctx F;
    F.lds = (LAS unsigned char*)lds_raw;
    const int wave_s = __builtin_amdgcn_readfirstlane((int)threadIdx.x >> 6);
#if !MK_MULTI
    {
        volatile LAS unsigned* st0 = (volatile LAS unsigned*)(F.lds + LDS_BARST_OFF);
        if (threadIdx.x == 0) { st0[0] = 0u; st0[1] = 0u; (void)xb_add((unsigned*)(args.ws + WS_BAR) + XB_XCNT(xb_xcc_id()), 1u); }
        __syncthreads();
    }
#endif
    const int lo = args.ph_lo, hi = args.ph_hi < NPHASES ? args.ph_hi : NPHASES;
    for (int ph2 = 2 * lo; ph2 < 2 * hi; ++ph2) {
        const int ph = ph2 >> 1;
        if (ph2 & 1) { if (ph < 3 || !((PROBE_DUP >> ((ph - 3) % 10)) & 1)) continue; }
        const bool seam = ph2 > 2 * lo;
        { CArgs* ap_ = (CArgs*)__builtin_amdgcn_kernarg_segment_ptr(); asm volatile("" : "+s"(ap_)); F.in.ap = ap_; F.out = ap_->out; F.ws = ap_->ws; }
        { int l_ = (int)__builtin_amdgcn_mbcnt_hi(~0u, __builtin_amdgcn_mbcnt_lo(~0u, 0u)); asm volatile("" : "+v"(l_)); int w_ = wave_s, b_ = blockIdx.x, g_ = gridDim.x; asm volatile("" : "+s"(w_), "+s"(b_), "+s"(g_));
          F.lane = l_; F.wave = w_; F.tid = w_ * 64 + l_; F.bid = b_; F.G = g_; }
        if (seam) {
            if (ph == 1 && !(ph2 & 1)) grid.sync();
            else { XcdBarrier xb; xb.bar = (unsigned*)(F.ws + WS_BAR); xb.x = xb_xcc_id(); xb.st = (volatile LAS unsigned*)(F.lds + LDS_BARST_OFF); xcd_barrier(xb, F.tid); }
        }
        bf16_t* H = (bf16_t*)(F.ws + WS_H); bf16_t* Gh = (bf16_t*)(F.ws + WS_G); float* Y = (float*)(F.ws + WS_Y);
        const float* MOD = (const float*)(F.ws + WS_MOD);
        if (ph == 0) { phase_prologue(F); continue; }
        if (ph == 1) { phase_prologue2(F); continue; }
        if (ph == 2) { phase_prologue3(F); phase_rowwise(F, true, false, false, true, MT, 0.f, nullptr, nullptr, 0, F.in[6] + 0, MOD, 0, 1); continue; }
        const int q = ph - 3, l = q / 10, kind = q % 10;
        const bool lastl = (l == DEPTH - 1);
        unsigned* CTL = (unsigned*)(F.ws + WS_CTL);
        if (kind == 0 || kind == 8) {
            const int s = kind == 0 ? 0 : 1; const int Mff = (lastl && s == 1) ? ML : MT;
            pg8::Gemm g{H, (const bf16_t*)(F.ws + WS_WGU) + (size_t)(l * 2 + s) * 5632 * DM, Mff, 5632, DM, DM, DM, 0, 0, 1};
            pg8::StaticOrder S; S.init(Mff, 5632, 1, F.G, F.bid);
            pg8::EpiSwiGLU E{Gh};
            pg8::gemm_phase<pg8::EpiSwiGLU, true, true, false>(F.lds, F.tid, g, S, E);
        } else if (kind == 1 || kind == 9) {
            const int s = kind == 1 ? 0 : 1; const int Mff = (lastl && s == 1) ? ML : MT; const int which = s ? 2 : 0;
            const bool split = (Mff == MT); const int total = 4 * (Mff / 256);
            unsigned* ctl = CTL + (l * 3 + which) * Q_SLOT_WORDS;
            if (F.tid == 0) *(LAS int*)(F.lds + LDS_PEND_OFF) = -1;
            __syncthreads();
            pg8::Gemm g{Gh, (const bf16_t*)(F.ws + WS_WD) + (size_t)(l * 2 + s) * DM * DFF, Mff, DM, DFF, DFF, DFF, 0, 0, 1};
            pg8::StaticOrder S; S.init(ML, DM, 1, F.G, F.bid);
            pg8::EpiBf16YQ E{(bf16_t*)Y, nullptr, ctl, F.in.ap, 0, 4, total, l, which, split};
            pg8::gemm_phase<pg8::EpiBf16YQ, true, true, false>(F.lds, F.tid, g, S, E);
            if (split) {
                pg8::Gemm g2{Gh + (size_t)ML * DFF, g.Bt, MC, DM, DFF / 2, DFF, DFF, (size_t)(DFF / 2) * 2, (size_t)(DFF / 2) * 2, 2};
                pg8::StaticOrder S2; S2.init(MC, DM, 2, F.G, F.bid);
                pg8::EpiBf16YQ E2{(bf16_t*)Y + (size_t)ML * DM, (bf16_t*)(F.ws + WS_Y2), ctl, F.in.ap, ML / 256, 8, total, l, which, split};
                pg8::gemm_phase<pg8::EpiBf16YQ, true, true, true>(F.lds, F.tid, g2, S2, E2);
            }
            rowq_drain(F.lds, ctl, total, F.in.ap, l, which, split, F.tid, F.wave);
        } else if (kind == 2) {
            pg8::Gemm g{H, (const bf16_t*)(F.ws + WS_WIN) + (size_t)l * INC * DM, MT, INC, DM, DM, DM, 0, 0, 1};
            pg8::StaticOrder S; S.init(MT, INC, 1, F.G, F.bid);
            pg8::EpiWin E{(bf16_t*)(F.ws + WS_Q), (bf16_t*)(F.ws + WS_K), (bf16_t*)(F.ws + WS_VT), (bf16_t*)(F.ws + WS_SSMA), (bf16_t*)(F.ws + WS_CZ), (const f32x2*)(F.ws + WS_CS)};
            pg8::gemm_phase<pg8::EpiWin, true, true, false>(F.lds, F.tid, g, S, E);
        } else if (kind == 3) {
            {
            pg8::Gemm g{(const bf16_t*)(F.ws + WS_SSMA), (const bf16_t*)(F.ws + WS_SST) + (size_t)l * 16 * 256 * 256, NCHUNK, 256, 256, 512, 256, (size_t)NCHUNK * 512 * 2, (size_t)256 * 256 * 2, 16};
            pg8::StaticOrder S; S.init(NCHUNK, 256, 16, F.G, F.bid);
            pg8::EpiF32 E{(float*)(F.ws + WS_SL), 256, (size_t)NCHUNK * 256};
            pg8::gemm_phase<pg8::EpiF32, true, true, true>(F.lds, F.tid, g, S, E);
            }
            __syncthreads();
            if (F.bid & 1) { phase_conv(F, l, lastl ? ML : MT); phase_attn(F, l, lastl); }
            else { phase_attn(F, l, lastl); phase_conv(F, l, lastl ? ML : MT); }
        } else if (kind == 4) {
            phase_scan(F, l);
        } else if (kind == 5) {
            pg8::Gemm g{(const bf16_t*)(F.ws + WS_SSMA), (const bf16_t*)(F.ws + WS_SOUT) + (size_t)l * 16 * 256 * 512, NCHUNK, 256, 512, 512, 512, (size_t)NCHUNK * 512 * 2, (size_t)256 * 512 * 2, 16};
            pg8::StaticOrder S; S.init(NCHUNK, 256, 16, F.G, F.bid);
            pg8::EpiSsmOut E{(bf16_t*)(F.ws + WS_YG)};
            pg8::gemm_phase<pg8::EpiSsmOut, true, true, true>(F.lds, F.tid, g, S, E);
        } else if (kind == 6) {
            const int Mg = lastl ? ML : MT;
            pg8::Gemm g{(const bf16_t*)(F.ws + WS_YG), (const bf16_t*)(F.ws + WS_WGLU) + (size_t)l * 256 * 256, Mg, 256, 256, 256, 256, 0, 0, 1};
            pg8::StaticOrder S; S.init(Mg, 256, 1, F.G, F.bid);
            pg8::EpiGlu E{(const bf16_t*)(F.ws + WS_YG), F.in[23] + l * 256, H};
            pg8::gemm_phase<pg8::EpiGlu, true, true, false>(F.lds, F.tid, g, S, E);
        } else {
            const int Mg = lastl ? ML : MT; const int total = 4 * (Mg / 256);
            unsigned* ctl = CTL + (l * 3 + 1) * Q_SLOT_WORDS;
            if (F.tid == 0) *(LAS int*)(F.lds + LDS_PEND_OFF) = -1;
            __syncthreads();
            pg8::Gemm g{H, (const bf16_t*)(F.ws + WS_WOUT) + (size_t)l * DM * DM, Mg, DM, DM, DM, DM, 0, 0, 1};
            pg8::StaticOrder S; S.init(Mg, DM, 1, F.G, F.bid);
            pg8::EpiBf16YQ E{(bf16_t*)Y, nullptr, ctl, F.in.ap, 0, 4, total, l, 1, false};
            pg8::gemm_phase<pg8::EpiBf16YQ, true, true, false>(F.lds, F.tid, g, S, E);
            rowq_drain(F.lds, ctl, total, F.in.ap, l, 1, false, F.tid, F.wave);
        }
    }
}

extern "C" void kernel_launch(void* const* d_in, const int* in_sizes, int n_in, void* d_out, int out_size, void* d_ws, size_t ws_size, hipStream_t stream) {
    static int grid = 0;
    if (grid == 0) {
        if (n_in != 25 || out_size != ML * DM || ws_size < WS_END) { fprintf(stderr, "kernel_launch: unexpected shapes: n_in %d out %d ws %zu\n", n_in, out_size, ws_size); grid = -1; return; }
        int dev = 0, cus = 0, per_cu = 0;
        hipGetDevice(&dev); hipDeviceGetAttribute(&cus, hipDeviceAttributeMultiprocessorCount, dev);
        if (hipFuncSetAttribute((const void*)fwd_megakernel, hipFuncAttributeMaxDynamicSharedMemorySize, LDS_BYTES) != hipSuccess) { fprintf(stderr, "kernel_launch: hipFuncSetAttribute failed\n"); grid = -1; return; }
        if (hipOccupancyMaxActiveBlocksPerMultiprocessor(&per_cu, (const void*)fwd_megakernel, NTHR, LDS_BYTES) != hipSuccess || per_cu < 1) { fprintf(stderr, "kernel_launch: occupancy query says %d\n", per_cu); per_cu = 1; }
        (void)hipGetLastError();
        grid = cus * per_cu;
        fprintf(stderr, "kernel_launch: grid %d (cus %d x %d)\n", grid, cus, per_cu);
    }
    if (grid < 0) return;
    Args a{};
    for (int i = 0; i < 25; ++i) a.in[i] = (const float*)d_in[i];
    a.out = (float*)d_out; a.ws = (unsigned char*)d_ws;
#if MK_MULTI
    for (int p = 0; p < NPHASES; ++p) { a.ph_lo = p; a.ph_hi = p + 1; hipLaunchKernelGGL(fwd_megakernel, dim3(grid), dim3(NTHR), LDS_BYTES, stream, a); }
#else
    a.ph_lo = 0; a.ph_hi = 1 << 20;
    if (hipMemsetAsync((char*)d_ws + WS_BAR, 0, 16384, stream) != hipSuccess) { fprintf(stderr, "kernel_launch: memset of the barrier words failed\n"); return; }
    void* kargs[] = {&a};
    hipError_t e = hipLaunchCooperativeKernel((const void*)fwd_megakernel, dim3(grid), dim3(NTHR), kargs, LDS_BYTES, stream);
    if (e != hipSuccess) fprintf(stderr, "cooperative launch failed: %s (grid %d)\n", hipGetErrorString(e), grid);
#endif
}
```

```cpp
#include <hip/hip_runtime.h>
#include <hip/hip_cooperative_groups.h>
#include <cstdio>
#include <cstdint>
namespace cg = cooperative_groups;

#define LAS __attribute__((address_space(3)))
typedef unsigned short bf16_t;
typedef short bf16x8 __attribute__((ext_vector_type(8)));
typedef short s16x4 __attribute__((ext_vector_type(4)));
typedef float f32x4 __attribute__((ext_vector_type(4)));
typedef float f32x16 __attribute__((ext_vector_type(16)));
typedef float f32x2 __attribute__((ext_vector_type(2)));
typedef __bf16 bf16x2_t __attribute__((ext_vector_type(2)));
typedef unsigned u32x4 __attribute__((ext_vector_type(4)));
typedef unsigned u32x2 __attribute__((ext_vector_type(2)));

constexpr int NB = 16, SEQL = 4096, NCTX = 256, DM = 1024, DEPTH = 4;
constexpr int ML = NB * SEQL;
constexpr int MC = NB * NCTX;
constexpr int MT = ML + MC;
constexpr int DFF = 2816, INC = 1792, NMOD = 9 * DM;
constexpr int NCHUNK = MT / 16;
constexpr int VTP = SEQL + NCTX;
constexpr float EPS = 1e-6f;
constexpr float LOG2E = 1.4426950408889634f;
constexpr float QSCALE = 0.125f * LOG2E;

constexpr size_t MiB = 1u << 20;
constexpr size_t WS_WGU = 0;
constexpr size_t WS_WD = 88 * MiB;
constexpr size_t WS_WIN = 132 * MiB;
constexpr size_t WS_WOUT = 146 * MiB;
constexpr size_t WS_WGLU = 154 * MiB;
constexpr size_t WS_SOUT = 155 * MiB;
constexpr size_t WS_SST = 171 * MiB;
constexpr size_t WS_MOD = 179 * MiB;
constexpr size_t WS_MODP = 620 * MiB;
constexpr size_t WS_KT = 660 * MiB;
constexpr size_t WS_APOW = 192 * MiB;
constexpr size_t WS_BBAR = 194 * MiB;
constexpr size_t WS_CS = 195 * MiB;
constexpr size_t WS_XC = 196 * MiB;
constexpr size_t WS_H = 212 * MiB;
constexpr size_t WS_Y = 348 * MiB;
constexpr size_t WS_Y2 = WS_Y + 136 * MiB;
constexpr size_t WS_G = 620 * MiB;
constexpr size_t WS_Q = WS_G;
constexpr size_t WS_K = WS_Q + 68 * MiB;
constexpr size_t WS_VT = WS_K + 17 * MiB;
constexpr size_t WS_SSMA = WS_VT + 17 * MiB;
constexpr size_t WS_SL = WS_SSMA + 68 * MiB;
constexpr size_t WS_CZ = WS_SL + 68 * MiB;
constexpr size_t WS_YG = WS_CZ + 102 * MiB;
constexpr size_t WS_END = 994 * MiB;
static_assert(WS_YG + 34 * MiB <= WS_END, "ws map");
static_assert((size_t)MT * DFF * 2 <= 374 * MiB, "G fits");

__device__ __forceinline__ unsigned pk2(float lo, float hi) { f32x2 v = {lo, hi}; bf16x2_t b = __builtin_convertvector(v, bf16x2_t); return __builtin_bit_cast(unsigned, b); }
__device__ __forceinline__ unsigned short f2bf(float f) { unsigned u = __builtin_bit_cast(unsigned, f); return (unsigned short)((u + 0x7fffu + ((u >> 16) & 1u)) >> 16); }
__device__ __forceinline__ float bf2f(unsigned short b) { return __builtin_bit_cast(float, (unsigned)b << 16); }
__device__ __forceinline__ float silu_f(float g) { return g * __builtin_amdgcn_rcpf(1.0f + __builtin_amdgcn_exp2f(-g * LOG2E)); }
__device__ __forceinline__ float sigmoid_f(float g) { return __builtin_amdgcn_rcpf(1.0f + __builtin_amdgcn_exp2f(-g * LOG2E)); }
__device__ __forceinline__ float gelu_tanh_f(float y) { const float t = 0.7978845608028654f * (y + 0.044715f * y * y * y); return y * __builtin_amdgcn_rcpf(1.0f + __builtin_amdgcn_exp2f(-2.0f * LOG2E * t)); }
__device__ __forceinline__ float shx(float v, int lane, int o) { return __builtin_bit_cast(float, __builtin_amdgcn_ds_bpermute((lane ^ o) << 2, __builtin_bit_cast(int, v))); }
__device__ __forceinline__ float wave_sum(float v, int lane) {
#pragma unroll
    for (int o = 1; o < 64; o <<= 1) v += shx(v, lane, o);
    return v;
}
__device__ __forceinline__ float exp_f(float x) { return __builtin_amdgcn_exp2f(x * LOG2E); }

struct Args { const float* in[25]; float* out; unsigned char* ws; int ph_lo, ph_hi; };
typedef __attribute__((address_space(4))) const Args CArgs;
#define RLXA __ATOMIC_RELAXED, __HIP_MEMORY_SCOPE_AGENT
constexpr size_t WS_CTL = 195 * MiB + 262144;
constexpr int LDS_FLAG_OFF = 131072;
constexpr int Q_CNT = 0, Q_QUEUE = 320, Q_TAIL = 640, Q_HEAD = 704, Q_SLOT_WORDS = 1024;

__device__ __forceinline__ void rowwise_quarter(CArgs* ap, int l, int which, bool y2, int pm, int quarter, int wid, int lane) {
    unsigned char* ws = ap->ws; float* outp = ap->out;
    const bf16_t* Y = (const bf16_t*)(ws + WS_Y); bf16_t* H = (bf16_t*)(ws + WS_H);
    const float* modg = (const float*)(ws + WS_MOD) + (size_t)l * 17 * NMOD;
    const float* npost = ap->in[7] + (size_t)l * 3 * DM + which * DM;
    const bool write_h = !(which == 2 && l == DEPTH - 1);
    const int lh = (which == 2 && l < DEPTH - 1) ? l + 1 : l;
    const float* modh = (const float*)(ws + WS_MOD) + (size_t)lh * 17 * NMOD;
    const float* npre = ap->in[6] + (size_t)lh * 3 * DM + (which == 2 ? 0 : (which + 1) * DM);
    const int shift_idx = which == 2 ? 0 : 3 * (which + 1);
    const float fac = which == 1 ? 1.0f : 0.5f;
    const int b17 = pm < (ML / 256) ? (pm >> 4) : 16;
    const bool add2 = y2 && pm >= (ML / 256);
    f32x4 ca[4], cb[4], cc[4];
#pragma unroll
    for (int j = 0; j < 4; ++j) { const int c0 = 4 * lane + 256 * j;
        ca[j] = *(const f32x4*)(npost + c0) * *(const f32x4*)(modg + (size_t)b17 * NMOD + (2 + 3 * which) * DM + c0) * fac;
        cb[j] = *(const f32x4*)(npre + c0) * (*(const f32x4*)(modh + (size_t)b17 * NMOD + (shift_idx + 1) * DM + c0) + 1.0f);
        cc[j] = *(const f32x4*)(modh + (size_t)b17 * NMOD + shift_idx * DM + c0); }
    constexpr int NR = 4;
    for (int i = 0; i < 8; i += NR) {
        const int r0 = pm * 256 + quarter * 64 + wid * 8 + i;
        f32x4 xv[NR][4], yv[NR][4]; float* xr[NR];
#pragma unroll
        for (int k = 0; k < NR; ++k) { const int r = r0 + k; xr[k] = r < ML ? outp + (size_t)r * DM : (float*)(ws + WS_XC) + (size_t)(r - ML) * DM;
#pragma unroll
            for (int j = 0; j < 4; ++j) {
                const u32x2 w = __builtin_nontemporal_load((const u32x2*)(Y + (size_t)r * DM + 4 * lane + 256 * j));
                yv[k][j] = (f32x4){bf2f((unsigned short)(w.x & 0xffff)), bf2f((unsigned short)(w.x >> 16)), bf2f((unsigned short)(w.y & 0xffff)), bf2f((unsigned short)(w.y >> 16))};
                xv[k][j] = __builtin_nontemporal_load((const f32x4*)(xr[k] + 4 * lane + 256 * j)); }
            if (add2) {
#pragma unroll
                for (int j = 0; j < 4; ++j) { const u32x2 w = __builtin_nontemporal_load((const u32x2*)((const bf16_t*)(ws + WS_Y2) + (size_t)(r - ML) * DM + 4 * lane + 256 * j));
                    yv[k][j] = yv[k][j] + (f32x4){bf2f((unsigned short)(w.x & 0xffff)), bf2f((unsigned short)(w.x >> 16)), bf2f((unsigned short)(w.y & 0xffff)), bf2f((unsigned short)(w.y >> 16))}; }
            } }
        float rs[NR], rs2[NR];
#pragma unroll
        for (int k = 0; k < NR; ++k) { float s = 0.f;
#pragma unroll
            for (int j = 0; j < 4; ++j) s += (yv[k][j][0] * yv[k][j][0] + yv[k][j][1] * yv[k][j][1]) + (yv[k][j][2] * yv[k][j][2] + yv[k][j][3] * yv[k][j][3]);
            rs[k] = s; }
#pragma unroll
        for (int o = 1; o < 64; o <<= 1) {
#pragma unroll
            for (int k = 0; k < NR; ++k) rs[k] += shx(rs[k], lane, o);
        }
#pragma unroll
        for (int k = 0; k < NR; ++k) {
            const float r1 = __builtin_amdgcn_rsqf(rs[k] * (1.0f / DM) + EPS);
            float s2 = 0.f;
#pragma unroll
            for (int j = 0; j < 4; ++j) { xv[k][j] = xv[k][j] + ca[j] * (yv[k][j] * r1); __builtin_nontemporal_store(xv[k][j], (f32x4*)(xr[k] + 4 * lane + 256 * j));
                s2 += (xv[k][j][0] * xv[k][j][0] + xv[k][j][1] * xv[k][j][1]) + (xv[k][j][2] * xv[k][j][2] + xv[k][j][3] * xv[k][j][3]); }
            rs2[k] = s2;
        }
        if (write_h) {
#pragma unroll
            for (int o = 1; o < 64; o <<= 1) {
#pragma unroll
                for (int k = 0; k < NR; ++k) rs2[k] += shx(rs2[k], lane, o);
            }
#pragma unroll
            for (int k = 0; k < NR; ++k) {
                const float r2 = __builtin_amdgcn_rsqf(rs2[k] * (1.0f / DM) + EPS);
#pragma unroll
                for (int j = 0; j < 4; ++j) { const f32x4 hv = (xv[k][j] * r2) * cb[j] + cc[j];
                    *(u32x2*)(H + (size_t)(r0 + k) * DM + 4 * lane + 256 * j) = (u32x2){pk2(hv[0], hv[1]), pk2(hv[2], hv[3])}; }
            }
        }
    }
}
constexpr int LDS_PEND_OFF = LDS_FLAG_OFF + 4;
__device__ __forceinline__ int rowq_step(unsigned* ctl, int total, LAS int* pend) {
    int p = *pend;
    if (p == -1) { const unsigned h = __hip_atomic_fetch_add(ctl + Q_HEAD, 1u, RLXA); p = ((int)h < total) ? (int)h : -2; }
    int item = -1;
    if (p >= 0) { const unsigned qe = __hip_atomic_load(ctl + Q_QUEUE + (p >> 2), RLXA); if (qe != 0u) { item = (int)(((qe - 1u) << 2) | ((unsigned)p & 3u)); p = -1; } }
    *pend = p;
    return item;
}
__device__ __forceinline__ void rowq_drain(LAS unsigned char* lds, unsigned* ctl, int total, CArgs* ap, int l, int which, bool y2, int tid, int wid) {
    LAS int* lflag = (LAS int*)(lds + LDS_FLAG_OFF); LAS int* pend = (LAS int*)(lds + LDS_PEND_OFF);
    for (;;) {
        __builtin_amdgcn_s_barrier();
        if (tid == 0) {
            int item = -1; int p = *pend;
            if (p == -1) { const unsigned h = __hip_atomic_fetch_add(ctl + Q_HEAD, 1u, RLXA); p = ((int)h < total) ? (int)h : -2; }
            if (p >= 0) {
                unsigned qe = 0u, spins = 0u;
                for (;;) { qe = __hip_atomic_load(ctl + Q_QUEUE + (p >> 2), RLXA); if (qe != 0u) break; __builtin_amdgcn_s_sleep(16); if (++spins > (1u << 21)) break; }
                if (qe != 0u) { item = (int)(((qe - 1u) << 2) | ((unsigned)p & 3u)); p = -1; } else p = -2;
            }
            *pend = p;
            if (item >= 0) { __builtin_amdgcn_fence(__ATOMIC_ACQUIRE, "agent"); asm volatile("s_waitcnt vmcnt(0)" ::: "memory"); }
            *lflag = item;
        }
        asm volatile("s_waitcnt lgkmcnt(0)" ::: "memory");
        __builtin_amdgcn_s_barrier();
        const int it = __builtin_amdgcn_readfirstlane(*lflag);
        if (it < 0) break;
        int lane = (int)__builtin_amdgcn_mbcnt_hi(~0u, __builtin_amdgcn_mbcnt_lo(~0u, 0u)); asm volatile("" : "+v"(lane));
        rowwise_quarter(ap, l, which, y2, it >> 2, it & 3, wid, lane);
    }
}

namespace pg8 {
constexpr int BM = 256, BK = 64, HALF = 128, HTB = HALF * BK * 2, STAGE_BYTES = 8 * HTB, NXCD = 8, WGM = 4;
__host__ __device__ __forceinline__ int lds_byte(int r, int c) { const int st = (r >> 4) * 2 + (c >> 5), rr = r & 15, cc = c & 31, ob = rr * 64 + cc * 2; return st * 1024 + (ob ^ (((ob >> 9) & 1) << 5)); }
__host__ __device__ __forceinline__ void stage_rc(int b, int& R, int& C) { const int st = b / 1024, sb = b % 1024, swz = sb ^ (((sb >> 9) & 1) << 5); R = (st >> 1) * 16 + swz / 64; C = (st & 1) * 32 + (swz % 64) / 2; }
__host__ __device__ __forceinline__ int perm32(int rho) { const int n = rho >> 4, i = rho & 15; return 8 * (i >> 2) + 4 * n + (i & 3); }

struct Unit { int pm, pn, z; };
struct Gemm { const bf16_t* A; const bf16_t* Bt; int M, N, K, lda, ldb; size_t zsA, zsB; int nz; };

struct StaticOrder {
    int nM, nN, nwg, G, c, nz;
    __device__ void init(int M, int N, int nz_, int G_, int c_) { nM = M / BM; nN = N / BM; nwg = nM * nN; G = G_; c = c_; nz = nz_; }
    __device__ bool next(int i, Unit& u) const {
        const long L = (long)i * G + c; if (L >= (long)nwg * nz) return false;
        u.z = (int)(L / nwg);
        int wgid = (int)(L % nwg); { const int q = nwg / NXCD, r = nwg % NXCD, xcd = wgid % NXCD, off = wgid / NXCD; wgid = (xcd < r ? xcd * (q + 1) : r * (q + 1) + (xcd - r) * q) + off; }
        const int nig = WGM * nN, gid = wgid / nig, fm = gid * WGM, gsz = (nM - fm) < WGM ? (nM - fm) : WGM;
        u.pm = fm + ((wgid % nig) % gsz); u.pn = (wgid % nig) / gsz; return true;
    }
};

template <class Epi, bool ALIGN_EPI, bool SP2, bool ZB>
__device__ __forceinline__ void gemm_phase(LAS unsigned char* lds, const int tid, const Gemm g, const StaticOrder& S, const Epi& E) {
    const int wid = __builtin_amdgcn_readfirstlane(tid >> 6), lane = tid & 63, wr = wid >> 2, wc = wid & 3, fr = lane & 15, fq = lane >> 4;
    const int K = g.K, nt = K / BK, lda = g.lda, ldb = g.ldb;
    unsigned voffA[2], voffB[2];
#pragma unroll
    for (int i = 0; i < 2; ++i) { int R, C; stage_rc(tid * 16 + i * 8192, R, C); const int Rb = Epi::PERM ? ((R & ~31) + perm32(R & 31)) : R;
        voffA[i] = (unsigned)(R * lda + C) * 2u; voffB[i] = (unsigned)(Rb * ldb + C) * 2u; }
    const size_t kstep = (size_t)(BK * 2);
    const size_t hstepA = (size_t)HALF * lda * 2, hstepB = (size_t)HALF * ldb * 2;
    const size_t tstepA = 2 * hstepA, tstepB = 2 * hstepB;
    const unsigned ldsw = (unsigned)wid * 1024u;
    const int aoff = lds_byte(wr * 64 + fr, fq * 8), boff = lds_byte(wc * 32 + fr, fq * 8);
#define PG8_SA(b, h) (((b) * 2 + (h)) * HTB)
#define PG8_SB(b, h) ((4 + (b) * 2 + (h)) * HTB)
#define PG8_STAGE(bufoff, gbase, voff) do { _Pragma("unroll") for (int _i = 0; _i < 2; ++_i) { unsigned _vo = (voff)[_i]; asm volatile("" : "+v"(_vo)); \
        __builtin_amdgcn_global_load_lds((const unsigned*)((const char*)(gbase) + _vo), (LAS unsigned*)(lds + (bufoff) + ldsw + _i * 8192), 16, 0, 0); } } while (0)
#define PG8_LDA(dst, b, h) do { _Pragma("unroll") for (int m = 0; m < 4; ++m) _Pragma("unroll") for (int k = 0; k < 2; ++k) dst[m][k] = *(const LAS bf16x8*)(lds + PG8_SA(b, h) + aoff + m * 2048 + k * 1024); } while (0)
#define PG8_LDB(dst, b, h) do { _Pragma("unroll") for (int n = 0; n < 2; ++n) _Pragma("unroll") for (int k = 0; k < 2; ++k) dst[n][k] = *(const LAS bf16x8*)(lds + PG8_SB(b, h) + boff + n * 2048 + k * 1024); } while (0)
#define PG8_MMA(ai, bj, At, Bt) do { __builtin_amdgcn_s_setprio(1); _Pragma("unroll") for (int m = 0; m < 4; ++m) _Pragma("unroll") for (int n = 0; n < 2; ++n) _Pragma("unroll") for (int k = 0; k < 2; ++k) \
        acc[ai][bj][m][n] = __builtin_amdgcn_mfma_f32_16x16x32_bf16(Bt[n][k], At[m][k], acc[ai][bj][m][n], 0, 0, 0); __builtin_amdgcn_s_setprio(0); } while (0)
#define PG8_WAIT_V(n) asm volatile("s_waitcnt vmcnt(" #n ")" ::: "memory")
#define PG8_WAIT_L(n) asm volatile("s_waitcnt lgkmcnt(" #n ")" ::: "memory")
#define PG8_BAR __builtin_amdgcn_s_barrier()
#define PG8_SCHED __builtin_amdgcn_sched_barrier(0)
    Unit cur, nxt; int ui = 0;
    if (!S.next(0, cur)) return;
    f32x4 acc[2][2][4][2];
#pragma unroll
    for (int a = 0; a < 2; ++a)
#pragma unroll
        for (int b = 0; b < 2; ++b)
#pragma unroll
            for (int m = 0; m < 4; ++m)
#pragma unroll
                for (int n = 0; n < 2; ++n) acc[a][b][m][n] = (f32x4){0.f, 0.f, 0.f, 0.f};
    bf16x8 At[4][2], B0[2][2], B1[2][2];
    const char* cA = (const char*)g.A + (ZB ? (size_t)cur.z * g.zsA : (size_t)0) + (size_t)cur.pm * tstepA; const char* cB = (const char*)g.Bt + (ZB ? (size_t)cur.z * g.zsB : (size_t)0) + (size_t)cur.pn * tstepB;
    if constexpr (SP2) {
        PG8_STAGE(PG8_SB(0, 0), cB, voffB); PG8_STAGE(PG8_SB(0, 1), cB + hstepB, voffB); PG8_STAGE(PG8_SA(0, 0), cA, voffA); PG8_STAGE(PG8_SA(0, 1), cA + hstepA, voffA);
        if (wr == 1) PG8_BAR;
        PG8_WAIT_V(2); PG8_BAR;
        PG8_STAGE(PG8_SB(1, 0), cB + kstep, voffB); PG8_STAGE(PG8_SA(1, 0), cA + kstep, voffA); PG8_STAGE(PG8_SB(1, 1), cB + hstepB + kstep, voffB);
        PG8_WAIT_V(6); PG8_BAR;
    } else {
        PG8_STAGE(PG8_SB(0, 0), cB, voffB); PG8_STAGE(PG8_SA(0, 0), cA, voffA); PG8_STAGE(PG8_SB(0, 1), cB + hstepB, voffB); PG8_STAGE(PG8_SA(0, 1), cA + hstepA, voffA);
        if (wr == 1) PG8_BAR;
        PG8_WAIT_V(4); PG8_BAR;
        PG8_STAGE(PG8_SB(1, 0), cB + kstep, voffB); PG8_STAGE(PG8_SA(1, 0), cA + kstep, voffA); PG8_STAGE(PG8_SB(1, 1), cB + hstepB + kstep, voffB);
        PG8_WAIT_V(6); PG8_BAR;
    }
    for (;;) {
        const bool has_next = S.next(ui + 1, nxt);
        const char* nA = has_next ? (const char*)g.A + (ZB ? (size_t)nxt.z * g.zsA : (size_t)0) + (size_t)nxt.pm * tstepA : cA; const char* nB = has_next ? (const char*)g.Bt + (ZB ? (size_t)nxt.z * g.zsB : (size_t)0) + (size_t)nxt.pn * tstepB : cB;
        for (int t = 0; t < nt; t += 2) {
            const bool last = (t == nt - 2);
            const char* a1 = cA + (size_t)(t + 1) * kstep;
            const char* a2 = last ? nA : cA + (size_t)(t + 2) * kstep; const char* b2 = last ? nB : cB + (size_t)(t + 2) * kstep;
            const char* a3 = a2 + kstep; const char* b3 = b2 + kstep;
            if constexpr (SP2) {
            PG8_LDB(B0, 0, 0); PG8_LDB(B1, 0, 1); PG8_SCHED; PG8_LDA(At, 0, 0); PG8_STAGE(PG8_SA(1, 1), a1 + hstepA, voffA);
            PG8_WAIT_V(8); PG8_WAIT_L(0); PG8_BAR; PG8_MMA(0, 0, At, B0); PG8_MMA(0, 1, At, B1); PG8_BAR; PG8_SCHED;
            PG8_LDA(At, 0, 1); PG8_STAGE(PG8_SB(0, 0), b2, voffB); PG8_STAGE(PG8_SB(0, 1), b2 + hstepB, voffB); PG8_STAGE(PG8_SA(0, 0), a2, voffA);
            PG8_WAIT_V(8); PG8_WAIT_L(0); PG8_BAR; PG8_MMA(1, 0, At, B0); PG8_MMA(1, 1, At, B1); PG8_BAR; PG8_SCHED;
            PG8_LDB(B0, 1, 0); PG8_LDB(B1, 1, 1); PG8_SCHED; PG8_LDA(At, 1, 0); PG8_STAGE(PG8_SA(0, 1), a2 + hstepA, voffA);
            PG8_WAIT_V(8); PG8_WAIT_L(0); PG8_BAR; PG8_MMA(0, 0, At, B0); PG8_MMA(0, 1, At, B1); PG8_BAR; PG8_SCHED;
            PG8_LDA(At, 1, 1); PG8_STAGE(PG8_SB(1, 0), b3, voffB); PG8_STAGE(PG8_SB(1, 1), b3 + hstepB, voffB); PG8_STAGE(PG8_SA(1, 0), a3, voffA);
            PG8_WAIT_V(8); PG8_WAIT_L(0); PG8_BAR; PG8_MMA(1, 0, At, B0); PG8_MMA(1, 1, At, B1); PG8_BAR; PG8_SCHED;
            } else {
            PG8_LDB(B0, 0, 0); PG8_SCHED; PG8_LDA(At, 0, 0); PG8_STAGE(PG8_SA(1, 1), a1 + hstepA, voffA);
            PG8_WAIT_L(8); PG8_BAR; PG8_WAIT_L(0); PG8_MMA(0, 0, At, B0); PG8_BAR; PG8_SCHED;
            PG8_LDB(B1, 0, 1); PG8_STAGE(PG8_SB(0, 0), b2, voffB);
            PG8_BAR; PG8_WAIT_L(0); PG8_MMA(0, 1, At, B1); PG8_BAR;
            PG8_LDA(At, 0, 1); PG8_STAGE(PG8_SA(0, 0), a2, voffA);
            PG8_BAR; PG8_WAIT_L(0); PG8_MMA(1, 0, At, B0); PG8_BAR; PG8_SCHED;
            PG8_STAGE(PG8_SB(0, 1), b2 + hstepB, voffB);
            PG8_WAIT_V(6); PG8_BAR; PG8_MMA(1, 1, At, B1); PG8_BAR;
            PG8_LDB(B0, 1, 0); PG8_SCHED; PG8_LDA(At, 1, 0); PG8_STAGE(PG8_SA(0, 1), a2 + hstepA, voffA);
            PG8_WAIT_L(8); PG8_BAR; PG8_WAIT_L(0); PG8_MMA(0, 0, At, B0); PG8_BAR; PG8_SCHED;
            PG8_LDB(B1, 1, 1); PG8_STAGE(PG8_SB(1, 0), b3, voffB);
            PG8_BAR; PG8_WAIT_L(0); PG8_MMA(0, 1, At, B1); PG8_BAR;
            PG8_LDA(At, 1, 1); PG8_STAGE(PG8_SA(1, 0), a3, voffA);
            PG8_BAR; PG8_WAIT_L(0); PG8_MMA(1, 0, At, B0); PG8_BAR; PG8_SCHED;
            PG8_STAGE(PG8_SB(1, 1), b3 + hstepB, voffB);
            PG8_WAIT_V(6); PG8_BAR; PG8_MMA(1, 1, At, B1); PG8_BAR;
            }
        }
        if constexpr (ALIGN_EPI) { if (wr == 0) PG8_BAR; }
        { const int lane_e = (int)__builtin_amdgcn_mbcnt_hi(~0u, __builtin_amdgcn_mbcnt_lo(~0u, 0u)); E(acc, cur, wr, wc, lane_e); }
        if constexpr (Epi::HAS_DONE) E.done(cur, lds, tid, wid);
        if (!has_next) break;
#pragma unroll
        for (int a = 0; a < 2; ++a)
#pragma unroll
            for (int b = 0; b < 2; ++b)
#pragma unroll
                for (int m = 0; m < 4; ++m)
#pragma unroll
                    for (int n = 0; n < 2; ++n) acc[a][b][m][n] = (f32x4){0.f, 0.f, 0.f, 0.f};
        cur = nxt; cA = nA; cB = nB; ++ui;
        if constexpr (ALIGN_EPI) { if (wr == 1) PG8_BAR; }
    }
    PG8_WAIT_V(0);
    if constexpr (!ALIGN_EPI) { if (wr == 0) PG8_BAR; }
    PG8_BAR;
#undef PG8_SA
#undef PG8_SB
#undef PG8_STAGE
#undef PG8_LDA
#undef PG8_LDB
#undef PG8_MMA
#undef PG8_WAIT_V
#undef PG8_WAIT_L
#undef PG8_BAR
#undef PG8_SCHED
}

typedef f32x4 Acc[2][2][4][2];

struct EpiSwiGLU {
    static constexpr bool PERM = true, HAS_DONE = false;
    bf16_t* G;
    __device__ __forceinline__ void operator()(const Acc& acc, const Unit& u, int wr, int wc, int lane) const {
        asm volatile("" : "+v"(lane)); const int fr = lane & 15, fq = lane >> 4;
        const int row0 = u.pm * BM + wr * 64 + fr, col0 = u.pn * 128 + wc * 32 + 8 * fq;
#pragma unroll
        for (int ai = 0; ai < 2; ++ai)
#pragma unroll
            for (int m = 0; m < 4; ++m) {
                const f32x4 g0 = acc[ai][0][m][0], g1 = acc[ai][0][m][1], u0 = acc[ai][1][m][0], u1 = acc[ai][1][m][1];
                u32x4 w;
                w.x = pk2(silu_f(g0[0]) * u0[0], silu_f(g0[1]) * u0[1]); w.y = pk2(silu_f(g0[2]) * u0[2], silu_f(g0[3]) * u0[3]);
                w.z = pk2(silu_f(g1[0]) * u1[0], silu_f(g1[1]) * u1[1]); w.w = pk2(silu_f(g1[2]) * u1[2], silu_f(g1[3]) * u1[3]);
                *(u32x4*)(G + (size_t)(row0 + ai * HALF + m * 16) * DFF + col0) = w;
            }
    }
};

struct EpiF32 {
    static constexpr bool PERM = false, HAS_DONE = false;
    float* Y; int ldc; size_t zs;
    __device__ __forceinline__ void operator()(const Acc& acc, const Unit& u, int wr, int wc, int lane) const {
        asm volatile("" : "+v"(lane)); const int fr = lane & 15, fq = lane >> 4;
        float* base = Y + (size_t)u.z * zs;
        const int row0 = u.pm * BM + wr * 64 + fr, col0 = u.pn * BM + wc * 32 + 4 * fq;
#pragma unroll
        for (int ai = 0; ai < 2; ++ai)
#pragma unroll
            for (int m = 0; m < 4; ++m) { float* rp = base + (size_t)(row0 + ai * HALF + m * 16) * ldc + col0;
#pragma unroll
                for (int bj = 0; bj < 2; ++bj)
#pragma unroll
                    for (int n = 0; n < 2; ++n) *(f32x4*)(rp + bj * HALF + n * 16) = acc[ai][bj][m][n]; }
    }
};

struct EpiBf16Y {
    static constexpr bool PERM = true, HAS_DONE = false;
    bf16_t* Y; bf16_t* Yz1;
    __device__ __forceinline__ void operator()(const Acc& acc, const Unit& u, int wr, int wc, int lane) const {
        asm volatile("" : "+v"(lane)); const int fr = lane & 15, fq = lane >> 4;
        const int row0 = u.pm * BM + wr * 64 + fr, col0 = u.pn * BM + wc * 32 + 8 * fq;
        bf16_t* Yb = u.z ? Yz1 : Y;
#pragma unroll
        for (int ai = 0; ai < 2; ++ai)
#pragma unroll
            for (int m = 0; m < 4; ++m) { bf16_t* rp = Yb + (size_t)(row0 + ai * HALF + m * 16) * DM + col0;
#pragma unroll
                for (int bj = 0; bj < 2; ++bj) { const f32x4 a0 = acc[ai][bj][m][0], a1 = acc[ai][bj][m][1];
                    *(u32x4*)(rp + bj * HALF) = (u32x4){pk2(a0[0], a0[1]), pk2(a0[2], a0[3]), pk2(a1[0], a1[1]), pk2(a1[2], a1[3])}; } }
    }
};

#ifndef YQ_STORE_AUX
#define YQ_STORE_AUX "sc0 sc1"
#endif
struct EpiBf16YQ {
    static constexpr bool PERM = true, HAS_DONE = true;
    bf16_t* Y; bf16_t* Yz1; unsigned* ctl; CArgs* ap; int pm_off, need, total, l, which; bool y2;
    __device__ __forceinline__ void operator()(const Acc& acc, const Unit& u, int wr, int wc, int lane) const {
        asm volatile("" : "+v"(lane)); const int fr = lane & 15, fq = lane >> 4;
        const int row0 = u.pm * BM + wr * 64 + fr, col0 = u.pn * BM + wc * 32 + 8 * fq;
        bf16_t* Yb = u.z ? Yz1 : Y;
#pragma unroll
        for (int ai = 0; ai < 2; ++ai)
#pragma unroll
            for (int m = 0; m < 4; ++m) { bf16_t* rp = Yb + (size_t)(row0 + ai * HALF + m * 16) * DM + col0;
#pragma unroll
                for (int bj = 0; bj < 2; ++bj) { const f32x4 a0 = acc[ai][bj][m][0], a1 = acc[ai][bj][m][1];
                    const u32x4 w = (u32x4){pk2(a0[0], a0[1]), pk2(a0[2], a0[3]), pk2(a1[0], a1[1]), pk2(a1[2], a1[3])};
                    asm volatile("global_store_dwordx4 %0, %1, off " YQ_STORE_AUX "\n\ts_nop 1" :: "v"(rp + bj * HALF), "v"(w) : "memory"); } }
    }
    __device__ __forceinline__ void done(const Unit& u, LAS unsigned char* lds, int tid, int wid) const {
        asm volatile("s_waitcnt vmcnt(0)" ::: "memory");
        __builtin_amdgcn_s_barrier();
        LAS int* lflag = (LAS int*)(lds + LDS_FLAG_OFF);
        if (tid == 0) {
            const int pmg = pm_off + u.pm;
            LAS int* pend = (LAS int*)(lds + LDS_PEND_OFF);
            int p = *pend;
            const unsigned old = __hip_atomic_fetch_add(ctl + Q_CNT + pmg, 1u, RLXA);
            unsigned h = 0u; if (p == -1) h = __hip_atomic_fetch_add(ctl + Q_HEAD, 1u, RLXA);
            if (p == -1) p = ((int)h < total) ? (int)h : -2;
            unsigned qe = 0u; if (p >= 0) qe = __hip_atomic_load(ctl + Q_QUEUE + (p >> 2), RLXA);
            if (old + 1u == (unsigned)need) { const unsigned slot = __hip_atomic_fetch_add(ctl + Q_TAIL, 1u, RLXA); __hip_atomic_store(ctl + Q_QUEUE + slot, (unsigned)pmg + 1u, RLXA); }
            int item = -1;
            if (p >= 0 && qe != 0u) { item = (int)(((qe - 1u) << 2) | ((unsigned)p & 3u)); p = -1; }
            *pend = p;
            if (item >= 0) { __builtin_amdgcn_fence(__ATOMIC_ACQUIRE, "agent"); asm volatile("s_waitcnt vmcnt(0)" ::: "memory"); }
            *lflag = item;
        }
        asm volatile("s_waitcnt lgkmcnt(0)" ::: "memory");
        __builtin_amdgcn_s_barrier();
        const int it = __builtin_amdgcn_readfirstlane(*lflag);
        if (it >= 0) { int lane = (int)__builtin_amdgcn_mbcnt_hi(~0u, __builtin_amdgcn_mbcnt_lo(~0u, 0u)); asm volatile("" : "+v"(lane)); rowwise_quarter(ap, l, which, y2, it >> 2, it & 3, wid, lane); }
    }
};

struct EpiWin {
    static constexpr bool PERM = false, HAS_DONE = false;
    bf16_t *Q, *Kb, *VT, *SSMA, *CZ; const f32x2* CS;
    __device__ __forceinline__ void operator()(const Acc& acc, const Unit& u, int wr, int wc, int lane) const {
        asm volatile("" : "+v"(lane)); const int fr = lane & 15, fq = lane >> 4;
        const int pn = u.pn; const bool isctx = u.pm >= (ML / BM);
        f32x4 cc = {1.f, 1.f, 1.f, 1.f}, ss = {0.f, 0.f, 0.f, 0.f};
#pragma unroll
        for (int ai = 0; ai < 2; ++ai)
#pragma unroll
            for (int m = 0; m < 4; ++m) {
                const int r = u.pm * BM + ai * HALF + wr * 64 + m * 16 + fr;
                int b, pos;
                if (!isctx) { b = r >> 12; pos = r & 4095; } else { const int rc = r - ML; b = rc >> 8; pos = rc & 255; }
                if (pn <= 2 && !isctx) {
                    const int v = (wc & 1) ? (pos & 63) : (pos >> 6);
                    const f32x2* t = CS + v * 16 + 4 * fq;
                    const f32x2 t0 = t[0], t1 = t[1], t2 = t[2], t3 = t[3];
                    cc = (f32x4){t0.x, t1.x, t2.x, t3.x}; ss = (f32x4){t0.y, t1.y, t2.y, t3.y};
                }
#pragma unroll
                for (int bj = 0; bj < 2; ++bj) {
                    const f32x4 a0 = acc[ai][bj][m][0], a1 = acc[ai][bj][m][1];
                    const int cl = 128 * bj + 32 * wc + 4 * fq;
                    if (pn <= 1) {
                        f32x4 o0, o1;
                        if (!isctx) { o0 = a0 * cc - a1 * ss; o1 = a1 * cc + a0 * ss; } else { o0 = a0; o1 = a1; }
                        o0 = o0 * QSCALE; o1 = o1 * QSCALE;
                        bf16_t* p = Q + (size_t)r * 512 + pn * 256 + cl;
                        *(u32x2*)p = (u32x2){pk2(o0[0], o0[1]), pk2(o0[2], o0[3])}; *(u32x2*)(p + 16) = (u32x2){pk2(o1[0], o1[1]), pk2(o1[2], o1[3])};
                    } else if (pn == 2) {
                        if (bj == 0) {
                            f32x4 o0, o1;
                            if (!isctx) { o0 = a0 * cc - a1 * ss; o1 = a1 * cc + a0 * ss; } else { o0 = a0; o1 = a1; }
                            bf16_t* p = Kb + (size_t)r * 128 + 32 * wc + 4 * fq;
                            *(u32x2*)p = (u32x2){pk2(o0[0], o0[1]), pk2(o0[2], o0[3])}; *(u32x2*)(p + 16) = (u32x2){pk2(o1[0], o1[1]), pk2(o1[2], o1[3])};
                        } else {
                            const int vc = 32 * wc + 4 * fq;
                            const int pidx = isctx ? (SEQL + pos) : pos;
                            bf16_t* p = VT + ((size_t)(b * 2 + (vc >> 6)) * 64 + (vc & 63)) * VTP + pidx;
#pragma unroll
                            for (int j = 0; j < 4; ++j) { p[(size_t)j * VTP] = f2bf(a0[j]); p[(size_t)(j + 16) * VTP] = f2bf(a1[j]); }
                        }
                    } else if (pn == 3) {
                        const int g0 = 8 * bj + 2 * wc;
                        bf16_t* p = SSMA + ((size_t)g0 * NCHUNK + (r >> 4)) * 512 + (r & 15) * 16 + 4 * fq;
                        *(u32x2*)p = (u32x2){pk2(a0[0], a0[1]), pk2(a0[2], a0[3])};
                        *(u32x2*)(p + (size_t)NCHUNK * 512) = (u32x2){pk2(a1[0], a1[1]), pk2(a1[2], a1[3])};
                    } else {
                        bf16_t* p = CZ + (size_t)r * 768 + (pn - 4) * 256 + cl;
                        *(u32x2*)p = (u32x2){pk2(a0[0], a0[1]), pk2(a0[2], a0[3])}; *(u32x2*)(p + 16) = (u32x2){pk2(a1[0], a1[1]), pk2(a1[2], a1[3])};
                    }
                }
            }
    }
};

struct EpiSsmOut {
    static constexpr bool PERM = false, HAS_DONE = false;
    bf16_t* YG;
    __device__ __forceinline__ void operator()(const Acc& acc, const Unit& u, int wr, int wc, int lane) const {
        asm volatile("" : "+v"(lane)); const int fr = lane & 15, fq = lane >> 4;
#pragma unroll
        for (int ai = 0; ai < 2; ++ai)
#pragma unroll
            for (int m = 0; m < 4; ++m) {
                const int r = u.pm * BM + ai * HALF + wr * 64 + m * 16 + fr;
#pragma unroll
                for (int bj = 0; bj < 2; ++bj)
#pragma unroll
                    for (int n = 0; n < 2; ++n) {
                        const int t = 8 * bj + 2 * wc + n; const f32x4 a = acc[ai][bj][m][n];
                        bf16_t* p = YG + (size_t)(r * 16 + t) * 256 + u.z * 16 + 4 * fq;
                        *(u32x2*)p = (u32x2){pk2(gelu_tanh_f(a[0]), gelu_tanh_f(a[1])), pk2(gelu_tanh_f(a[2]), gelu_tanh_f(a[3]))};
                    }
            }
    }
};

struct EpiGlu {
    static constexpr bool PERM = true, HAS_DONE = false;
    const bf16_t* YG; const float* bias; bf16_t* MIX;
    __device__ __forceinline__ void operator()(const Acc& acc, const Unit& u, int wr, int wc, int lane) const {
        asm volatile("" : "+v"(lane)); const int fr = lane & 15, fq = lane >> 4;
        const int row0 = u.pm * BM + wr * 64 + fr;
#pragma unroll
        for (int bj = 0; bj < 2; ++bj) {
            const int col0 = bj * HALF + wc * 32 + 8 * fq;
            const f32x4 b0 = *(const f32x4*)(bias + col0), b1 = *(const f32x4*)(bias + col0 + 4);
#pragma unroll
            for (int ai = 0; ai < 2; ++ai)
#pragma unroll
                for (int m = 0; m < 4; ++m) {
                    const size_t r = (size_t)(row0 + ai * HALF + m * 16);
                    const u32x4 gv = *(const u32x4*)(YG + r * 256 + col0);
                    const f32x4 a0 = acc[ai][bj][m][0] + b0, a1 = acc[ai][bj][m][1] + b1;
                    float gg[8];
                    gg[0] = bf2f((unsigned short)(gv.x & 0xffff)); gg[1] = bf2f((unsigned short)(gv.x >> 16)); gg[2] = bf2f((unsigned short)(gv.y & 0xffff)); gg[3] = bf2f((unsigned short)(gv.y >> 16));
                    gg[4] = bf2f((unsigned short)(gv.z & 0xffff)); gg[5] = bf2f((unsigned short)(gv.z >> 16)); gg[6] = bf2f((unsigned short)(gv.w & 0xffff)); gg[7] = bf2f((unsigned short)(gv.w >> 16));
                    u32x4 w;
                    w.x = pk2(gg[0] * sigmoid_f(a0[0]), gg[1] * sigmoid_f(a0[1])); w.y = pk2(gg[2] * sigmoid_f(a0[2]), gg[3] * sigmoid_f(a0[3]));
                    w.z = pk2(gg[4] * sigmoid_f(a1[0]), gg[5] * sigmoid_f(a1[1])); w.w = pk2(gg[6] * sigmoid_f(a1[2]), gg[7] * sigmoid_f(a1[3]));
                    *(u32x4*)(MIX + r * 1024 + 512 + col0) = w;
                }
        }
    }
};
}

constexpr int NWAVES = 8, NTHR = 512;
constexpr int NPHASES = 3 + 10 * DEPTH;
constexpr int LDS_BYTES = 147456;

struct InView { CArgs* ap; __device__ __forceinline__ const float* operator[](int i) const { return ap->in[i]; } };
struct Ctx {
    LAS unsigned char* lds;
    int tid, lane, wave, G, bid;
    InView in;
    float* out; unsigned char* ws;
};

__device__ __forceinline__ float* xrow_ptr(const Ctx& F, int r) { return r < ML ? F.out + (size_t)r * DM : (float*)(F.ws + WS_XC) + (size_t)(r - ML) * DM; }

__device__ __forceinline__ void transpose_item(const float* W, int Nsrc, int k0, int n0, bf16_t* WT, int Kd, int drow0, LAS float* scr, int lane) {
#pragma unroll 8
    for (int i = 0; i < 32; ++i) { const int kk = 2 * i + (lane >> 5); scr[kk * 33 + (lane & 31)] = W[(size_t)(k0 + kk) * Nsrc + n0 + (lane & 31)]; }
    asm volatile("s_waitcnt lgkmcnt(0)" ::: "memory");
    const int c = lane & 7;
#pragma unroll
    for (int j = 0; j < 4; ++j) { const int n = (lane >> 3) + 8 * j; const LAS float* s = scr + (8 * c) * 33 + n;
        u32x4 o; o.x = pk2(s[0 * 33], s[1 * 33]); o.y = pk2(s[2 * 33], s[3 * 33]); o.z = pk2(s[4 * 33], s[5 * 33]); o.w = pk2(s[6 * 33], s[7 * 33]);
        *(u32x4*)(WT + (size_t)(drow0 + n) * Kd + k0 + 8 * c) = o; }
    asm volatile("s_waitcnt lgkmcnt(0)" ::: "memory");
}

__device__ __forceinline__ void phase_prologue(const Ctx& F) {
    const float* c_in = F.in[1]; const float* cctx = F.in[3]; const float* w_ada = F.in[4];
    {
        LAS float* sl = (LAS float*)F.lds;
        float* MODP = (float*)(F.ws + WS_MODP);
        for (int item = F.bid; item < 576; item += F.G) {
            const int l = item / 144, r2 = item % 144, kq = r2 / 18, nb = r2 % 18;
            __syncthreads();
            for (int idx = F.tid; idx < 17 * 128; idx += NTHR) { const int rr = idx >> 7, kk = idx & 127; const float v = rr < 16 ? c_in[rr * DM + kq * 128 + kk] : cctx[kq * 128 + kk]; sl[idx] = v / (1.0f + exp_f(-v)); }
            __syncthreads();
            const int n = nb * 512 + F.tid;
            float acc[17];
#pragma unroll
            for (int r = 0; r < 17; ++r) acc[r] = 0.f;
            const float* wp = w_ada + ((size_t)l * DM + kq * 128) * NMOD + n;
            for (int k0 = 0; k0 < 128; k0 += 16) {
                float w[16];
#pragma unroll
                for (int k = 0; k < 16; ++k) w[k] = __builtin_nontemporal_load(wp + (size_t)(k0 + k) * NMOD);
#pragma unroll
                for (int k = 0; k < 16; ++k) {
#pragma unroll
                    for (int r = 0; r < 17; ++r) acc[r] += sl[r * 128 + k0 + k] * w[k]; }
            }
#pragma unroll
            for (int r = 0; r < 17; ++r) MODP[(((size_t)kq * 4 + l) * 17 + r) * NMOD + n] = acc[r];
        }
        __syncthreads();
    }
    {
        LAS float* scr = (LAS float*)(F.lds + F.wave * 16384);
        const int gw = F.bid * NWAVES + F.wave, NGW = F.G * NWAVES;
        bf16_t* WGU = (bf16_t*)(F.ws + WS_WGU); bf16_t* WD = (bf16_t*)(F.ws + WS_WD); bf16_t* WIN = (bf16_t*)(F.ws + WS_WIN); bf16_t* WOUT = (bf16_t*)(F.ws + WS_WOUT); bf16_t* WGLU = (bf16_t*)(F.ws + WS_WGLU);
        constexpr int I_GU = 16 * 88, I_D = 44 * 32, I_IN = 16 * 56, I_OUT = 16 * 32, I_GLU = 4 * 8;
        constexpr int NITEMS = I_GU * 16 + I_D * 8 + I_IN * 4 + I_OUT * 4 + I_GLU * 4;
        for (int it = gw; it < NITEMS; it += NGW) {
            int r = it;
            if (r < I_GU * 16) { const int up = r / (I_GU * 8); r -= up * I_GU * 8; const int ls = r / I_GU; r %= I_GU; const int kb = r / 88, nb = r % 88, n0 = nb * 32;
                transpose_item(F.in[up ? 9 : 8] + (size_t)ls * DM * DFF, DFF, kb * 64, n0, WGU + (size_t)ls * 5632 * DM, DM, (n0 / 128) * 256 + (n0 % 128) + up * 128, scr, F.lane); continue; }
            r -= I_GU * 16;
            if (r < I_D * 8) { const int ls = r / I_D; r %= I_D; const int kb = r / 32, nb = r % 32;
                transpose_item(F.in[10] + (size_t)ls * DFF * DM, DM, kb * 64, nb * 32, WD + (size_t)ls * DM * DFF, DFF, nb * 32, scr, F.lane); continue; }
            r -= I_D * 8;
            if (r < I_IN * 4) { const int l = r / I_IN; r %= I_IN; const int kb = r / 56, nb = r % 56;
                transpose_item(F.in[11] + (size_t)l * DM * INC, INC, kb * 64, nb * 32, WIN + (size_t)l * INC * DM, DM, nb * 32, scr, F.lane); continue; }
            r -= I_IN * 4;
            if (r < I_OUT * 4) { const int l = r / I_OUT; r %= I_OUT; const int kb = r / 32, nb = r % 32;
                transpose_item(F.in[12] + (size_t)l * DM * DM, DM, kb * 64, nb * 32, WOUT + (size_t)l * DM * DM, DM, nb * 32, scr, F.lane); continue; }
            r -= I_OUT * 4;
            { const int l = r / I_GLU; r %= I_GLU; const int kb = r / 8, nb = r % 8;
                transpose_item(F.in[22] + (size_t)l * 256 * 256, 256, kb * 64, nb * 32, WGLU + (size_t)l * 256 * 256, 256, nb * 32, scr, F.lane); }
        }
    }
    const int gt = F.bid * NTHR + F.tid;
    if (gt < 12 * Q_SLOT_WORDS) ((unsigned*)(F.ws + WS_CTL))[gt] = 0u;
    if (gt < 1024) {
        const int v = gt >> 4, i = gt & 15;
        const float inv = __builtin_amdgcn_exp2f(-13.287712379549449f * (float)i * 0.0625f);
        float rev = (float)v * inv * 0.15915494309189535f; rev -= __builtin_rintf(rev);
        ((f32x2*)(F.ws + WS_CS))[gt] = (f32x2){__builtin_amdgcn_cosf(rev), __builtin_amdgcn_sinf(rev)};
    }
    if (gt >= 1024 && gt < 1024 + 8192) {
        const int id = gt - 1024, ldg = id >> 6, p = id & 63;
        const float lr = F.in[14][id], li = F.in[15][id]; const float dt = exp_f(F.in[16][ldg]);
        f32x2* AP = (f32x2*)(F.ws + WS_APOW) + (size_t)ldg * 17 * 64 + p;
        float a1r = 1.f, a1i = 0.f;
        for (int n = 0; n <= 16; ++n) {
            const float mag = exp_f((float)n * lr * dt);
            double a = (double)n * (double)li * (double)dt * 0.15915494309189535; a -= rint(a);
            const float rev = (float)a; const float cr = mag * __builtin_amdgcn_cosf(rev), ci = mag * __builtin_amdgcn_sinf(rev);
            AP[n * 64] = (f32x2){cr, ci};
            if (n == 1) { a1r = cr; a1i = ci; }
        }
        const float den = lr * lr + li * li;
        const float gr = ((a1r - 1.f) * lr + a1i * li) / den, gi = (a1i * lr - (a1r - 1.f) * li) / den;
        f32x2* BB = (f32x2*)(F.ws + WS_BBAR) + (size_t)id * 16;
        for (int h = 0; h < 16; ++h) { const float br = F.in[17][(size_t)id * 16 + h], bi = F.in[18][(size_t)id * 16 + h]; BB[h] = (f32x2){gr * br - gi * bi, gr * bi + gi * br}; }
    }
}

__device__ __forceinline__ float ssm_kval(const Ctx& F, int ldg, int tau, int h, int h2) {
    const float* cr = F.in[19] + ((size_t)ldg * 16 + h) * 64; const float* ci = F.in[20] + ((size_t)ldg * 16 + h) * 64;
    const f32x2* AP = (const f32x2*)(F.ws + WS_APOW) + ((size_t)ldg * 17 + tau) * 64;
    const f32x2* BB = (const f32x2*)(F.ws + WS_BBAR) + (size_t)ldg * 64 * 16 + h2;
    float s = 0.f;
    for (int p = 0; p < 64; ++p) { const f32x2 a = AP[p], b = BB[p * 16]; const float c_r = cr[p], c_i = ci[p];
        const float er = c_r * a.x - c_i * a.y, ei = c_r * a.y + c_i * a.x; s += er * b.x - ei * b.y; }
    return s;
}
__device__ __forceinline__ void phase_prologue2(const Ctx& F) {
    const int gt = F.bid * NTHR + F.tid, NT = F.G * NTHR;
    float* MOD = (float*)(F.ws + WS_MOD); const float* MODP = (const float*)(F.ws + WS_MODP);
    for (int idx = gt; idx < 4 * 17 * NMOD; idx += NT) {
        const int l = idx / (17 * NMOD), n = idx % NMOD;
        float s = F.in[5][l * NMOD + n];
#pragma unroll
        for (int kq = 0; kq < 8; ++kq) s += MODP[(size_t)kq * 4 * 17 * NMOD + idx];
        MOD[idx] = s;
    }
    float* KT = (float*)(F.ws + WS_KT);
    for (int idx = gt; idx < 4 * 2 * 16 * 16 * 256; idx += NT) {
        const int h2 = idx & 15, h = (idx >> 4) & 15, tau = (idx >> 8) & 15, g = (idx >> 12) & 15, dir = (idx >> 16) & 1, l = idx >> 17;
        KT[idx] = ssm_kval(F, (l * 2 + dir) * 16 + g, tau, h, h2);
    }
    bf16_t* SST = (bf16_t*)(F.ws + WS_SST);
    for (int idx = gt; idx < 4 * 16 * 256 * 256; idx += NT) {
        const int k = idx & 255, n = (idx >> 8) & 255, g = (idx >> 16) & 15, l = idx >> 20;
        const int dir = n >> 7, ri = (n >> 6) & 1, p = n & 63, j = k >> 4, h2 = k & 15, pw = dir == 0 ? 15 - j : j, ldg = (l * 2 + dir) * 16 + g;
        const f32x2 a = ((const f32x2*)(F.ws + WS_APOW))[((size_t)ldg * 17 + pw) * 64 + p];
        const f32x2 b = ((const f32x2*)(F.ws + WS_BBAR))[((size_t)ldg * 64 + p) * 16 + h2];
        SST[idx] = f2bf(ri == 0 ? (a.x * b.x - a.y * b.y) : (a.x * b.y + a.y * b.x));
    }
}
__device__ __forceinline__ void phase_prologue3(const Ctx& F) {
    const int gt = F.bid * NTHR + F.tid, NT = F.G * NTHR;
    bf16_t* SOUT = (bf16_t*)(F.ws + WS_SOUT); const float* KT = (const float*)(F.ws + WS_KT);
    for (int idx = gt; idx < 4 * 16 * 256 * 512; idx += NT) {
        const int k = idx & 511, row = (idx >> 9) & 255, g = (idx >> 17) & 15, l = idx >> 21, t = row >> 4, h = row & 15;
        float val = 0.f;
        if (k < 256) { const int j = k >> 4, h2 = k & 15;
            if (j <= t) val += KT[(((((size_t)l * 2 + 0) * 16 + g) * 16 + (t - j)) * 16 + h) * 16 + h2];
            if (j >= t) val += KT[(((((size_t)l * 2 + 1) * 16 + g) * 16 + (j - t)) * 16 + h) * 16 + h2];
            if (j == t && h == h2) val += F.in[21][l * 256 + g * 16 + h];
        } else { const int kk = k - 256, dir = kk >> 7, ri = (kk >> 6) & 1, p = kk & 63, n = dir == 0 ? t + 1 : 16 - t, ldg = (l * 2 + dir) * 16 + g;
            const float c_r = F.in[19][((size_t)ldg * 16 + h) * 64 + p], c_i = F.in[20][((size_t)ldg * 16 + h) * 64 + p];
            const f32x2 a = ((const f32x2*)(F.ws + WS_APOW))[((size_t)ldg * 17 + n) * 64 + p];
            const float er = c_r * a.x - c_i * a.y, ei = c_r * a.y + c_i * a.x; val = ri == 0 ? er : -ei; }
        SOUT[idx] = f2bf(val);
    }
}

__device__ __forceinline__ void phase_rowwise(const Ctx& F, bool first, bool has_y, bool y2, bool write_h, int nrows, float fac,
                                              const float* gpost, const float* modg  , int gate_idx,
                                              const float* gpre, const float* modh  , int shift_idx, int scale_idx) {
    const int gw = F.bid * NWAVES + F.wave, NGW = F.G * NWAVES, lane = F.lane;
    const bf16_t* Y = (const bf16_t*)(F.ws + WS_Y); bf16_t* H = (bf16_t*)(F.ws + WS_H);
    constexpr int NR = 2;
    for (int rb = gw; rb < nrows; rb += NR * NGW) {
        f32x4 xv[NR][4], yv[NR][4]; float* xr[NR]; int b17[NR]; bool ok[NR]; int rr[NR];
#pragma unroll
        for (int k = 0; k < NR; ++k) {
            const int r0 = rb + k * NGW; ok[k] = r0 < nrows; const int r = ok[k] ? r0 : rb; rr[k] = r;
            b17[k] = r < ML ? (r >> 12) : 16; xr[k] = xrow_ptr(F, r);
            const float* xs = first ? (r < ML ? F.in[0] + (size_t)r * DM : F.in[2] + (size_t)(r - ML) * DM) : xr[k];
#pragma unroll
            for (int j = 0; j < 4; ++j) xv[k][j] = __builtin_nontemporal_load((const f32x4*)(xs + 4 * lane + 256 * j));
            if (has_y) {
#pragma unroll
                for (int j = 0; j < 4; ++j) { const u32x2 w = __builtin_nontemporal_load((const u32x2*)(Y + (size_t)r * DM + 4 * lane + 256 * j));
                    yv[k][j] = (f32x4){bf2f((unsigned short)(w.x & 0xffff)), bf2f((unsigned short)(w.x >> 16)), bf2f((unsigned short)(w.y & 0xffff)), bf2f((unsigned short)(w.y >> 16))}; }
                if (y2 && r >= ML) {
#pragma unroll
                    for (int j = 0; j < 4; ++j) { const u32x2 w = __builtin_nontemporal_load((const u32x2*)((const bf16_t*)(F.ws + WS_Y2) + (size_t)(r - ML) * DM + 4 * lane + 256 * j));
                        yv[k][j] = yv[k][j] + (f32x4){bf2f((unsigned short)(w.x & 0xffff)), bf2f((unsigned short)(w.x >> 16)), bf2f((unsigned short)(w.y & 0xffff)), bf2f((unsigned short)(w.y >> 16))}; }
                }
            }
        }
        if (has_y) {
            float s[NR];
#pragma unroll
            for (int k = 0; k < NR; ++k) { s[k] = 0.f;
#pragma unroll
                for (int j = 0; j < 4; ++j) s[k] += (yv[k][j][0] * yv[k][j][0] + yv[k][j][1] * yv[k][j][1]) + (yv[k][j][2] * yv[k][j][2] + yv[k][j][3] * yv[k][j][3]); }
#pragma unroll
            for (int o = 1; o < 64; o <<= 1) {
#pragma unroll
                for (int k = 0; k < NR; ++k) s[k] += shx(s[k], lane, o);
            }
#pragma unroll
            for (int k = 0; k < NR; ++k) { const float rs = fac * __builtin_amdgcn_rsqf(s[k] * (1.0f / DM) + EPS);
#pragma unroll
                for (int j = 0; j < 4; ++j) { const f32x4 gp = *(const f32x4*)(gpost + 4 * lane + 256 * j); const f32x4 gt = *(const f32x4*)(modg + (size_t)b17[k] * NMOD + gate_idx * DM + 4 * lane + 256 * j);
                    xv[k][j] = xv[k][j] + gt * (yv[k][j] * rs * gp); } }
        }
        if (has_y || first) {
#pragma unroll
            for (int k = 0; k < NR; ++k) if (ok[k]) {
#pragma unroll
                for (int j = 0; j < 4; ++j) __builtin_nontemporal_store(xv[k][j], (f32x4*)(xr[k] + 4 * lane + 256 * j)); }
        }
        if (write_h) {
            float s[NR];
#pragma unroll
            for (int k = 0; k < NR; ++k) { s[k] = 0.f;
#pragma unroll
                for (int j = 0; j < 4; ++j) s[k] += (xv[k][j][0] * xv[k][j][0] + xv[k][j][1] * xv[k][j][1]) + (xv[k][j][2] * xv[k][j][2] + xv[k][j][3] * xv[k][j][3]); }
#pragma unroll
            for (int o = 1; o < 64; o <<= 1) {
#pragma unroll
                for (int k = 0; k < NR; ++k) s[k] += shx(s[k], lane, o);
            }
#pragma unroll
            for (int k = 0; k < NR; ++k) if (ok[k]) { const float rs = __builtin_amdgcn_rsqf(s[k] * (1.0f / DM) + EPS);
#pragma unroll
                for (int j = 0; j < 4; ++j) { const int c0 = 4 * lane + 256 * j; const f32x4 gp = *(const f32x4*)(gpre + c0);
                    const f32x4 sh = *(const f32x4*)(modh + (size_t)b17[k] * NMOD + shift_idx * DM + c0), sc = *(const f32x4*)(modh + (size_t)b17[k] * NMOD + scale_idx * DM + c0);
                    const f32x4 hv = (xv[k][j] * rs * gp) * (sc + 1.0f) + sh;
                    *(u32x2*)(H + (size_t)rr[k] * DM + c0) = (u32x2){pk2(hv[0], hv[1]), pk2(hv[2], hv[3])}; } }
        }
    }
}

__device__ __forceinline__ int crow(int r, int hi) { return (r & 3) + 8 * (r >> 2) + 4 * hi; }
__device__ __forceinline__ void attn_tile(LAS unsigned char* lb, bool local, int kvstart, int qpos, int q, int hi, int lane, const bf16x8 (&qf)[4], float& mrun, float& lsum, f32x16 (&ot)[2]) {
    f32x16 p0, p1;
#pragma unroll
    for (int i = 0; i < 16; ++i) { p0[i] = 0.f; p1[i] = 0.f; }
#pragma unroll
    for (int s = 0; s < 4; ++s) {
        const bf16x8 a0 = *(const LAS bf16x8*)(lb + q * 144 + 32 * s + 16 * hi);
        const bf16x8 a1 = *(const LAS bf16x8*)(lb + (32 + q) * 144 + 32 * s + 16 * hi);
        p0 = __builtin_amdgcn_mfma_f32_32x32x16_bf16(a0, qf[s], p0, 0, 0, 0);
        p1 = __builtin_amdgcn_mfma_f32_32x32x16_bf16(a1, qf[s], p1, 0, 0, 0);
    }
    if (local) {
#pragma unroll
        for (int i = 0; i < 16; ++i) { const int d0 = kvstart + crow(i, hi) - qpos; if (d0 > 128 || d0 < -128) p0[i] = -1e30f; const int d1 = d0 + 32; if (d1 > 128 || d1 < -128) p1[i] = -1e30f; }
    }
    float mx = p0[0];
#pragma unroll
    for (int i = 1; i < 16; ++i) mx = fmaxf(mx, p0[i]);
#pragma unroll
    for (int i = 0; i < 16; ++i) mx = fmaxf(mx, p1[i]);
    mx = fmaxf(mx, shx(mx, lane, 32));
    const float mnew = fmaxf(mrun, mx), sc = __builtin_amdgcn_exp2f(mrun - mnew); mrun = mnew;
    float ps = 0.f;
#pragma unroll
    for (int i = 0; i < 16; ++i) { p0[i] = __builtin_amdgcn_exp2f(p0[i] - mnew); p1[i] = __builtin_amdgcn_exp2f(p1[i] - mnew); ps += p0[i] + p1[i]; }
    lsum = lsum * sc + ps;
#pragma unroll
    for (int i = 0; i < 16; ++i) { ot[0][i] *= sc; ot[1][i] *= sc; }
    bf16x8 pb[4];
#pragma unroll
    for (int ks = 0; ks < 4; ++ks) {
        u32x4 w;
        if (ks < 2) { w.x = pk2(p0[8 * ks + 0], p0[8 * ks + 1]); w.y = pk2(p0[8 * ks + 2], p0[8 * ks + 3]); w.z = pk2(p0[8 * ks + 4], p0[8 * ks + 5]); w.w = pk2(p0[8 * ks + 6], p0[8 * ks + 7]); }
        else { const int k2 = ks - 2; w.x = pk2(p1[8 * k2 + 0], p1[8 * k2 + 1]); w.y = pk2(p1[8 * k2 + 2], p1[8 * k2 + 3]); w.z = pk2(p1[8 * k2 + 4], p1[8 * k2 + 5]); w.w = pk2(p1[8 * k2 + 6], p1[8 * k2 + 7]); }
        pb[ks] = __builtin_bit_cast(bf16x8, w);
    }
#pragma unroll
    for (int dh = 0; dh < 2; ++dh)
#pragma unroll
        for (int ks = 0; ks < 4; ++ks) {
            const s16x4 lo = *(const LAS s16x4*)(lb + 9216 + (32 * dh + q) * 144 + (16 * ks + 4 * hi) * 2);
            const s16x4 h4 = *(const LAS s16x4*)(lb + 9216 + (32 * dh + q) * 144 + (16 * ks + 8 + 4 * hi) * 2);
            const bf16x8 va = __builtin_shufflevector(lo, h4, 0, 1, 2, 3, 4, 5, 6, 7);
            ot[dh] = __builtin_amdgcn_mfma_f32_32x32x16_bf16(va, pb[ks], ot[dh], 0, 0, 0);
        }
}
__device__ __forceinline__ void attn_unit(const Ctx& F, int b, int kh, int qc, const float* sink  ) {
    const bf16_t* Qb = (const bf16_t*)(F.ws + WS_Q); const bf16_t* Kb = (const bf16_t*)(F.ws + WS_K); const bf16_t* VT = (const bf16_t*)(F.ws + WS_VT); bf16_t* MIX = (bf16_t*)(F.ws + WS_H);
    LAS unsigned char* lds = F.lds;
    const int lane = F.lane, q = lane & 31, hi = lane >> 5, hq = kh * 4 + (F.wave >> 1), qs = F.wave & 1;
    const bool isctx = qc >= 64;
    int qpos; size_t qrow;
    if (!isctx) { qpos = qc * 64 + qs * 32 + q; qrow = (size_t)b * SEQL + qpos; } else { qpos = (qc - 64) * 64 + qs * 32 + q; qrow = (size_t)ML + b * NCTX + qpos; }
    const int ilo = isctx ? 0 : (qc < 2 ? 2 - qc : 0), ihi = isctx ? -1 : (65 - qc < 4 ? 65 - qc : 4), nloc = ihi - ilo + 1, nt = nloc + 4;
    const int row = F.tid >> 3, ch = F.tid & 7;
    const bf16_t* kbase = Kb + (size_t)row * 128 + kh * 64 + ch * 8;
    const bf16_t* vbase = VT + ((size_t)(b * 2 + kh) * 64 + row) * VTP + ch * 8;
#define ATT_LOAD(t, kk, vv) do { const int t_ = (t); size_t kr_; int vi_; \
        if (t_ < nloc) { const int ks_ = qc * 64 - 128 + 64 * (ilo + t_); kr_ = (size_t)b * SEQL + ks_; vi_ = ks_; } else { const int c_ = t_ - nloc; kr_ = (size_t)ML + b * NCTX + 64 * c_; vi_ = SEQL + 64 * c_; } \
        kk = *(const u32x4*)(kbase + kr_ * 128); vv = *(const u32x4*)(vbase + vi_); } while (0)
#define ATT_STORE(bo, kk, vv) do { *(LAS u32x4*)(lds + (bo) + row * 144 + ch * 16) = kk; *(LAS u32x4*)(lds + (bo) + 9216 + row * 144 + ch * 16) = vv; } while (0)
    u32x4 kA, vA, kB, vB;
    ATT_LOAD(0, kA, vA); ATT_LOAD(1, kB, vB);
    bf16x8 qf[4];
#pragma unroll
    for (int s = 0; s < 4; ++s) qf[s] = *(const bf16x8*)(Qb + qrow * 512 + hq * 64 + 16 * s + 8 * hi);
    float mrun = sink[hq] * LOG2E, lsum = hi == 0 ? 1.0f : 0.0f;
    f32x16 ot[2];
#pragma unroll
    for (int i = 0; i < 16; ++i) { ot[0][i] = 0.f; ot[1][i] = 0.f; }
    __syncthreads();
    for (int t = 0; t < nt; t += 2) {
        ATT_STORE(0, kA, vA);
        __syncthreads();
        if (t + 2 < nt) ATT_LOAD(t + 2, kA, vA);
        attn_tile(lds, t < nloc, qc * 64 - 128 + 64 * (ilo + t), qpos, q, hi, lane, qf, mrun, lsum, ot);
        if (t + 1 < nt) {
            ATT_STORE(18432, kB, vB);
            __syncthreads();
            if (t + 3 < nt) ATT_LOAD(t + 3, kB, vB);
            attn_tile(lds + 18432, t + 1 < nloc, qc * 64 - 128 + 64 * (ilo + t + 1), qpos, q, hi, lane, qf, mrun, lsum, ot);
        }
    }
#undef ATT_LOAD
#undef ATT_STORE
    lsum += shx(lsum, lane, 32);
    const float inv = 1.0f / lsum;
#pragma unroll
    for (int dh = 0; dh < 2; ++dh)
#pragma unroll
        for (int g4 = 0; g4 < 4; ++g4) {
            const int d0 = 32 * dh + 8 * g4 + 4 * hi;
            *(u32x2*)(MIX + qrow * 1024 + hq * 64 + d0) = (u32x2){pk2(ot[dh][4 * g4] * inv, ot[dh][4 * g4 + 1] * inv), pk2(ot[dh][4 * g4 + 2] * inv, ot[dh][4 * g4 + 3] * inv)};
        }
}
__device__ __forceinline__ void phase_attn(const Ctx& F, int l, bool lastl) {
    const int nq = lastl ? 64 : 68, nunits = NB * 2 * nq;
    for (int id = F.bid; id < nunits; id += F.G) { const int bk = id / nq, qc = id % nq; attn_unit(F, bk >> 1, bk & 1, qc, F.in[13] + l * 8); }
    __syncthreads();
}

__device__ __forceinline__ void unpack8(const u32x4 v, float* f) {
    f[0] = bf2f((unsigned short)(v.x & 0xffff)); f[1] = bf2f((unsigned short)(v.x >> 16)); f[2] = bf2f((unsigned short)(v.y & 0xffff)); f[3] = bf2f((unsigned short)(v.y >> 16));
    f[4] = bf2f((unsigned short)(v.z & 0xffff)); f[5] = bf2f((unsigned short)(v.z >> 16)); f[6] = bf2f((unsigned short)(v.w & 0xffff)); f[7] = bf2f((unsigned short)(v.w >> 16));
}
__device__ __forceinline__ void phase_conv(const Ctx& F, int l, int nrows) {
    const bf16_t* CZ = (const bf16_t*)(F.ws + WS_CZ); bf16_t* MIX = (bf16_t*)(F.ws + WS_H); const float* cw = F.in[24] + l * 768;
    const int gt = F.bid * NTHR + F.tid, NT = F.G * NTHR;
    for (int idx = gt; idx < nrows * 32; idx += NT) {
        const int r = idx >> 5, c0 = (idx & 31) * 8;
        int pos, len; if (r < ML) { pos = r & 4095; len = SEQL; } else { pos = (r - ML) & 255; len = NCTX; }
        const bf16_t* p = CZ + (size_t)r * 768 + c0;
        float gb[8], gc[8], z[8], tp[8], tn[8], a[8], b2[8];
        unpack8(*(const u32x4*)p, gb); unpack8(*(const u32x4*)(p + 256), gc); unpack8(*(const u32x4*)(p + 512), z);
        if (pos > 0) { unpack8(*(const u32x4*)(p - 768 + 256), a); unpack8(*(const u32x4*)(p - 768 + 512), b2);
#pragma unroll
            for (int i = 0; i < 8; ++i) tp[i] = a[i] * b2[i]; }
        else {
#pragma unroll
            for (int i = 0; i < 8; ++i) tp[i] = 0.f; }
        if (pos < len - 1) { unpack8(*(const u32x4*)(p + 768 + 256), a); unpack8(*(const u32x4*)(p + 768 + 512), b2);
#pragma unroll
            for (int i = 0; i < 8; ++i) tn[i] = a[i] * b2[i]; }
        else {
#pragma unroll
            for (int i = 0; i < 8; ++i) tn[i] = 0.f; }
        float o[8];
#pragma unroll
        for (int i = 0; i < 8; ++i) o[i] = gb[i] * (tp[i] * cw[c0 + i] + (gc[i] * z[i]) * cw[256 + c0 + i] + tn[i] * cw[512 + c0 + i]);
        *(u32x4*)(MIX + (size_t)r * 1024 + 768 + c0) = (u32x4){pk2(o[0], o[1]), pk2(o[2], o[3]), pk2(o[4], o[5]), pk2(o[6], o[7])};
    }
}

__device__ __forceinline__ int scan_chunk(int b, int dir, int step) {
    return step < 16 ? NB * 256 + b * 16 + (dir == 0 ? step : 15 - step) : b * 256 + (dir == 0 ? step - 16 : 271 - step);
}
__device__ __forceinline__ void phase_scan(const Ctx& F, int l) {
    const float* SL = (const float*)(F.ws + WS_SL); bf16_t* SSMA = (bf16_t*)(F.ws + WS_SSMA);
    LAS f32x2* sh = (LAS f32x2*)F.lds;
    for (int id = F.bid; id < 512; id += F.G) {
        const int b = id >> 5, g = (id >> 1) & 15, dir = id & 1, p = F.lane, seg = F.wave, ldg = (l * 2 + dir) * 16 + g;
        const f32x2 a16 = ((const f32x2*)(F.ws + WS_APOW))[((size_t)ldg * 17 + 16) * 64 + p];
        const float ar = a16.x, ai = a16.y;
        const size_t gbase = (size_t)g * NCHUNK;
        float xr[34], xi[34];
#pragma unroll
        for (int j = 0; j < 34; ++j) { const size_t rowc = gbase + scan_chunk(b, dir, seg * 34 + j); xr[j] = SL[rowc * 256 + dir * 128 + p]; xi[j] = SL[rowc * 256 + dir * 128 + 64 + p]; }
        float sr = 0.f, si = 0.f;
#pragma unroll
        for (int j = 0; j < 34; ++j) { const float nr = ar * sr - ai * si + xr[j], ni = ar * si + ai * sr + xi[j]; sr = nr; si = ni; }
        __syncthreads();
        sh[seg * 64 + p] = (f32x2){sr, si};
        float pr = ar, pi = ai, p2r, p2i;
        { const float tr = pr * pr - pi * pi, ti = 2.f * pr * pi; pr = tr; pi = ti; } p2r = pr; p2i = pi;
#pragma unroll
        for (int k = 0; k < 4; ++k) { const float tr = pr * pr - pi * pi, ti = 2.f * pr * pi; pr = tr; pi = ti; }
        { const float tr = pr * p2r - pi * p2i, ti = pr * p2i + pi * p2r; pr = tr; pi = ti; }
        __syncthreads();
        sr = 0.f; si = 0.f;
        for (int s2 = 0; s2 < seg; ++s2) { const f32x2 tt = sh[s2 * 64 + p]; const float nr = pr * sr - pi * si + tt.x, ni = pr * si + pi * sr + tt.y; sr = nr; si = ni; }
#pragma unroll
        for (int j = 0; j < 34; ++j) { const size_t rowc = gbase + scan_chunk(b, dir, seg * 34 + j);
            SSMA[rowc * 512 + 256 + dir * 128 + p] = f2bf(sr); SSMA[rowc * 512 + 256 + dir * 128 + 64 + p] = f2bf(si);
            const float nr = ar * sr - ai * si + xr[j], ni = ar * si + ai * sr + xi[j]; sr = nr; si = ni; }
    }
    __syncthreads();
}

#ifndef MK_MULTI
#define MK_MULTI 0
#endif
constexpr size_t WS_BAR = 195 * MiB + 131072;
constexpr int LDS_BARST_OFF = 131072 + 64;
#define XB_TMO      128
#define XB_XCNT(j)  (256  + 64 * (j))
#define XB_XSUB(j)  (1280 + 64 * (j))
#define XB_XGEN(j)  (2304 + 64 * (j))
#define XB_TOP      3328
#define XB_TOPGEN   3392
#define XCD_BAR_WORDS 3456
#define XB_SPIN_CAP (1u << 20)
__device__ __forceinline__ unsigned xb_ld(unsigned* p)              { return __hip_atomic_load(p, __ATOMIC_RELAXED, __HIP_MEMORY_SCOPE_AGENT); }
__device__ __forceinline__ unsigned xb_add(unsigned* p, unsigned v) { return __hip_atomic_fetch_add(p, v, __ATOMIC_RELAXED, __HIP_MEMORY_SCOPE_AGENT); }
__device__ __forceinline__ unsigned xb_xcc_id() { return (unsigned)__builtin_amdgcn_s_getreg((3 << 11) | 20) & 0xFu; }
#define XB_SPIN(cond, bar) do { unsigned _sp = 0; while (cond) { __builtin_amdgcn_s_sleep(1); \
    if ((++_sp & 255u) == 0u) { if (xb_ld(&(bar)[XB_TMO])) break; if (_sp > XB_SPIN_CAP) { atomicAdd(&(bar)[XB_TMO], 1u); break; } } } } while (0)
struct XcdBarrier { unsigned* bar; unsigned x; volatile LAS unsigned* st; };
__device__ __forceinline__ void xcd_barrier_complete(unsigned* bar, unsigned x, unsigned& nloc, unsigned& nx) {
    const unsigned G = gridDim.x * gridDim.y * gridDim.z;
    unsigned sum, cnt, mine, sp = 0u;
    for (;;) {
        sum = 0u; cnt = 0u; mine = 0u;
#pragma unroll
        for (unsigned j = 0; j < 16; ++j) { const unsigned c = xb_ld(&bar[XB_XCNT(j)]); sum += c; cnt += (c > 0u) ? 1u : 0u; mine = (j == x) ? c : mine; }
        if (sum == G) break;
        __builtin_amdgcn_s_sleep(1);
        if ((++sp & 255u) == 0u) { if (xb_ld(&bar[XB_TMO])) break; if (sp > XB_SPIN_CAP) { atomicAdd(&bar[XB_TMO], 1u); break; } }
    }
    nloc = mine > 0u ? mine : 1u; nx = cnt > 0u ? cnt : 1u;
}
__device__ __forceinline__ void xcd_barrier(const XcdBarrier& b, int tid) {
    asm volatile("s_waitcnt vmcnt(0)" ::: "memory");
    __syncthreads();
    if (tid == 0) {
        unsigned* bar = b.bar;
        __builtin_amdgcn_s_waitcnt(0);
        unsigned nloc = b.st[0], nx = b.st[1];
        if (nloc == 0u) { xcd_barrier_complete(bar, b.x, nloc, nx); b.st[0] = nloc; b.st[1] = nx; }
        const unsigned old = xb_add(&bar[XB_XSUB(b.x)], 1u);
        const unsigned gen = old / nloc;
        if (old + 1u == (gen + 1u) * nloc) {
            __builtin_amdgcn_fence(__ATOMIC_RELEASE, "agent");
            asm volatile("s_waitcnt vmcnt(0)" ::: "memory");
            const unsigned og = xb_add(&bar[XB_TOP], 1u);
            const unsigned tg = og / nx;
            if (og + 1u == (tg + 1u) * nx) xb_add(&bar[XB_TOPGEN], 1u);
            else XB_SPIN(xb_ld(&bar[XB_TOPGEN]) == tg, bar);
            __builtin_amdgcn_fence(__ATOMIC_ACQUIRE, "agent");
            xb_add(&bar[XB_XGEN(b.x)], 1u);
            asm volatile("s_waitcnt vmcnt(0)" ::: "memory");
        } else {
            XB_SPIN(xb_ld(&bar[XB_XGEN(b.x)]) == gen, bar);
            __builtin_amdgcn_fence(__ATOMIC_ACQUIRE, "agent");
            asm volatile("s_waitcnt vmcnt(0)" ::: "memory");
        }
    }
    __syncthreads();
}

#ifndef PROBE_DUP
#define PROBE_DUP 0
#endif
__global__ void __launch_bounds__(NTHR, 2) fwd_megakernel(Args args) {
    extern __shared__ __attribute__((aligned(16))) unsigned char lds_raw[];
    cg::grid_group grid = cg::this_grid();
    Ctx F;
    F.lds = (LAS unsigned char*)lds_raw;
    const int wave_s = __builtin_amdgcn_readfirstlane((int)threadIdx.x >> 6);
#if !MK_MULTI
    {
        volatile LAS unsigned* st0 = (volatile LAS unsigned*)(F.lds + LDS_BARST_OFF);
        if (threadIdx.x == 0) { st0[0] = 0u; st0[1] = 0u; (void)xb_add((unsigned*)(args.ws + WS_BAR) + XB_XCNT(xb_xcc_id()), 1u); }
        __syncthreads();
    }
#endif
    const int lo = args.ph_lo, hi = args.ph_hi < NPHASES ? args.ph_hi : NPHASES;
    for (int ph2 = 2 * lo; ph2 < 2 * hi; ++ph2) {
        const int ph = ph2 >> 1;
        if (ph2 & 1) { if (ph < 3 || !((PROBE_DUP >> ((ph - 3) % 10)) & 1)) continue; }
        const bool seam = ph2 > 2 * lo;
        { CArgs* ap_ = (CArgs*)__builtin_amdgcn_kernarg_segment_ptr(); asm volatile("" : "+s"(ap_)); F.in.ap = ap_; F.out = ap_->out; F.ws = ap_->ws; }
        { int l_ = (int)__builtin_amdgcn_mbcnt_hi(~0u, __builtin_amdgcn_mbcnt_lo(~0u, 0u)); asm volatile("" : "+v"(l_)); int w_ = wave_s, b_ = blockIdx.x, g_ = gridDim.x; asm volatile("" : "+s"(w_), "+s"(b_), "+s"(g_));
          F.lane = l_; F.wave = w_; F.tid = w_ * 64 + l_; F.bid = b_; F.G = g_; }
        if (seam) {
            if (ph == 1 && !(ph2 & 1)) grid.sync();
            else { XcdBarrier xb; xb.bar = (unsigned*)(F.ws + WS_BAR); xb.x = xb_xcc_id(); xb.st = (volatile LAS unsigned*)(F.lds + LDS_BARST_OFF); xcd_barrier(xb, F.tid); }
        }
        bf16_t* H = (bf16_t*)(F.ws + WS_H); bf16_t* Gh = (bf16_t*)(F.ws + WS_G); float* Y = (float*)(F.ws + WS_Y);
        const float* MOD = (const float*)(F.ws + WS_MOD);
        if (ph == 0) { phase_prologue(F); continue; }
        if (ph == 1) { phase_prologue2(F); continue; }
        if (ph == 2) { phase_prologue3(F); phase_rowwise(F, true, false, false, true, MT, 0.f, nullptr, nullptr, 0, F.in[6] + 0, MOD, 0, 1); continue; }
        const int q = ph - 3, l = q / 10, kind = q % 10;
        const bool lastl = (l == DEPTH - 1);
        unsigned* CTL = (unsigned*)(F.ws + WS_CTL);
        if (kind == 0 || kind == 8) {
            const int s = kind == 0 ? 0 : 1; const int Mff = (lastl && s == 1) ? ML : MT;
            pg8::Gemm g{H, (const bf16_t*)(F.ws + WS_WGU) + (size_t)(l * 2 + s) * 5632 * DM, Mff, 5632, DM, DM, DM, 0, 0, 1};
            pg8::StaticOrder S; S.init(Mff, 5632, 1, F.G, F.bid);
            pg8::EpiSwiGLU E{Gh};
            pg8::gemm_phase<pg8::EpiSwiGLU, true, true, false>(F.lds, F.tid, g, S, E);
        } else if (kind == 1 || kind == 9) {
            const int s = kind == 1 ? 0 : 1; const int Mff = (lastl && s == 1) ? ML : MT; const int which = s ? 2 : 0;
            const bool split = (Mff == MT); const int total = 4 * (Mff / 256);
            unsigned* ctl = CTL + (l * 3 + which) * Q_SLOT_WORDS;
            if (F.tid == 0) *(LAS int*)(F.lds + LDS_PEND_OFF) = -1;
            __syncthreads();
            pg8::Gemm g{Gh, (const bf16_t*)(F.ws + WS_WD) + (size_t)(l * 2 + s) * DM * DFF, Mff, DM, DFF, DFF, DFF, 0, 0, 1};
            pg8::StaticOrder S; S.init(ML, DM, 1, F.G, F.bid);
            pg8::EpiBf16YQ E{(bf16_t*)Y, nullptr, ctl, F.in.ap, 0, 4, total, l, which, split};
            pg8::gemm_phase<pg8::EpiBf16YQ, true, true, false>(F.lds, F.tid, g, S, E);
            if (split) {
                pg8::Gemm g2{Gh + (size_t)ML * DFF, g.Bt, MC, DM, DFF / 2, DFF, DFF, (size_t)(DFF / 2) * 2, (size_t)(DFF / 2) * 2, 2};
                pg8::StaticOrder S2; S2.init(MC, DM, 2, F.G, F.bid);
                pg8::EpiBf16YQ E2{(bf16_t*)Y + (size_t)ML * DM, (bf16_t*)(F.ws + WS_Y2), ctl, F.in.ap, ML / 256, 8, total, l, which, split};
                pg8::gemm_phase<pg8::EpiBf16YQ, true, true, true>(F.lds, F.tid, g2, S2, E2);
            }
            rowq_drain(F.lds, ctl, total, F.in.ap, l, which, split, F.tid, F.wave);
        } else if (kind == 2) {
            pg8::Gemm g{H, (const bf16_t*)(F.ws + WS_WIN) + (size_t)l * INC * DM, MT, INC, DM, DM, DM, 0, 0, 1};
            pg8::StaticOrder S; S.init(MT, INC, 1, F.G, F.bid);
            pg8::EpiWin E{(bf16_t*)(F.ws + WS_Q), (bf16_t*)(F.ws + WS_K), (bf16_t*)(F.ws + WS_VT), (bf16_t*)(F.ws + WS_SSMA), (bf16_t*)(F.ws + WS_CZ), (const f32x2*)(F.ws + WS_CS)};
            pg8::gemm_phase<pg8::EpiWin, true, true, false>(F.lds, F.tid, g, S, E);
        } else if (kind == 3) {
            {
            pg8::Gemm g{(const bf16_t*)(F.ws + WS_SSMA), (const bf16_t*)(F.ws + WS_SST) + (size_t)l * 16 * 256 * 256, NCHUNK, 256, 256, 512, 256, (size_t)NCHUNK * 512 * 2, (size_t)256 * 256 * 2, 16};
            pg8::StaticOrder S; S.init(NCHUNK, 256, 16, F.G, F.bid);
            pg8::EpiF32 E{(float*)(F.ws + WS_SL), 256, (size_t)NCHUNK * 256};
            pg8::gemm_phase<pg8::EpiF32, true, true, true>(F.lds, F.tid, g, S, E);
            }
            __syncthreads();
            if (F.bid & 1) { phase_conv(F, l, lastl ? ML : MT); phase_attn(F, l, lastl); }
            else { phase_attn(F, l, lastl); phase_conv(F, l, lastl ? ML : MT); }
        } else if (kind == 4) {
            phase_scan(F, l);
        } else if (kind == 5) {
            pg8::Gemm g{(const bf16_t*)(F.ws + WS_SSMA), (const bf16_t*)(F.ws + WS_SOUT) + (size_t)l * 16 * 256 * 512, NCHUNK, 256, 512, 512, 512, (size_t)NCHUNK * 512 * 2, (size_t)256 * 512 * 2, 16};
            pg8::StaticOrder S; S.init(NCHUNK, 256, 16, F.G, F.bid);
            pg8::EpiSsmOut E{(bf16_t*)(F.ws + WS_YG)};
            pg8::gemm_phase<pg8::EpiSsmOut, true, true, true>(F.lds, F.tid, g, S, E);
        } else if (kind == 6) {
            const int Mg = lastl ? ML : MT;
            pg8::Gemm g{(const bf16_t*)(F.ws + WS_YG), (const bf16_t*)(F.ws + WS_WGLU) + (size_t)l * 256 * 256, Mg, 256, 256, 256, 256, 0, 0, 1};
            pg8::StaticOrder S; S.init(Mg, 256, 1, F.G, F.bid);
            pg8::EpiGlu E{(const bf16_t*)(F.ws + WS_YG), F.in[23] + l * 256, H};
            pg8::gemm_phase<pg8::EpiGlu, true, true, false>(F.lds, F.tid, g, S, E);
        } else {
            const int Mg = lastl ? ML : MT; const int total = 4 * (Mg / 256);
            unsigned* ctl = CTL + (l * 3 + 1) * Q_SLOT_WORDS;
            if (F.tid == 0) *(LAS int*)(F.lds + LDS_PEND_OFF) = -1;
            __syncthreads();
            pg8::Gemm g{H, (const bf16_t*)(F.ws + WS_WOUT) + (size_t)l * DM * DM, Mg, DM, DM, DM, DM, 0, 0, 1};
            pg8::StaticOrder S; S.init(Mg, DM, 1, F.G, F.bid);
            pg8::EpiBf16YQ E{(bf16_t*)Y, nullptr, ctl, F.in.ap, 0, 4, total, l, 1, false};
            pg8::gemm_phase<pg8::EpiBf16YQ, true, true, false>(F.lds, F.tid, g, S, E);
            rowq_drain(F.lds, ctl, total, F.in.ap, l, 1, false, F.tid, F.wave);
        }
    }
}

extern "C" void kernel_launch(void* const* d_in, const int* in_sizes, int n_in, void* d_out, int out_size, void* d_ws, size_t ws_size, hipStream_t stream) {
    static int grid = 0;
    if (grid == 0) {
        if (n_in != 25 || out_size != ML * DM || ws_size < WS_END) { fprintf(stderr, "kernel_launch: unexpected shapes: n_in %d out %d ws %zu\n", n_in, out_size, ws_size); grid = -1; return; }
        int dev = 0, cus = 0, per_cu = 0;
        hipGetDevice(&dev); hipDeviceGetAttribute(&cus, hipDeviceAttributeMultiprocessorCount, dev);
        if (hipFuncSetAttribute((const void*)fwd_megakernel, hipFuncAttributeMaxDynamicSharedMemorySize, LDS_BYTES) != hipSuccess) { fprintf(stderr, "kernel_launch: hipFuncSetAttribute failed\n"); grid = -1; return; }
        if (hipOccupancyMaxActiveBlocksPerMultiprocessor(&per_cu, (const void*)fwd_megakernel, NTHR, LDS_BYTES) != hipSuccess || per_cu < 1) { fprintf(stderr, "kernel_launch: occupancy query says %d\n", per_cu); per_cu = 1; }
        (void)hipGetLastError();
        grid = cus * per_cu;
        fprintf(stderr, "kernel_launch: grid %d (cus %d x %d)\n", grid, cus, per_cu);
    }
    if (grid < 0) return;
    Args a{};
    for (int i = 0; i < 25; ++i) a.in[i] = (const float*)d_in[i];
    a.out = (float*)d_out; a.ws = (unsigned char*)d_ws;
#if MK_MULTI
    for (int p = 0; p < NPHASES; ++p) { a.ph_lo = p; a.ph_hi = p + 1; hipLaunchKernelGGL(fwd_megakernel, dim3(grid), dim3(NTHR), LDS_BYTES, stream, a); }
#else
    a.ph_lo = 0; a.ph_hi = 1 << 20;
    if (hipMemsetAsync((char*)d_ws + WS_BAR, 0, 16384, stream) != hipSuccess) { fprintf(stderr, "kernel_launch: memset of the barrier words failed\n"); return; }
    void* kargs[] = {&a};
    hipError_t e = hipLaunchCooperativeKernel((const void*)fwd_megakernel, dim3(grid), dim3(NTHR), kargs, LDS_BYTES, stream);
    if (e != hipSuccess) fprintf(stderr, "cooperative launch failed: %s (grid %d)\n", hipGetErrorString(e), grid);
#endif
}
```

```cpp
#include <hip/hip_runtime.h>
#include <hip/hip_cooperative_groups.h>
#include <cstdio>
#include <cstdint>
namespace cg = cooperative_groups;

#define LAS __attribute__((address_space(3)))
typedef unsigned short bf16_t;
typedef short bf16x8 __attribute__((ext_vector_type(8)));
typedef short s16x4 __attribute__((ext_vector_type(4)));
typedef float f32x4 __attribute__((ext_vector_type(4)));
typedef float f32x16 __attribute__((ext_vector_type(16)));
typedef float f32x2 __attribute__((ext_vector_type(2)));
typedef __bf16 bf16x2_t __attribute__((ext_vector_type(2)));
typedef unsigned u32x4 __attribute__((ext_vector_type(4)));
typedef unsigned u32x2 __attribute__((ext_vector_type(2)));

constexpr int NB = 16, SEQL = 4096, NCTX = 256, DM = 1024, DEPTH = 4;
constexpr int ML = NB * SEQL;
constexpr int MC = NB * NCTX;
constexpr int MT = ML + MC;
constexpr int DFF = 2816, INC = 1792, NMOD = 9 * DM;
constexpr int NCHUNK = MT / 16;
constexpr int VTP = SEQL + NCTX;
constexpr float EPS = 1e-6f;
constexpr float LOG2E = 1.4426950408889634f;
constexpr float QSCALE = 0.125f * LOG2E;

constexpr size_t MiB = 1u << 20;
constexpr size_t WS_WGU = 0;
constexpr size_t WS_WD = 88 * MiB;
constexpr size_t WS_WIN = 132 * MiB;
constexpr size_t WS_WOUT = 146 * MiB;
constexpr size_t WS_WGLU = 154 * MiB;
constexpr size_t WS_SOUT = 155 * MiB;
constexpr size_t WS_SST = 171 * MiB;
constexpr size_t WS_MOD = 179 * MiB;
constexpr size_t WS_MODP = 620 * MiB;
constexpr size_t WS_KT = 660 * MiB;
constexpr size_t WS_APOW = 192 * MiB;
constexpr size_t WS_BBAR = 194 * MiB;
constexpr size_t WS_CS = 195 * MiB;
constexpr size_t WS_XC = 196 * MiB;
constexpr size_t WS_H = 212 * MiB;
constexpr size_t WS_Y = 348 * MiB;
constexpr size_t WS_Y2 = WS_Y + 136 * MiB;
constexpr size_t WS_G = 620 * MiB;
constexpr size_t WS_Q = WS_G;
constexpr size_t WS_K = WS_Q + 68 * MiB;
constexpr size_t WS_VT = WS_K + 17 * MiB;
constexpr size_t WS_SSMA = WS_VT + 17 * MiB;
constexpr size_t WS_SL = WS_SSMA + 68 * MiB;
constexpr size_t WS_CZ = WS_SL + 68 * MiB;
constexpr size_t WS_YG = WS_CZ + 102 * MiB;
constexpr size_t WS_END = 994 * MiB;
static_assert(WS_YG + 34 * MiB <= WS_END, "ws map");
static_assert((size_t)MT * DFF * 2 <= 374 * MiB, "G fits");

__device__ __forceinline__ int lane_id_fresh() { int l; asm volatile("v_mbcnt_lo_u32_b32 %0, -1, 0\n\tv_mbcnt_hi_u32_b32 %0, -1, %0" : "=v"(l)); return l; }
__device__ __forceinline__ unsigned pk2(float lo, float hi) { f32x2 v = {lo, hi}; bf16x2_t b = __builtin_convertvector(v, bf16x2_t); return __builtin_bit_cast(unsigned, b); }
__device__ __forceinline__ unsigned short f2bf(float f) { unsigned u = __builtin_bit_cast(unsigned, f); return (unsigned short)((u + 0x7fffu + ((u >> 16) & 1u)) >> 16); }
__device__ __forceinline__ float bf2f(unsigned short b) { return __builtin_bit_cast(float, (unsigned)b << 16); }
__device__ __forceinline__ float silu_f(float g) { return g * __builtin_amdgcn_rcpf(1.0f + __builtin_amdgcn_exp2f(-g * LOG2E)); }
__device__ __forceinline__ float sigmoid_f(float g) { return __builtin_amdgcn_rcpf(1.0f + __builtin_amdgcn_exp2f(-g * LOG2E)); }
__device__ __forceinline__ float gelu_tanh_f(float y) { const float t = 0.7978845608028654f * (y + 0.044715f * y * y * y); return y * __builtin_amdgcn_rcpf(1.0f + __builtin_amdgcn_exp2f(-2.0f * LOG2E * t)); }
__device__ __forceinline__ float shx(float v, int lane, int o) { return __builtin_bit_cast(float, __builtin_amdgcn_ds_bpermute((lane ^ o) << 2, __builtin_bit_cast(int, v))); }
__device__ __forceinline__ float wave_sum(float v, int lane) {
#pragma unroll
    for (int o = 1; o < 64; o <<= 1) v += shx(v, lane, o);
    return v;
}
__device__ __forceinline__ float dppf(float v, int ctrl_sel) {
    const int x = __builtin_bit_cast(int, v); int r;
    if (ctrl_sel == 0) r = __builtin_amdgcn_update_dpp(x, x, 0xB1, 0xF, 0xF, true);
    else if (ctrl_sel == 1) r = __builtin_amdgcn_update_dpp(x, x, 0x4E, 0xF, 0xF, true);
    else if (ctrl_sel == 2) r = __builtin_amdgcn_update_dpp(x, x, 0x141, 0xF, 0xF, true);
    else r = __builtin_amdgcn_update_dpp(x, x, 0x140, 0xF, 0xF, true);
    return __builtin_bit_cast(float, r);
}
__device__ __forceinline__ float wave_sum_dpp(float v) {
    v += dppf(v, 0); v += dppf(v, 1); v += dppf(v, 2); v += dppf(v, 3);
    v += __builtin_bit_cast(float, __builtin_amdgcn_ds_swizzle(__builtin_bit_cast(int, v), 0x401F));
    const unsigned u = __builtin_bit_cast(unsigned, v);
    auto rr = __builtin_amdgcn_permlane32_swap(u, u, false, false);
    return __builtin_bit_cast(float, rr[0]) + __builtin_bit_cast(float, rr[1]);
}
__device__ __forceinline__ float shx_t(float v, int lane4, int o) { int a = lane4 ^ (o << 2); asm volatile("" : "+v"(a)); return __builtin_bit_cast(float, __builtin_amdgcn_ds_bpermute(a, __builtin_bit_cast(int, v))); }
__device__ __forceinline__ float exp_f(float x) { return __builtin_amdgcn_exp2f(x * LOG2E); }

struct Args { const float* in[25]; float* out; unsigned char* ws; int ph_lo, ph_hi; };
typedef __attribute__((address_space(4))) const Args CArgs;
#define RLXA __ATOMIC_RELAXED, __HIP_MEMORY_SCOPE_AGENT
constexpr size_t WS_CTL = 195 * MiB + 262144;
constexpr int LDS_FLAG_OFF = 131072;
constexpr int Q_CNT = 0, Q_QUEUE = 320, Q_TAIL = 640, Q_HEAD = 704, Q_SLOT_WORDS = 1024;

__device__ __forceinline__ void rowwise_quarter(CArgs* ap, int l, int which, bool y2, int pm, int quarter, int wid, int lane) {
    unsigned char* ws = ap->ws; float* outp = ap->out;
    const bf16_t* Y = (const bf16_t*)(ws + WS_Y); bf16_t* H = (bf16_t*)(ws + WS_H);
    const float* modg = (const float*)(ws + WS_MOD) + (size_t)l * 17 * NMOD;
    const float* npost = ap->in[7] + (size_t)l * 3 * DM + which * DM;
    const bool write_h = !(which == 2 && l == DEPTH - 1);
    const int lh = (which == 2 && l < DEPTH - 1) ? l + 1 : l;
    const float* modh = (const float*)(ws + WS_MOD) + (size_t)lh * 17 * NMOD;
    const float* npre = ap->in[6] + (size_t)lh * 3 * DM + (which == 2 ? 0 : (which + 1) * DM);
    const int shift_idx = which == 2 ? 0 : 3 * (which + 1);
    const float fac = which == 1 ? 1.0f : 0.5f;
    const int b17 = pm < (ML / 256) ? (pm >> 4) : 16;
    const bool add2 = y2 && pm >= (ML / 256);
    const int r0 = pm * 256 + quarter * 64 + wid * 8;
    const char* xb = (const char*)(pm < (ML / 256) ? outp + (size_t)r0 * DM : (float*)(ws + WS_XC) + (size_t)(r0 - ML) * DM);
    const char* yb = (const char*)(Y + (size_t)r0 * DM);
    const char* y2b = (const char*)((const bf16_t*)(ws + WS_Y2) + (size_t)(add2 ? r0 - ML : 0) * DM);
    char* hb = (char*)(H + (size_t)r0 * DM);
    unsigned vo16 = (unsigned)lane * 16u, vo8 = (unsigned)lane * 8u; asm volatile("" : "+v"(vo16), "+v"(vo8));
    const int lane4 = (int)(vo8 >> 1);
    f32x4 xv[8][4];
#pragma unroll
    for (int k = 0; k < 8; ++k) {
#pragma unroll
        for (int j = 0; j < 4; ++j) if (k < 4 || j < 2) xv[k][j] = __builtin_nontemporal_load((const f32x4*)(xb + k * 4096 + j * 1024 + vo16)); }
#pragma unroll
    for (int hh = 0; hh < 2; ++hh) {
        asm volatile("" ::: "memory");
        u32x2 yp[4][4]; float rs[4], rs2[4];
        if (hh == 1) {
#pragma unroll
            for (int k = 4; k < 8; ++k) { xv[k][2] = __builtin_nontemporal_load((const f32x4*)(xb + k * 4096 + 2 * 1024 + vo16)); xv[k][3] = __builtin_nontemporal_load((const f32x4*)(xb + k * 4096 + 3 * 1024 + vo16)); }
        }
#pragma unroll
        for (int k = 0; k < 4; ++k) {
#pragma unroll
            for (int j = 0; j < 4; ++j) yp[k][j] = __builtin_nontemporal_load((const u32x2*)(yb + (4 * hh + k) * 2048 + j * 512 + vo8)); }
        if (add2) {
#pragma unroll
            for (int k = 0; k < 4; ++k) {
#pragma unroll
                for (int j = 0; j < 4; ++j) { const u32x2 w = __builtin_nontemporal_load((const u32x2*)(y2b + (4 * hh + k) * 2048 + j * 512 + vo8)); const u32x2 a = yp[k][j];
                    yp[k][j] = (u32x2){pk2(bf2f((unsigned short)(a.x & 0xffff)) + bf2f((unsigned short)(w.x & 0xffff)), bf2f((unsigned short)(a.x >> 16)) + bf2f((unsigned short)(w.x >> 16))),
                                       pk2(bf2f((unsigned short)(a.y & 0xffff)) + bf2f((unsigned short)(w.y & 0xffff)), bf2f((unsigned short)(a.y >> 16)) + bf2f((unsigned short)(w.y >> 16)))}; } }
        }
#pragma unroll
        for (int k = 0; k < 4; ++k) { float s = 0.f;
#pragma unroll
            for (int j = 0; j < 4; ++j) { const u32x2 a = yp[k][j]; const float y0 = bf2f((unsigned short)(a.x & 0xffff)), y1 = bf2f((unsigned short)(a.x >> 16)), y2v = bf2f((unsigned short)(a.y & 0xffff)), y3 = bf2f((unsigned short)(a.y >> 16));
                s += (y0 * y0 + y1 * y1) + (y2v * y2v + y3 * y3); }
            rs[k] = s; rs2[k] = 0.f; }
#pragma unroll
        for (int o = 1; o < 64; o <<= 1) {
#pragma unroll
            for (int k = 0; k < 4; ++k) rs[k] += shx_t(rs[k], lane4, o);
        }
#pragma unroll
        for (int k = 0; k < 4; ++k) rs[k] = __builtin_amdgcn_rsqf(rs[k] * (1.0f / DM) + EPS);
#pragma unroll
        for (int j = 0; j < 4; ++j) { const int c0 = 4 * lane + 256 * j;
            const f32x4 ca = *(const f32x4*)(npost + c0) * *(const f32x4*)(modg + (size_t)b17 * NMOD + (2 + 3 * which) * DM + c0) * fac;
#pragma unroll
            for (int k = 0; k < 4; ++k) { const u32x2 a = yp[k][j];
                const f32x4 yv = (f32x4){bf2f((unsigned short)(a.x & 0xffff)), bf2f((unsigned short)(a.x >> 16)), bf2f((unsigned short)(a.y & 0xffff)), bf2f((unsigned short)(a.y >> 16))};
                const f32x4 xn = xv[4 * hh + k][j] + ca * (yv * rs[k]); xv[4 * hh + k][j] = xn;
                __builtin_nontemporal_store(xn, (f32x4*)(const_cast<char*>(xb) + (4 * hh + k) * 4096 + j * 1024 + vo16));
                rs2[k] += (xn[0] * xn[0] + xn[1] * xn[1]) + (xn[2] * xn[2] + xn[3] * xn[3]); } }
        if (write_h) {
#pragma unroll
            for (int o = 1; o < 64; o <<= 1) {
#pragma unroll
                for (int k = 0; k < 4; ++k) rs2[k] += shx_t(rs2[k], lane4, o);
            }
#pragma unroll
            for (int k = 0; k < 4; ++k) rs2[k] = __builtin_amdgcn_rsqf(rs2[k] * (1.0f / DM) + EPS);
#pragma unroll
            for (int j = 0; j < 4; ++j) { const int c0 = 4 * lane + 256 * j;
                const f32x4 cb = *(const f32x4*)(npre + c0) * (*(const f32x4*)(modh + (size_t)b17 * NMOD + (shift_idx + 1) * DM + c0) + 1.0f);
                const f32x4 cc = *(const f32x4*)(modh + (size_t)b17 * NMOD + shift_idx * DM + c0);
#pragma unroll
                for (int k = 0; k < 4; ++k) { const f32x4 hv = (xv[4 * hh + k][j] * rs2[k]) * cb + cc;
                    *(u32x2*)(hb + (4 * hh + k) * 2048 + j * 512 + vo8) = (u32x2){pk2(hv[0], hv[1]), pk2(hv[2], hv[3])}; } }
        }
    }
}
constexpr int LDS_PEND_OFF = LDS_FLAG_OFF + 4;
__device__ __forceinline__ int rowq_step(unsigned* ctl, int total, LAS int* pend) {
    int p = *pend;
    if (p == -1) { const unsigned h = __hip_atomic_fetch_add(ctl + Q_HEAD, 1u, RLXA); p = ((int)h < total) ? (int)h : -2; }
    int item = -1;
    if (p >= 0) { const unsigned qe = __hip_atomic_load(ctl + Q_QUEUE + (p >> 2), RLXA); if (qe != 0u) { item = (int)(((qe - 1u) << 2) | ((unsigned)p & 3u)); p = -1; } }
    *pend = p;
    return item;
}
__device__ __forceinline__ void rowq_drain(LAS unsigned char* lds, unsigned* ctl, int total, CArgs* ap, int l, int which, bool y2, int tid, int wid) {
    LAS int* lflag = (LAS int*)(lds + LDS_FLAG_OFF); LAS int* pend = (LAS int*)(lds + LDS_PEND_OFF);
    for (;;) {
        __builtin_amdgcn_s_barrier();
        if (tid == 0) {
            int item = -1; int p = *pend;
            if (p == -1) { const unsigned h = __hip_atomic_fetch_add(ctl + Q_HEAD, 1u, RLXA); p = ((int)h < total) ? (int)h : -2; }
            if (p >= 0) {
                unsigned qe = 0u, spins = 0u;
                for (;;) { qe = __hip_atomic_load(ctl + Q_QUEUE + (p >> 2), RLXA); if (qe != 0u) break; __builtin_amdgcn_s_sleep(16); if (++spins > (1u << 21)) break; }
                if (qe != 0u) { item = (int)(((qe - 1u) << 2) | ((unsigned)p & 3u)); p = -1; } else p = -2;
            }
            *pend = p;
            if (item >= 0) { __builtin_amdgcn_fence(__ATOMIC_ACQUIRE, "agent"); asm volatile("s_waitcnt vmcnt(0)" ::: "memory"); }
            *lflag = item;
        }
        asm volatile("s_waitcnt lgkmcnt(0)" ::: "memory");
        __builtin_amdgcn_s_barrier();
        const int it = __builtin_amdgcn_readfirstlane(*lflag);
        if (it < 0) break;
        int lane = lane_id_fresh(); asm volatile("" : "+v"(lane));
        rowwise_quarter(ap, l, which, y2, it >> 2, it & 3, wid, lane);
    }
}

namespace pg8 {
constexpr int BM = 256, BK = 64, HALF = 128, HTB = HALF * BK * 2, STAGE_BYTES = 8 * HTB, NXCD = 8, WGM = 4;
__host__ __device__ __forceinline__ int lds_byte(int r, int c) { const int st = (r >> 4) * 2 + (c >> 5), rr = r & 15, cc = c & 31, ob = rr * 64 + cc * 2; return st * 1024 + (ob ^ (((ob >> 9) & 1) << 5)); }
__host__ __device__ __forceinline__ void stage_rc(int b, int& R, int& C) { const int st = b / 1024, sb = b % 1024, swz = sb ^ (((sb >> 9) & 1) << 5); R = (st >> 1) * 16 + swz / 64; C = (st & 1) * 32 + (swz % 64) / 2; }
__host__ __device__ __forceinline__ int perm32(int rho) { const int n = rho >> 4, i = rho & 15; return 8 * (i >> 2) + 4 * n + (i & 3); }

struct Unit { int pm, pn, z; };
struct Gemm { const bf16_t* A; const bf16_t* Bt; int M, N, K, lda, ldb; size_t zsA, zsB; int nz; };

struct StaticOrder {
    int nM, nN, nwg, G, c, nz;
    __device__ void init(int M, int N, int nz_, int G_, int c_) { nM = M / BM; nN = N / BM; nwg = nM * nN; G = G_; c = c_; nz = nz_; }
    __device__ bool next(int i, Unit& u) const {
        const long L = (long)i * G + c; if (L >= (long)nwg * nz) return false;
        u.z = (int)(L / nwg);
        int wgid = (int)(L % nwg); { const int q = nwg / NXCD, r = nwg % NXCD, xcd = wgid % NXCD, off = wgid / NXCD; wgid = (xcd < r ? xcd * (q + 1) : r * (q + 1) + (xcd - r) * q) + off; }
        const int nig = WGM * nN, gid = wgid / nig, fm = gid * WGM, gsz = (nM - fm) < WGM ? (nM - fm) : WGM;
        u.pm = fm + ((wgid % nig) % gsz); u.pn = (wgid % nig) / gsz; return true;
    }
};

template <class Epi, bool ALIGN_EPI, bool SP2, bool ZB>
__device__ __forceinline__ void gemm_phase(LAS unsigned char* lds, const int tid, const Gemm g, const StaticOrder& S, const Epi& E) {
    const int wid = __builtin_amdgcn_readfirstlane(tid >> 6), lane = tid & 63, wr = wid >> 2, wc = wid & 3, fr = lane & 15, fq = lane >> 4;
    const int K = g.K, nt = K / BK, lda = g.lda, ldb = g.ldb;
    unsigned voffA[2], voffB[2];
#pragma unroll
    for (int i = 0; i < 2; ++i) { int R, C; stage_rc(tid * 16 + i * 8192, R, C); const int Rb = Epi::PERM ? ((R & ~31) + perm32(R & 31)) : R;
        voffA[i] = (unsigned)(R * lda + C) * 2u; voffB[i] = (unsigned)(Rb * ldb + C) * 2u; }
    const size_t kstep = (size_t)(BK * 2);
    const size_t hstepA = (size_t)HALF * lda * 2, hstepB = (size_t)HALF * ldb * 2;
    const size_t tstepA = 2 * hstepA, tstepB = 2 * hstepB;
    const unsigned ldsw = (unsigned)wid * 1024u;
    const int aoff = lds_byte(wr * 64 + fr, fq * 8), boff = lds_byte(wc * 32 + fr, fq * 8);
#define PG8_SA(b, h) (((b) * 2 + (h)) * HTB)
#define PG8_SB(b, h) ((4 + (b) * 2 + (h)) * HTB)
#define PG8_STAGE(bufoff, gbase, voff) do { _Pragma("unroll") for (int _i = 0; _i < 2; ++_i) { unsigned _vo = (voff)[_i]; asm volatile("" : "+v"(_vo)); \
        __builtin_amdgcn_global_load_lds((const unsigned*)((const char*)(gbase) + _vo), (LAS unsigned*)(lds + (bufoff) + ldsw + _i * 8192), 16, 0, 0); } } while (0)
#define PG8_LDA(dst, b, h) do { _Pragma("unroll") for (int m = 0; m < 4; ++m) _Pragma("unroll") for (int k = 0; k < 2; ++k) dst[m][k] = *(const LAS bf16x8*)(lds + PG8_SA(b, h) + aoff + m * 2048 + k * 1024); } while (0)
#define PG8_LDB(dst, b, h) do { _Pragma("unroll") for (int n = 0; n < 2; ++n) _Pragma("unroll") for (int k = 0; k < 2; ++k) dst[n][k] = *(const LAS bf16x8*)(lds + PG8_SB(b, h) + boff + n * 2048 + k * 1024); } while (0)
#define PG8_MMA(ai, bj, At, Bt) do { __builtin_amdgcn_s_setprio(1); _Pragma("unroll") for (int m = 0; m < 4; ++m) _Pragma("unroll") for (int n = 0; n < 2; ++n) _Pragma("unroll") for (int k = 0; k < 2; ++k) \
        acc[ai][bj][m][n] = __builtin_amdgcn_mfma_f32_16x16x32_bf16(Bt[n][k], At[m][k], acc[ai][bj][m][n], 0, 0, 0); __builtin_amdgcn_s_setprio(0); } while (0)
#define PG8_WAIT_V(n) asm volatile("s_waitcnt vmcnt(" #n ")" ::: "memory")
#define PG8_WAIT_L(n) asm volatile("s_waitcnt lgkmcnt(" #n ")" ::: "memory")
#define PG8_BAR __builtin_amdgcn_s_barrier()
#define PG8_SCHED __builtin_amdgcn_sched_barrier(0)
    Unit cur, nxt; int ui = 0;
    if (!S.next(0, cur)) return;
    f32x4 acc[2][2][4][2];
#pragma unroll
    for (int a = 0; a < 2; ++a)
#pragma unroll
        for (int b = 0; b < 2; ++b)
#pragma unroll
            for (int m = 0; m < 4; ++m)
#pragma unroll
                for (int n = 0; n < 2; ++n) acc[a][b][m][n] = (f32x4){0.f, 0.f, 0.f, 0.f};
    bf16x8 At[4][2], B0[2][2], B1[2][2];
    const char* cA = (const char*)g.A + (ZB ? (size_t)cur.z * g.zsA : (size_t)0) + (size_t)cur.pm * tstepA; const char* cB = (const char*)g.Bt + (ZB ? (size_t)cur.z * g.zsB : (size_t)0) + (size_t)cur.pn * tstepB;
    if constexpr (SP2) {
        PG8_STAGE(PG8_SB(0, 0), cB, voffB); PG8_STAGE(PG8_SB(0, 1), cB + hstepB, voffB); PG8_STAGE(PG8_SA(0, 0), cA, voffA); PG8_STAGE(PG8_SA(0, 1), cA + hstepA, voffA);
        if (wr == 1) PG8_BAR;
        PG8_WAIT_V(2); PG8_BAR;
        PG8_STAGE(PG8_SB(1, 0), cB + kstep, voffB); PG8_STAGE(PG8_SA(1, 0), cA + kstep, voffA); PG8_STAGE(PG8_SB(1, 1), cB + hstepB + kstep, voffB);
        PG8_WAIT_V(6); PG8_BAR;
    } else {
        PG8_STAGE(PG8_SB(0, 0), cB, voffB); PG8_STAGE(PG8_SA(0, 0), cA, voffA); PG8_STAGE(PG8_SB(0, 1), cB + hstepB, voffB); PG8_STAGE(PG8_SA(0, 1), cA + hstepA, voffA);
        if (wr == 1) PG8_BAR;
        PG8_WAIT_V(4); PG8_BAR;
        PG8_STAGE(PG8_SB(1, 0), cB + kstep, voffB); PG8_STAGE(PG8_SA(1, 0), cA + kstep, voffA); PG8_STAGE(PG8_SB(1, 1), cB + hstepB + kstep, voffB);
        PG8_WAIT_V(6); PG8_BAR;
    }
    for (;;) {
        const bool has_next = S.next(ui + 1, nxt);
        const char* nA = has_next ? (const char*)g.A + (ZB ? (size_t)nxt.z * g.zsA : (size_t)0) + (size_t)nxt.pm * tstepA : cA; const char* nB = has_next ? (const char*)g.Bt + (ZB ? (size_t)nxt.z * g.zsB : (size_t)0) + (size_t)nxt.pn * tstepB : cB;
        for (int t = 0; t < nt; t += 2) {
            const bool last = (t == nt - 2);
            const char* a1 = cA + (size_t)(t + 1) * kstep;
            const char* a2 = last ? nA : cA + (size_t)(t + 2) * kstep; const char* b2 = last ? nB : cB + (size_t)(t + 2) * kstep;
            const char* a3 = a2 + kstep; const char* b3 = b2 + kstep;
            if constexpr (SP2) {
            PG8_LDB(B0, 0, 0); PG8_LDB(B1, 0, 1); PG8_SCHED; PG8_LDA(At, 0, 0); PG8_STAGE(PG8_SA(1, 1), a1 + hstepA, voffA);
            PG8_WAIT_V(8); PG8_WAIT_L(0); PG8_BAR; PG8_MMA(0, 0, At, B0); PG8_MMA(0, 1, At, B1); PG8_BAR; PG8_SCHED;
            PG8_LDA(At, 0, 1); PG8_STAGE(PG8_SB(0, 0), b2, voffB); PG8_STAGE(PG8_SB(0, 1), b2 + hstepB, voffB); PG8_STAGE(PG8_SA(0, 0), a2, voffA);
            PG8_WAIT_V(8); PG8_WAIT_L(0); PG8_BAR; PG8_MMA(1, 0, At, B0); PG8_MMA(1, 1, At, B1); PG8_BAR; PG8_SCHED;
            PG8_LDB(B0, 1, 0); PG8_LDB(B1, 1, 1); PG8_SCHED; PG8_LDA(At, 1, 0); PG8_STAGE(PG8_SA(0, 1), a2 + hstepA, voffA);
            PG8_WAIT_V(8); PG8_WAIT_L(0); PG8_BAR; PG8_MMA(0, 0, At, B0); PG8_MMA(0, 1, At, B1); PG8_BAR; PG8_SCHED;
            PG8_LDA(At, 1, 1); PG8_STAGE(PG8_SB(1, 0), b3, voffB); PG8_STAGE(PG8_SB(1, 1), b3 + hstepB, voffB); PG8_STAGE(PG8_SA(1, 0), a3, voffA);
            PG8_WAIT_V(8); PG8_WAIT_L(0); PG8_BAR; PG8_MMA(1, 0, At, B0); PG8_MMA(1, 1, At, B1); PG8_BAR; PG8_SCHED;
            } else {
            PG8_LDB(B0, 0, 0); PG8_SCHED; PG8_LDA(At, 0, 0); PG8_STAGE(PG8_SA(1, 1), a1 + hstepA, voffA);
            PG8_WAIT_L(8); PG8_BAR; PG8_WAIT_L(0); PG8_MMA(0, 0, At, B0); PG8_BAR; PG8_SCHED;
            PG8_LDB(B1, 0, 1); PG8_STAGE(PG8_SB(0, 0), b2, voffB);
            PG8_BAR; PG8_WAIT_L(0); PG8_MMA(0, 1, At, B1); PG8_BAR;
            PG8_LDA(At, 0, 1); PG8_STAGE(PG8_SA(0, 0), a2, voffA);
            PG8_BAR; PG8_WAIT_L(0); PG8_MMA(1, 0, At, B0); PG8_BAR; PG8_SCHED;
            PG8_STAGE(PG8_SB(0, 1), b2 + hstepB, voffB);
            PG8_WAIT_V(6); PG8_BAR; PG8_MMA(1, 1, At, B1); PG8_BAR;
            PG8_LDB(B0, 1, 0); PG8_SCHED; PG8_LDA(At, 1, 0); PG8_STAGE(PG8_SA(0, 1), a2 + hstepA, voffA);
            PG8_WAIT_L(8); PG8_BAR; PG8_WAIT_L(0); PG8_MMA(0, 0, At, B0); PG8_BAR; PG8_SCHED;
            PG8_LDB(B1, 1, 1); PG8_STAGE(PG8_SB(1, 0), b3, voffB);
            PG8_BAR; PG8_WAIT_L(0); PG8_MMA(0, 1, At, B1); PG8_BAR;
            PG8_LDA(At, 1, 1); PG8_STAGE(PG8_SA(1, 0), a3, voffA);
            PG8_BAR; PG8_WAIT_L(0); PG8_MMA(1, 0, At, B0); PG8_BAR; PG8_SCHED;
            PG8_STAGE(PG8_SB(1, 1), b3 + hstepB, voffB);
            PG8_WAIT_V(6); PG8_BAR; PG8_MMA(1, 1, At, B1); PG8_BAR;
            }
        }
        if constexpr (ALIGN_EPI) { if (wr == 0) PG8_BAR; }
        { const int lane_e = lane_id_fresh(); E(acc, cur, wr, wc, lane_e); }
        if constexpr (Epi::HAS_DONE) E.done(cur, lds, tid, wid);
        if (!has_next) break;
#pragma unroll
        for (int a = 0; a < 2; ++a)
#pragma unroll
            for (int b = 0; b < 2; ++b)
#pragma unroll
                for (int m = 0; m < 4; ++m)
#pragma unroll
                    for (int n = 0; n < 2; ++n) acc[a][b][m][n] = (f32x4){0.f, 0.f, 0.f, 0.f};
        cur = nxt; cA = nA; cB = nB; ++ui;
        if constexpr (ALIGN_EPI) { if (wr == 1) PG8_BAR; }
    }
    PG8_WAIT_V(0);
    if constexpr (!ALIGN_EPI) { if (wr == 0) PG8_BAR; }
    PG8_BAR;
#undef PG8_SA
#undef PG8_SB
#undef PG8_STAGE
#undef PG8_LDA
#undef PG8_LDB
#undef PG8_MMA
#undef PG8_WAIT_V
#undef PG8_WAIT_L
#undef PG8_BAR
#undef PG8_SCHED
}

typedef f32x4 Acc[2][2][4][2];

struct EpiSwiGLU {
    static constexpr bool PERM = true, HAS_DONE = false;
    bf16_t* G;
    __device__ __forceinline__ void operator()(const Acc& acc, const Unit& u, int wr, int wc, int lane) const {
        asm volatile("" : "+v"(lane)); const int fr = lane & 15, fq = lane >> 4;
        const int row0 = u.pm * BM + wr * 64 + fr, col0 = u.pn * 128 + wc * 32 + 8 * fq;
#pragma unroll
        for (int ai = 0; ai < 2; ++ai)
#pragma unroll
            for (int m = 0; m < 4; ++m) {
                const f32x4 g0 = acc[ai][0][m][0], g1 = acc[ai][0][m][1], u0 = acc[ai][1][m][0], u1 = acc[ai][1][m][1];
                u32x4 w;
                w.x = pk2(silu_f(g0[0]) * u0[0], silu_f(g0[1]) * u0[1]); w.y = pk2(silu_f(g0[2]) * u0[2], silu_f(g0[3]) * u0[3]);
                w.z = pk2(silu_f(g1[0]) * u1[0], silu_f(g1[1]) * u1[1]); w.w = pk2(silu_f(g1[2]) * u1[2], silu_f(g1[3]) * u1[3]);
                *(u32x4*)(G + (size_t)(row0 + ai * HALF + m * 16) * DFF + col0) = w;
            }
    }
};

struct EpiF32 {
    static constexpr bool PERM = false, HAS_DONE = false;
    float* Y; int ldc; size_t zs;
    __device__ __forceinline__ void operator()(const Acc& acc, const Unit& u, int wr, int wc, int lane) const {
        asm volatile("" : "+v"(lane)); const int fr = lane & 15, fq = lane >> 4;
        float* base = Y + (size_t)u.z * zs;
        const int row0 = u.pm * BM + wr * 64 + fr, col0 = u.pn * BM + wc * 32 + 4 * fq;
#pragma unroll
        for (int ai = 0; ai < 2; ++ai)
#pragma unroll
            for (int m = 0; m < 4; ++m) { float* rp = base + (size_t)(row0 + ai * HALF + m * 16) * ldc + col0;
#pragma unroll
                for (int bj = 0; bj < 2; ++bj)
#pragma unroll
                    for (int n = 0; n < 2; ++n) *(f32x4*)(rp + bj * HALF + n * 16) = acc[ai][bj][m][n]; }
    }
};

struct EpiBf16Y {
    static constexpr bool PERM = true, HAS_DONE = false;
    bf16_t* Y; bf16_t* Yz1;
    __device__ __forceinline__ void operator()(const Acc& acc, const Unit& u, int wr, int wc, int lane) const {
        asm volatile("" : "+v"(lane)); const int fr = lane & 15, fq = lane >> 4;
        const int row0 = u.pm * BM + wr * 64 + fr, col0 = u.pn * BM + wc * 32 + 8 * fq;
        bf16_t* Yb = u.z ? Yz1 : Y;
#pragma unroll
        for (int ai = 0; ai < 2; ++ai)
#pragma unroll
            for (int m = 0; m < 4; ++m) { bf16_t* rp = Yb + (size_t)(row0 + ai * HALF + m * 16) * DM + col0;
#pragma unroll
                for (int bj = 0; bj < 2; ++bj) { const f32x4 a0 = acc[ai][bj][m][0], a1 = acc[ai][bj][m][1];
                    *(u32x4*)(rp + bj * HALF) = (u32x4){pk2(a0[0], a0[1]), pk2(a0[2], a0[3]), pk2(a1[0], a1[1]), pk2(a1[2], a1[3])}; } }
    }
};

#ifndef YQ_STORE_AUX
#define YQ_STORE_AUX "sc0 sc1"
#endif
struct EpiBf16YQ {
    static constexpr bool PERM = true, HAS_DONE = true;
    bf16_t* Y; bf16_t* Yz1; unsigned* ctl; CArgs* ap; int pm_off, need, total, l, which; bool y2;
    __device__ __forceinline__ void operator()(const Acc& acc, const Unit& u, int wr, int wc, int lane) const {
        asm volatile("" : "+v"(lane)); const int fr = lane & 15, fq = lane >> 4;
        const int row0 = u.pm * BM + wr * 64 + fr, col0 = u.pn * BM + wc * 32 + 8 * fq;
        bf16_t* Yb = u.z ? Yz1 : Y;
#pragma unroll
        for (int ai = 0; ai < 2; ++ai)
#pragma unroll
            for (int m = 0; m < 4; ++m) { bf16_t* rp = Yb + (size_t)(row0 + ai * HALF + m * 16) * DM + col0;
#pragma unroll
                for (int bj = 0; bj < 2; ++bj) { const f32x4 a0 = acc[ai][bj][m][0], a1 = acc[ai][bj][m][1];
                    const u32x4 w = (u32x4){pk2(a0[0], a0[1]), pk2(a0[2], a0[3]), pk2(a1[0], a1[1]), pk2(a1[2], a1[3])};
                    asm volatile("global_store_dwordx4 %0, %1, off " YQ_STORE_AUX "\n\ts_nop 1" :: "v"(rp + bj * HALF), "v"(w) : "memory"); } }
    }
    __device__ __forceinline__ void done(const Unit& u, LAS unsigned char* lds, int tid, int wid) const {
        { int l0 = lane_id_fresh(); asm volatile("" : "+v"(l0)); tid = (wid == 0 && l0 == 0) ? 0 : 1; }
        asm volatile("s_waitcnt vmcnt(0)" ::: "memory");
        __builtin_amdgcn_s_barrier();
        LAS int* lflag = (LAS int*)(lds + LDS_FLAG_OFF);
        if (tid == 0) {
            const int pmg = pm_off + u.pm;
            LAS int* pend = (LAS int*)(lds + LDS_PEND_OFF);
            int p = *pend;
            const unsigned old = __hip_atomic_fetch_add(ctl + Q_CNT + pmg, 1u, RLXA);
            unsigned h = 0u; if (p == -1) h = __hip_atomic_fetch_add(ctl + Q_HEAD, 1u, RLXA);
            if (p == -1) p = ((int)h < total) ? (int)h : -2;
            unsigned qe = 0u; if (p >= 0) qe = __hip_atomic_load(ctl + Q_QUEUE + (p >> 2), RLXA);
            if (old + 1u == (unsigned)need) { const unsigned slot = __hip_atomic_fetch_add(ctl + Q_TAIL, 1u, RLXA); __hip_atomic_store(ctl + Q_QUEUE + slot, (unsigned)pmg + 1u, RLXA); }
            int item = -1;
            if (p >= 0 && qe != 0u) { item = (int)(((qe - 1u) << 2) | ((unsigned)p & 3u)); p = -1; }
            *pend = p;
            if (item >= 0) { __builtin_amdgcn_fence(__ATOMIC_ACQUIRE, "agent"); asm volatile("s_waitcnt vmcnt(0)" ::: "memory"); }
            *lflag = item;
        }
        asm volatile("s_waitcnt lgkmcnt(0)" ::: "memory");
        __builtin_amdgcn_s_barrier();
        const int it = __builtin_amdgcn_readfirstlane(*lflag);
        if (it >= 0) { int lane = lane_id_fresh(); asm volatile("" : "+v"(lane)); rowwise_quarter(ap, l, which, y2, it >> 2, it & 3, wid, lane); }
    }
};

struct EpiWin {
    static constexpr bool PERM = false, HAS_DONE = false;
    bf16_t *Q, *Kb, *VT, *SSMA, *CZ; const f32x2* CS;
    __device__ __forceinline__ void operator()(const Acc& acc, const Unit& u, int wr, int wc, int lane) const {
        asm volatile("" : "+v"(lane)); const int fr = lane & 15, fq = lane >> 4;
        const int pn = u.pn; const bool isctx = u.pm >= (ML / BM);
        f32x4 cc = {1.f, 1.f, 1.f, 1.f}, ss = {0.f, 0.f, 0.f, 0.f};
#pragma unroll
        for (int ai = 0; ai < 2; ++ai)
#pragma unroll
            for (int m = 0; m < 4; ++m) {
                const int r = u.pm * BM + ai * HALF + wr * 64 + m * 16 + fr;
                int b, pos;
                if (!isctx) { b = r >> 12; pos = r & 4095; } else { const int rc = r - ML; b = rc >> 8; pos = rc & 255; }
                if (pn <= 2 && !isctx) {
                    const int v = (wc & 1) ? (pos & 63) : (pos >> 6);
                    const f32x2* t = CS + v * 16 + 4 * fq;
                    const f32x2 t0 = t[0], t1 = t[1], t2 = t[2], t3 = t[3];
                    cc = (f32x4){t0.x, t1.x, t2.x, t3.x}; ss = (f32x4){t0.y, t1.y, t2.y, t3.y};
                }
#pragma unroll
                for (int bj = 0; bj < 2; ++bj) {
                    const f32x4 a0 = acc[ai][bj][m][0], a1 = acc[ai][bj][m][1];
                    const int cl = 128 * bj + 32 * wc + 4 * fq;
                    if (pn <= 1) {
                        f32x4 o0, o1;
                        if (!isctx) { o0 = a0 * cc - a1 * ss; o1 = a1 * cc + a0 * ss; } else { o0 = a0; o1 = a1; }
                        o0 = o0 * QSCALE; o1 = o1 * QSCALE;
                        bf16_t* p = Q + (size_t)r * 512 + pn * 256 + cl;
                        *(u32x2*)p = (u32x2){pk2(o0[0], o0[1]), pk2(o0[2], o0[3])}; *(u32x2*)(p + 16) = (u32x2){pk2(o1[0], o1[1]), pk2(o1[2], o1[3])};
                    } else if (pn == 2) {
                        if (bj == 0) {
                            f32x4 o0, o1;
                            if (!isctx) { o0 = a0 * cc - a1 * ss; o1 = a1 * cc + a0 * ss; } else { o0 = a0; o1 = a1; }
                            bf16_t* p = Kb + (size_t)r * 128 + 32 * wc + 4 * fq;
                            *(u32x2*)p = (u32x2){pk2(o0[0], o0[1]), pk2(o0[2], o0[3])}; *(u32x2*)(p + 16) = (u32x2){pk2(o1[0], o1[1]), pk2(o1[2], o1[3])};
                        } else {
                            const int vc = 32 * wc + 4 * fq;
                            const int pidx = isctx ? (SEQL + pos) : pos;
                            bf16_t* p = VT + ((size_t)(b * 2 + (vc >> 6)) * 64 + (vc & 63)) * VTP + pidx;
#pragma unroll
                            for (int j = 0; j < 4; ++j) { p[(size_t)j * VTP] = f2bf(a0[j]); p[(size_t)(j + 16) * VTP] = f2bf(a1[j]); }
                        }
                    } else if (pn == 3) {
                        const int g0 = 8 * bj + 2 * wc;
                        bf16_t* p = SSMA + ((size_t)g0 * NCHUNK + (r >> 4)) * 512 + (r & 15) * 16 + 4 * fq;
                        *(u32x2*)p = (u32x2){pk2(a0[0], a0[1]), pk2(a0[2], a0[3])};
                        *(u32x2*)(p + (size_t)NCHUNK * 512) = (u32x2){pk2(a1[0], a1[1]), pk2(a1[2], a1[3])};
                    } else {
                        bf16_t* p = CZ + (size_t)r * 768 + (pn - 4) * 256 + cl;
                        *(u32x2*)p = (u32x2){pk2(a0[0], a0[1]), pk2(a0[2], a0[3])}; *(u32x2*)(p + 16) = (u32x2){pk2(a1[0], a1[1]), pk2(a1[2], a1[3])};
                    }
                }
            }
    }
};

struct EpiSsmOut {
    static constexpr bool PERM = false, HAS_DONE = false;
    bf16_t* YG;
    __device__ __forceinline__ void operator()(const Acc& acc, const Unit& u, int wr, int wc, int lane) const {
        asm volatile("" : "+v"(lane)); const int fr = lane & 15, fq = lane >> 4;
#pragma unroll
        for (int ai = 0; ai < 2; ++ai)
#pragma unroll
            for (int m = 0; m < 4; ++m) {
                const int r = u.pm * BM + ai * HALF + wr * 64 + m * 16 + fr;
#pragma unroll
                for (int bj = 0; bj < 2; ++bj)
#pragma unroll
                    for (int n = 0; n < 2; ++n) {
                        const int t = 8 * bj + 2 * wc + n; const f32x4 a = acc[ai][bj][m][n];
                        bf16_t* p = YG + (size_t)(r * 16 + t) * 256 + u.z * 16 + 4 * fq;
                        *(u32x2*)p = (u32x2){pk2(gelu_tanh_f(a[0]), gelu_tanh_f(a[1])), pk2(gelu_tanh_f(a[2]), gelu_tanh_f(a[3]))};
                    }
            }
    }
};

struct EpiGlu {
    static constexpr bool PERM = true, HAS_DONE = false;
    const bf16_t* YG; const float* bias; bf16_t* MIX;
    __device__ __forceinline__ void operator()(const Acc& acc, const Unit& u, int wr, int wc, int lane) const {
        asm volatile("" : "+v"(lane)); const int fr = lane & 15, fq = lane >> 4;
        const int row0 = u.pm * BM + wr * 64 + fr;
#pragma unroll
        for (int bj = 0; bj < 2; ++bj) {
            const int col0 = bj * HALF + wc * 32 + 8 * fq;
            const f32x4 b0 = *(const f32x4*)(bias + col0), b1 = *(const f32x4*)(bias + col0 + 4);
#pragma unroll
            for (int ai = 0; ai < 2; ++ai)
#pragma unroll
                for (int m = 0; m < 4; ++m) {
                    const size_t r = (size_t)(row0 + ai * HALF + m * 16);
                    const u32x4 gv = *(const u32x4*)(YG + r * 256 + col0);
                    const f32x4 a0 = acc[ai][bj][m][0] + b0, a1 = acc[ai][bj][m][1] + b1;
                    float gg[8];
                    gg[0] = bf2f((unsigned short)(gv.x & 0xffff)); gg[1] = bf2f((unsigned short)(gv.x >> 16)); gg[2] = bf2f((unsigned short)(gv.y & 0xffff)); gg[3] = bf2f((unsigned short)(gv.y >> 16));
                    gg[4] = bf2f((unsigned short)(gv.z & 0xffff)); gg[5] = bf2f((unsigned short)(gv.z >> 16)); gg[6] = bf2f((unsigned short)(gv.w & 0xffff)); gg[7] = bf2f((unsigned short)(gv.w >> 16));
                    u32x4 w;
                    w.x = pk2(gg[0] * sigmoid_f(a0[0]), gg[1] * sigmoid_f(a0[1])); w.y = pk2(gg[2] * sigmoid_f(a0[2]), gg[3] * sigmoid_f(a0[3]));
                    w.z = pk2(gg[4] * sigmoid_f(a1[0]), gg[5] * sigmoid_f(a1[1])); w.w = pk2(gg[6] * sigmoid_f(a1[2]), gg[7] * sigmoid_f(a1[3]));
                    *(u32x4*)(MIX + r * 1024 + 512 + col0) = w;
                }
        }
    }
};
}

constexpr int NWAVES = 8, NTHR = 512;
constexpr int NPHASES = 3 + 10 * DEPTH;
constexpr int LDS_BYTES = 147456;

struct InView { CArgs* ap; __device__ __forceinline__ const float* operator[](int i) const { return ap->in[i]; } };
struct Ctx {
    LAS unsigned char* lds;
    int tid, lane, wave, G, bid;
    InView in;
    float* out; unsigned char* ws;
};

__device__ __forceinline__ float* xrow_ptr(const Ctx& F, int r) { return r < ML ? F.out + (size_t)r * DM : (float*)(F.ws + WS_XC) + (size_t)(r - ML) * DM; }

__device__ __forceinline__ void transpose_item(const float* W, int Nsrc, int k0, int n0, bf16_t* WT, int Kd, int drow0, LAS float* scr, int lane) {
#pragma unroll 8
    for (int i = 0; i < 32; ++i) { const int kk = 2 * i + (lane >> 5); scr[kk * 33 + (lane & 31)] = W[(size_t)(k0 + kk) * Nsrc + n0 + (lane & 31)]; }
    asm volatile("s_waitcnt lgkmcnt(0)" ::: "memory");
    const int c = lane & 7;
#pragma unroll
    for (int j = 0; j < 4; ++j) { const int n = (lane >> 3) + 8 * j; const LAS float* s = scr + (8 * c) * 33 + n;
        u32x4 o; o.x = pk2(s[0 * 33], s[1 * 33]); o.y = pk2(s[2 * 33], s[3 * 33]); o.z = pk2(s[4 * 33], s[5 * 33]); o.w = pk2(s[6 * 33], s[7 * 33]);
        *(u32x4*)(WT + (size_t)(drow0 + n) * Kd + k0 + 8 * c) = o; }
    asm volatile("s_waitcnt lgkmcnt(0)" ::: "memory");
}

__device__ __forceinline__ void phase_prologue(const Ctx& F) {
    const float* c_in = F.in[1]; const float* cctx = F.in[3]; const float* w_ada = F.in[4];
    {
        LAS float* sl = (LAS float*)F.lds;
        float* MODP = (float*)(F.ws + WS_MODP);
        for (int item = F.bid; item < 576; item += F.G) {
            const int l = item / 144, r2 = item % 144, kq = r2 / 18, nb = r2 % 18;
            __syncthreads();
            for (int idx = F.tid; idx < 17 * 128; idx += NTHR) { const int rr = idx >> 7, kk = idx & 127; const float v = rr < 16 ? c_in[rr * DM + kq * 128 + kk] : cctx[kq * 128 + kk]; sl[idx] = v / (1.0f + exp_f(-v)); }
            __syncthreads();
            const int n = nb * 512 + F.tid;
            float acc[17];
#pragma unroll
            for (int r = 0; r < 17; ++r) acc[r] = 0.f;
            const float* wp = w_ada + ((size_t)l * DM + kq * 128) * NMOD + n;
            for (int k0 = 0; k0 < 128; k0 += 16) {
                float w[16];
#pragma unroll
                for (int k = 0; k < 16; ++k) w[k] = __builtin_nontemporal_load(wp + (size_t)(k0 + k) * NMOD);
#pragma unroll
                for (int k = 0; k < 16; ++k) {
#pragma unroll
                    for (int r = 0; r < 17; ++r) acc[r] += sl[r * 128 + k0 + k] * w[k]; }
            }
#pragma unroll
            for (int r = 0; r < 17; ++r) MODP[(((size_t)kq * 4 + l) * 17 + r) * NMOD + n] = acc[r];
        }
        __syncthreads();
    }
    {
        LAS float* scr = (LAS float*)(F.lds + F.wave * 16384);
        const int gw = F.bid * NWAVES + F.wave, NGW = F.G * NWAVES;
        bf16_t* WGU = (bf16_t*)(F.ws + WS_WGU); bf16_t* WD = (bf16_t*)(F.ws + WS_WD); bf16_t* WIN = (bf16_t*)(F.ws + WS_WIN); bf16_t* WOUT = (bf16_t*)(F.ws + WS_WOUT); bf16_t* WGLU = (bf16_t*)(F.ws + WS_WGLU);
        constexpr int I_GU = 16 * 88, I_D = 44 * 32, I_IN = 16 * 56, I_OUT = 16 * 32, I_GLU = 4 * 8;
        constexpr int NITEMS = I_GU * 16 + I_D * 8 + I_IN * 4 + I_OUT * 4 + I_GLU * 4;
        for (int it = gw; it < NITEMS; it += NGW) {
            int r = it;
            if (r < I_GU * 16) { const int up = r / (I_GU * 8); r -= up * I_GU * 8; const int ls = r / I_GU; r %= I_GU; const int kb = r / 88, nb = r % 88, n0 = nb * 32;
                transpose_item(F.in[up ? 9 : 8] + (size_t)ls * DM * DFF, DFF, kb * 64, n0, WGU + (size_t)ls * 5632 * DM, DM, (n0 / 128) * 256 + (n0 % 128) + up * 128, scr, F.lane); continue; }
            r -= I_GU * 16;
            if (r < I_D * 8) { const int ls = r / I_D; r %= I_D; const int kb = r / 32, nb = r % 32;
                transpose_item(F.in[10] + (size_t)ls * DFF * DM, DM, kb * 64, nb * 32, WD + (size_t)ls * DM * DFF, DFF, nb * 32, scr, F.lane); continue; }
            r -= I_D * 8;
            if (r < I_IN * 4) { const int l = r / I_IN; r %= I_IN; const int kb = r / 56, nb = r % 56;
                transpose_item(F.in[11] + (size_t)l * DM * INC, INC, kb * 64, nb * 32, WIN + (size_t)l * INC * DM, DM, nb * 32, scr, F.lane); continue; }
            r -= I_IN * 4;
            if (r < I_OUT * 4) { const int l = r / I_OUT; r %= I_OUT; const int kb = r / 32, nb = r % 32;
                transpose_item(F.in[12] + (size_t)l * DM * DM, DM, kb * 64, nb * 32, WOUT + (size_t)l * DM * DM, DM, nb * 32, scr, F.lane); continue; }
            r -= I_OUT * 4;
            { const int l = r / I_GLU; r %= I_GLU; const int kb = r / 8, nb = r % 8;
                transpose_item(F.in[22] + (size_t)l * 256 * 256, 256, kb * 64, nb * 32, WGLU + (size_t)l * 256 * 256, 256, nb * 32, scr, F.lane); }
        }
    }
    const int gt = F.bid * NTHR + F.tid;
    if (gt < 12 * Q_SLOT_WORDS) ((unsigned*)(F.ws + WS_CTL))[gt] = 0u;
    if (gt < 1024) {
        const int v = gt >> 4, i = gt & 15;
        const float inv = __builtin_amdgcn_exp2f(-13.287712379549449f * (float)i * 0.0625f);
        float rev = (float)v * inv * 0.15915494309189535f; rev -= __builtin_rintf(rev);
        ((f32x2*)(F.ws + WS_CS))[gt] = (f32x2){__builtin_amdgcn_cosf(rev), __builtin_amdgcn_sinf(rev)};
    }
    if (gt >= 1024 && gt < 1024 + 8192) {
        const int id = gt - 1024, ldg = id >> 6, p = id & 63;
        const float lr = F.in[14][id], li = F.in[15][id]; const float dt = exp_f(F.in[16][ldg]);
        f32x2* AP = (f32x2*)(F.ws + WS_APOW) + (size_t)ldg * 17 * 64 + p;
        float a1r = 1.f, a1i = 0.f;
        for (int n = 0; n <= 16; ++n) {
            const float mag = exp_f((float)n * lr * dt);
            double a = (double)n * (double)li * (double)dt * 0.15915494309189535; a -= rint(a);
            const float rev = (float)a; const float cr = mag * __builtin_amdgcn_cosf(rev), ci = mag * __builtin_amdgcn_sinf(rev);
            AP[n * 64] = (f32x2){cr, ci};
            if (n == 1) { a1r = cr; a1i = ci; }
        }
        const float den = lr * lr + li * li;
        const float gr = ((a1r - 1.f) * lr + a1i * li) / den, gi = (a1i * lr - (a1r - 1.f) * li) / den;
        f32x2* BB = (f32x2*)(F.ws + WS_BBAR) + (size_t)id * 16;
        for (int h = 0; h < 16; ++h) { const float br = F.in[17][(size_t)id * 16 + h], bi = F.in[18][(size_t)id * 16 + h]; BB[h] = (f32x2){gr * br - gi * bi, gr * bi + gi * br}; }
    }
}

__device__ __forceinline__ float ssm_kval(const Ctx& F, int ldg, int tau, int h, int h2) {
    const float* cr = F.in[19] + ((size_t)ldg * 16 + h) * 64; const float* ci = F.in[20] + ((size_t)ldg * 16 + h) * 64;
    const f32x2* AP = (const f32x2*)(F.ws + WS_APOW) + ((size_t)ldg * 17 + tau) * 64;
    const f32x2* BB = (const f32x2*)(F.ws + WS_BBAR) + (size_t)ldg * 64 * 16 + h2;
    float s = 0.f;
    for (int p = 0; p < 64; ++p) { const f32x2 a = AP[p], b = BB[p * 16]; const float c_r = cr[p], c_i = ci[p];
        const float er = c_r * a.x - c_i * a.y, ei = c_r * a.y + c_i * a.x; s += er * b.x - ei * b.y; }
    return s;
}
__device__ __forceinline__ void phase_prologue2(const Ctx& F) {
    const int gt = F.bid * NTHR + F.tid, NT = F.G * NTHR;
    float* MOD = (float*)(F.ws + WS_MOD); const float* MODP = (const float*)(F.ws + WS_MODP);
    for (int idx = gt; idx < 4 * 17 * NMOD; idx += NT) {
        const int l = idx / (17 * NMOD), n = idx % NMOD;
        float s = F.in[5][l * NMOD + n];
#pragma unroll
        for (int kq = 0; kq < 8; ++kq) s += MODP[(size_t)kq * 4 * 17 * NMOD + idx];
        MOD[idx] = s;
    }
    float* KT = (float*)(F.ws + WS_KT);
    for (int idx = gt; idx < 4 * 2 * 16 * 16 * 256; idx += NT) {
        const int h2 = idx & 15, h = (idx >> 4) & 15, tau = (idx >> 8) & 15, g = (idx >> 12) & 15, dir = (idx >> 16) & 1, l = idx >> 17;
        KT[idx] = ssm_kval(F, (l * 2 + dir) * 16 + g, tau, h, h2);
    }
    bf16_t* SST = (bf16_t*)(F.ws + WS_SST);
    for (int idx = gt; idx < 4 * 16 * 256 * 256; idx += NT) {
        const int k = idx & 255, n = (idx >> 8) & 255, g = (idx >> 16) & 15, l = idx >> 20;
        const int dir = n >> 7, ri = (n >> 6) & 1, p = n & 63, j = k >> 4, h2 = k & 15, pw = dir == 0 ? 15 - j : j, ldg = (l * 2 + dir) * 16 + g;
        const f32x2 a = ((const f32x2*)(F.ws + WS_APOW))[((size_t)ldg * 17 + pw) * 64 + p];
        const f32x2 b = ((const f32x2*)(F.ws + WS_BBAR))[((size_t)ldg * 64 + p) * 16 + h2];
        SST[idx] = f2bf(ri == 0 ? (a.x * b.x - a.y * b.y) : (a.x * b.y + a.y * b.x));
    }
}
__device__ __forceinline__ void phase_prologue3(const Ctx& F) {
    const int gt = F.bid * NTHR + F.tid, NT = F.G * NTHR;
    bf16_t* SOUT = (bf16_t*)(F.ws + WS_SOUT); const float* KT = (const float*)(F.ws + WS_KT);
    for (int idx = gt; idx < 4 * 16 * 256 * 512; idx += NT) {
        const int k = idx & 511, row = (idx >> 9) & 255, g = (idx >> 17) & 15, l = idx >> 21, t = row >> 4, h = row & 15;
        float val = 0.f;
        if (k < 256) { const int j = k >> 4, h2 = k & 15;
            if (j <= t) val += KT[(((((size_t)l * 2 + 0) * 16 + g) * 16 + (t - j)) * 16 + h) * 16 + h2];
            if (j >= t) val += KT[(((((size_t)l * 2 + 1) * 16 + g) * 16 + (j - t)) * 16 + h) * 16 + h2];
            if (j == t && h == h2) val += F.in[21][l * 256 + g * 16 + h];
        } else { const int kk = k - 256, dir = kk >> 7, ri = (kk >> 6) & 1, p = kk & 63, n = dir == 0 ? t + 1 : 16 - t, ldg = (l * 2 + dir) * 16 + g;
            const float c_r = F.in[19][((size_t)ldg * 16 + h) * 64 + p], c_i = F.in[20][((size_t)ldg * 16 + h) * 64 + p];
            const f32x2 a = ((const f32x2*)(F.ws + WS_APOW))[((size_t)ldg * 17 + n) * 64 + p];
            const float er = c_r * a.x - c_i * a.y, ei = c_r * a.y + c_i * a.x; val = ri == 0 ? er : -ei; }
        SOUT[idx] = f2bf(val);
    }
}

__device__ __forceinline__ void phase_rowwise(const Ctx& F, bool first, bool has_y, bool y2, bool write_h, int nrows, float fac,
                                              const float* gpost, const float* modg  , int gate_idx,
                                              const float* gpre, const float* modh  , int shift_idx, int scale_idx) {
    const int gw = F.bid * NWAVES + F.wave, NGW = F.G * NWAVES, lane = F.lane;
    const bf16_t* Y = (const bf16_t*)(F.ws + WS_Y); bf16_t* H = (bf16_t*)(F.ws + WS_H);
    constexpr int NR = 2;
    for (int rb = gw; rb < nrows; rb += NR * NGW) {
        f32x4 xv[NR][4], yv[NR][4]; float* xr[NR]; int b17[NR]; bool ok[NR]; int rr[NR];
#pragma unroll
        for (int k = 0; k < NR; ++k) {
            const int r0 = rb + k * NGW; ok[k] = r0 < nrows; const int r = ok[k] ? r0 : rb; rr[k] = r;
            b17[k] = r < ML ? (r >> 12) : 16; xr[k] = xrow_ptr(F, r);
            const float* xs = first ? (r < ML ? F.in[0] + (size_t)r * DM : F.in[2] + (size_t)(r - ML) * DM) : xr[k];
#pragma unroll
            for (int j = 0; j < 4; ++j) xv[k][j] = __builtin_nontemporal_load((const f32x4*)(xs + 4 * lane + 256 * j));
            if (has_y) {
#pragma unroll
                for (int j = 0; j < 4; ++j) { const u32x2 w = __builtin_nontemporal_load((const u32x2*)(Y + (size_t)r * DM + 4 * lane + 256 * j));
                    yv[k][j] = (f32x4){bf2f((unsigned short)(w.x & 0xffff)), bf2f((unsigned short)(w.x >> 16)), bf2f((unsigned short)(w.y & 0xffff)), bf2f((unsigned short)(w.y >> 16))}; }
                if (y2 && r >= ML) {
#pragma unroll
                    for (int j = 0; j < 4; ++j) { const u32x2 w = __builtin_nontemporal_load((const u32x2*)((const bf16_t*)(F.ws + WS_Y2) + (size_t)(r - ML) * DM + 4 * lane + 256 * j));
                        yv[k][j] = yv[k][j] + (f32x4){bf2f((unsigned short)(w.x & 0xffff)), bf2f((unsigned short)(w.x >> 16)), bf2f((unsigned short)(w.y & 0xffff)), bf2f((unsigned short)(w.y >> 16))}; }
                }
            }
        }
        if (has_y) {
            float s[NR];
#pragma unroll
            for (int k = 0; k < NR; ++k) { s[k] = 0.f;
#pragma unroll
                for (int j = 0; j < 4; ++j) s[k] += (yv[k][j][0] * yv[k][j][0] + yv[k][j][1] * yv[k][j][1]) + (yv[k][j][2] * yv[k][j][2] + yv[k][j][3] * yv[k][j][3]); }
#pragma unroll
            for (int o = 1; o < 64; o <<= 1) {
#pragma unroll
                for (int k = 0; k < NR; ++k) s[k] += shx(s[k], lane, o);
            }
#pragma unroll
            for (int k = 0; k < NR; ++k) { const float rs = fac * __builtin_amdgcn_rsqf(s[k] * (1.0f / DM) + EPS);
#pragma unroll
                for (int j = 0; j < 4; ++j) { const f32x4 gp = *(const f32x4*)(gpost + 4 * lane + 256 * j); const f32x4 gt = *(const f32x4*)(modg + (size_t)b17[k] * NMOD + gate_idx * DM + 4 * lane + 256 * j);
                    xv[k][j] = xv[k][j] + gt * (yv[k][j] * rs * gp); } }
        }
        if (has_y || first) {
#pragma unroll
            for (int k = 0; k < NR; ++k) if (ok[k]) {
#pragma unroll
                for (int j = 0; j < 4; ++j) __builtin_nontemporal_store(xv[k][j], (f32x4*)(xr[k] + 4 * lane + 256 * j)); }
        }
        if (write_h) {
            float s[NR];
#pragma unroll
            for (int k = 0; k < NR; ++k) { s[k] = 0.f;
#pragma unroll
                for (int j = 0; j < 4; ++j) s[k] += (xv[k][j][0] * xv[k][j][0] + xv[k][j][1] * xv[k][j][1]) + (xv[k][j][2] * xv[k][j][2] + xv[k][j][3] * xv[k][j][3]); }
#pragma unroll
            for (int o = 1; o < 64; o <<= 1) {
#pragma unroll
                for (int k = 0; k < NR; ++k) s[k] += shx(s[k], lane, o);
            }
#pragma unroll
            for (int k = 0; k < NR; ++k) if (ok[k]) { const float rs = __builtin_amdgcn_rsqf(s[k] * (1.0f / DM) + EPS);
#pragma unroll
                for (int j = 0; j < 4; ++j) { const int c0 = 4 * lane + 256 * j; const f32x4 gp = *(const f32x4*)(gpre + c0);
                    const f32x4 sh = *(const f32x4*)(modh + (size_t)b17[k] * NMOD + shift_idx * DM + c0), sc = *(const f32x4*)(modh + (size_t)b17[k] * NMOD + scale_idx * DM + c0);
                    const f32x4 hv = (xv[k][j] * rs * gp) * (sc + 1.0f) + sh;
                    *(u32x2*)(H + (size_t)rr[k] * DM + c0) = (u32x2){pk2(hv[0], hv[1]), pk2(hv[2], hv[3])}; } }
        }
    }
}

__device__ __forceinline__ int crow(int r, int hi) { return (r & 3) + 8 * (r >> 2) + 4 * hi; }
__device__ __forceinline__ void attn_tile(LAS unsigned char* lb, bool local, int kvstart, int qpos, int q, int hi, int lane, const bf16x8 (&qf)[4], float& mrun, float& lsum, f32x16 (&ot)[2]) {
    f32x16 p0, p1;
#pragma unroll
    for (int i = 0; i < 16; ++i) { p0[i] = 0.f; p1[i] = 0.f; }
#pragma unroll
    for (int s = 0; s < 4; ++s) {
        const bf16x8 a0 = *(const LAS bf16x8*)(lb + q * 144 + 32 * s + 16 * hi);
        const bf16x8 a1 = *(const LAS bf16x8*)(lb + (32 + q) * 144 + 32 * s + 16 * hi);
        p0 = __builtin_amdgcn_mfma_f32_32x32x16_bf16(a0, qf[s], p0, 0, 0, 0);
        p1 = __builtin_amdgcn_mfma_f32_32x32x16_bf16(a1, qf[s], p1, 0, 0, 0);
    }
    if (local) {
#pragma unroll
        for (int i = 0; i < 16; ++i) { const int d0 = kvstart + crow(i, hi) - qpos; if (d0 > 128 || d0 < -128) p0[i] = -1e30f; const int d1 = d0 + 32; if (d1 > 128 || d1 < -128) p1[i] = -1e30f; }
    }
    float mx = p0[0];
#pragma unroll
    for (int i = 1; i < 16; ++i) mx = fmaxf(mx, p0[i]);
#pragma unroll
    for (int i = 0; i < 16; ++i) mx = fmaxf(mx, p1[i]);
    mx = fmaxf(mx, shx(mx, lane, 32));
    const float mnew = fmaxf(mrun, mx), sc = __builtin_amdgcn_exp2f(mrun - mnew); mrun = mnew;
    float ps = 0.f;
#pragma unroll
    for (int i = 0; i < 16; ++i) { p0[i] = __builtin_amdgcn_exp2f(p0[i] - mnew); p1[i] = __builtin_amdgcn_exp2f(p1[i] - mnew); ps += p0[i] + p1[i]; }
    lsum = lsum * sc + ps;
#pragma unroll
    for (int i = 0; i < 16; ++i) { ot[0][i] *= sc; ot[1][i] *= sc; }
    bf16x8 pb[4];
#pragma unroll
    for (int ks = 0; ks < 4; ++ks) {
        u32x4 w;
        if (ks < 2) { w.x = pk2(p0[8 * ks + 0], p0[8 * ks + 1]); w.y = pk2(p0[8 * ks + 2], p0[8 * ks + 3]); w.z = pk2(p0[8 * ks + 4], p0[8 * ks + 5]); w.w = pk2(p0[8 * ks + 6], p0[8 * ks + 7]); }
        else { const int k2 = ks - 2; w.x = pk2(p1[8 * k2 + 0], p1[8 * k2 + 1]); w.y = pk2(p1[8 * k2 + 2], p1[8 * k2 + 3]); w.z = pk2(p1[8 * k2 + 4], p1[8 * k2 + 5]); w.w = pk2(p1[8 * k2 + 6], p1[8 * k2 + 7]); }
        pb[ks] = __builtin_bit_cast(bf16x8, w);
    }
#pragma unroll
    for (int dh = 0; dh < 2; ++dh)
#pragma unroll
        for (int ks = 0; ks < 4; ++ks) {
            const s16x4 lo = *(const LAS s16x4*)(lb + 9216 + (32 * dh + q) * 144 + (16 * ks + 4 * hi) * 2);
            const s16x4 h4 = *(const LAS s16x4*)(lb + 9216 + (32 * dh + q) * 144 + (16 * ks + 8 + 4 * hi) * 2);
            const bf16x8 va = __builtin_shufflevector(lo, h4, 0, 1, 2, 3, 4, 5, 6, 7);
            ot[dh] = __builtin_amdgcn_mfma_f32_32x32x16_bf16(va, pb[ks], ot[dh], 0, 0, 0);
        }
}
__device__ __forceinline__ void attn_unit(const Ctx& F, int b, int kh, int qc, const float* sink  ) {
    const bf16_t* Qb = (const bf16_t*)(F.ws + WS_Q); const bf16_t* Kb = (const bf16_t*)(F.ws + WS_K); const bf16_t* VT = (const bf16_t*)(F.ws + WS_VT); bf16_t* MIX = (bf16_t*)(F.ws + WS_H);
    LAS unsigned char* lds = F.lds;
    const int lane = F.lane, q = lane & 31, hi = lane >> 5, hq = kh * 4 + (F.wave >> 1), qs = F.wave & 1;
    const bool isctx = qc >= 64;
    int qpos; size_t qrow;
    if (!isctx) { qpos = qc * 64 + qs * 32 + q; qrow = (size_t)b * SEQL + qpos; } else { qpos = (qc - 64) * 64 + qs * 32 + q; qrow = (size_t)ML + b * NCTX + qpos; }
    const int ilo = isctx ? 0 : (qc < 2 ? 2 - qc : 0), ihi = isctx ? -1 : (65 - qc < 4 ? 65 - qc : 4), nloc = ihi - ilo + 1, nt = nloc + 4;
    const int row = F.tid >> 3, ch = F.tid & 7;
    const bf16_t* kbase = Kb + (size_t)row * 128 + kh * 64 + ch * 8;
    const bf16_t* vbase = VT + ((size_t)(b * 2 + kh) * 64 + row) * VTP + ch * 8;
#define ATT_LOAD(t, kk, vv) do { const int t_ = (t); size_t kr_; int vi_; \
        if (t_ < nloc) { const int ks_ = qc * 64 - 128 + 64 * (ilo + t_); kr_ = (size_t)b * SEQL + ks_; vi_ = ks_; } else { const int c_ = t_ - nloc; kr_ = (size_t)ML + b * NCTX + 64 * c_; vi_ = SEQL + 64 * c_; } \
        kk = *(const u32x4*)(kbase + kr_ * 128); vv = *(const u32x4*)(vbase + vi_); } while (0)
#define ATT_STORE(bo, kk, vv) do { *(LAS u32x4*)(lds + (bo) + row * 144 + ch * 16) = kk; *(LAS u32x4*)(lds + (bo) + 9216 + row * 144 + ch * 16) = vv; } while (0)
    u32x4 kA, vA, kB, vB;
    ATT_LOAD(0, kA, vA); ATT_LOAD(1, kB, vB);
    bf16x8 qf[4];
#pragma unroll
    for (int s = 0; s < 4; ++s) qf[s] = *(const bf16x8*)(Qb + qrow * 512 + hq * 64 + 16 * s + 8 * hi);
    float mrun = sink[hq] * LOG2E, lsum = hi == 0 ? 1.0f : 0.0f;
    f32x16 ot[2];
#pragma unroll
    for (int i = 0; i < 16; ++i) { ot[0][i] = 0.f; ot[1][i] = 0.f; }
    __syncthreads();
    for (int t = 0; t < nt; t += 2) {
        ATT_STORE(0, kA, vA);
        __syncthreads();
        if (t + 2 < nt) ATT_LOAD(t + 2, kA, vA);
        attn_tile(lds, t < nloc, qc * 64 - 128 + 64 * (ilo + t), qpos, q, hi, lane, qf, mrun, lsum, ot);
        if (t + 1 < nt) {
            ATT_STORE(18432, kB, vB);
            __syncthreads();
            if (t + 3 < nt) ATT_LOAD(t + 3, kB, vB);
            attn_tile(lds + 18432, t + 1 < nloc, qc * 64 - 128 + 64 * (ilo + t + 1), qpos, q, hi, lane, qf, mrun, lsum, ot);
        }
    }
#undef ATT_LOAD
#undef ATT_STORE
    lsum += shx(lsum, lane, 32);
    const float inv = 1.0f / lsum;
#pragma unroll
    for (int dh = 0; dh < 2; ++dh)
#pragma unroll
        for (int g4 = 0; g4 < 4; ++g4) {
            const int d0 = 32 * dh + 8 * g4 + 4 * hi;
            *(u32x2*)(MIX + qrow * 1024 + hq * 64 + d0) = (u32x2){pk2(ot[dh][4 * g4] * inv, ot[dh][4 * g4 + 1] * inv), pk2(ot[dh][4 * g4 + 2] * inv, ot[dh][4 * g4 + 3] * inv)};
        }
}
__device__ __forceinline__ void phase_attn(const Ctx& F, int l, bool lastl) {
    const int nq = lastl ? 64 : 68, nunits = NB * 2 * nq;
    for (int id = F.bid; id < nunits; id += F.G) { const int bk = id / nq, qc = id % nq; attn_unit(F, bk >> 1, bk & 1, qc, F.in[13] + l * 8); }
    __syncthreads();
}

__device__ __forceinline__ void unpack8(const u32x4 v, float* f) {
    f[0] = bf2f((unsigned short)(v.x & 0xffff)); f[1] = bf2f((unsigned short)(v.x >> 16)); f[2] = bf2f((unsigned short)(v.y & 0xffff)); f[3] = bf2f((unsigned short)(v.y >> 16));
    f[4] = bf2f((unsigned short)(v.z & 0xffff)); f[5] = bf2f((unsigned short)(v.z >> 16)); f[6] = bf2f((unsigned short)(v.w & 0xffff)); f[7] = bf2f((unsigned short)(v.w >> 16));
}
__device__ __forceinline__ void phase_conv(const Ctx& F, int l, int nrows) {
    const bf16_t* CZ = (const bf16_t*)(F.ws + WS_CZ); bf16_t* MIX = (bf16_t*)(F.ws + WS_H); const float* cw = F.in[24] + l * 768;
    const int gt = F.bid * NTHR + F.tid, NT = F.G * NTHR;
    for (int idx = gt; idx < nrows * 32; idx += NT) {
        const int r = idx >> 5, c0 = (idx & 31) * 8;
        int pos, len; if (r < ML) { pos = r & 4095; len = SEQL; } else { pos = (r - ML) & 255; len = NCTX; }
        const bf16_t* p = CZ + (size_t)r * 768 + c0;
        float gb[8], gc[8], z[8], tp[8], tn[8], a[8], b2[8];
        unpack8(*(const u32x4*)p, gb); unpack8(*(const u32x4*)(p + 256), gc); unpack8(*(const u32x4*)(p + 512), z);
        if (pos > 0) { unpack8(*(const u32x4*)(p - 768 + 256), a); unpack8(*(const u32x4*)(p - 768 + 512), b2);
#pragma unroll
            for (int i = 0; i < 8; ++i) tp[i] = a[i] * b2[i]; }
        else {
#pragma unroll
            for (int i = 0; i < 8; ++i) tp[i] = 0.f; }
        if (pos < len - 1) { unpack8(*(const u32x4*)(p + 768 + 256), a); unpack8(*(const u32x4*)(p + 768 + 512), b2);
#pragma unroll
            for (int i = 0; i < 8; ++i) tn[i] = a[i] * b2[i]; }
        else {
#pragma unroll
            for (int i = 0; i < 8; ++i) tn[i] = 0.f; }
        float o[8];
#pragma unroll
        for (int i = 0; i < 8; ++i) o[i] = gb[i] * (tp[i] * cw[c0 + i] + (gc[i] * z[i]) * cw[256 + c0 + i] + tn[i] * cw[512 + c0 + i]);
        *(u32x4*)(MIX + (size_t)r * 1024 + 768 + c0) = (u32x4){pk2(o[0], o[1]), pk2(o[2], o[3]), pk2(o[4], o[5]), pk2(o[6], o[7])};
    }
}

__device__ __forceinline__ int scan_chunk(int b, int dir, int step) {
    return step < 16 ? NB * 256 + b * 16 + (dir == 0 ? step : 15 - step) : b * 256 + (dir == 0 ? step - 16 : 271 - step);
}
__device__ __forceinline__ void phase_scan(const Ctx& F, int l) {
    const float* SL = (const float*)(F.ws + WS_SL); bf16_t* SSMA = (bf16_t*)(F.ws + WS_SSMA);
    LAS f32x2* sh = (LAS f32x2*)F.lds;
    for (int id = F.bid; id < 512; id += F.G) {
        const int b = id >> 5, g = (id >> 1) & 15, dir = id & 1, p = F.lane, seg = F.wave, ldg = (l * 2 + dir) * 16 + g;
        const f32x2 a16 = ((const f32x2*)(F.ws + WS_APOW))[((size_t)ldg * 17 + 16) * 64 + p];
        const float ar = a16.x, ai = a16.y;
        const size_t gbase = (size_t)g * NCHUNK;
        float xr[34], xi[34];
#pragma unroll
        for (int j = 0; j < 34; ++j) { const size_t rowc = gbase + scan_chunk(b, dir, seg * 34 + j); xr[j] = SL[rowc * 256 + dir * 128 + p]; xi[j] = SL[rowc * 256 + dir * 128 + 64 + p]; }
        float sr = 0.f, si = 0.f;
#pragma unroll
        for (int j = 0; j < 34; ++j) { const float nr = ar * sr - ai * si + xr[j], ni = ar * si + ai * sr + xi[j]; sr = nr; si = ni; }
        __syncthreads();
        sh[seg * 64 + p] = (f32x2){sr, si};
        float pr = ar, pi = ai, p2r, p2i;
        { const float tr = pr * pr - pi * pi, ti = 2.f * pr * pi; pr = tr; pi = ti; } p2r = pr; p2i = pi;
#pragma unroll
        for (int k = 0; k < 4; ++k) { const float tr = pr * pr - pi * pi, ti = 2.f * pr * pi; pr = tr; pi = ti; }
        { const float tr = pr * p2r - pi * p2i, ti = pr * p2i + pi * p2r; pr = tr; pi = ti; }
        __syncthreads();
        sr = 0.f; si = 0.f;
        for (int s2 = 0; s2 < seg; ++s2) { const f32x2 tt = sh[s2 * 64 + p]; const float nr = pr * sr - pi * si + tt.x, ni = pr * si + pi * sr + tt.y; sr = nr; si = ni; }
#pragma unroll
        for (int j = 0; j < 34; ++j) { const size_t rowc = gbase + scan_chunk(b, dir, seg * 34 + j);
            SSMA[rowc * 512 + 256 + dir * 128 + p] = f2bf(sr); SSMA[rowc * 512 + 256 + dir * 128 + 64 + p] = f2bf(si);
            const float nr = ar * sr - ai * si + xr[j], ni = ar * si + ai * sr + xi[j]; sr = nr; si = ni; }
    }
    __syncthreads();
}

#ifndef MK_MULTI
#define MK_MULTI 0
#endif
constexpr size_t WS_BAR = 195 * MiB + 131072;
constexpr int LDS_BARST_OFF = 131072 + 64;
#define XB_TMO      128
#define XB_XCNT(j)  (256  + 64 * (j))
#define XB_XSUB(j)  (1280 + 64 * (j))
#define XB_XGEN(j)  (2304 + 64 * (j))
#define XB_TOP      3328
#define XB_TOPGEN   3392
#define XCD_BAR_WORDS 3456
#define XB_SPIN_CAP (1u << 20)
__device__ __forceinline__ unsigned xb_ld(unsigned* p)              { return __hip_atomic_load(p, __ATOMIC_RELAXED, __HIP_MEMORY_SCOPE_AGENT); }
__device__ __forceinline__ unsigned xb_add(unsigned* p, unsigned v) { return __hip_atomic_fetch_add(p, v, __ATOMIC_RELAXED, __HIP_MEMORY_SCOPE_AGENT); }
__device__ __forceinline__ unsigned xb_xcc_id() { return (unsigned)__builtin_amdgcn_s_getreg((3 << 11) | 20) & 0xFu; }
#define XB_SPIN(cond, bar) do { unsigned _sp = 0; while (cond) { __builtin_amdgcn_s_sleep(1); \
    if ((++_sp & 255u) == 0u) { if (xb_ld(&(bar)[XB_TMO])) break; if (_sp > XB_SPIN_CAP) { atomicAdd(&(bar)[XB_TMO], 1u); break; } } } } while (0)
struct XcdBarrier { unsigned* bar; unsigned x; volatile LAS unsigned* st; };
__device__ __forceinline__ void xcd_barrier_complete(unsigned* bar, unsigned x, unsigned& nloc, unsigned& nx) {
    const unsigned G = gridDim.x * gridDim.y * gridDim.z;
    unsigned sum, cnt, mine, sp = 0u;
    for (;;) {
        sum = 0u; cnt = 0u; mine = 0u;
#pragma unroll
        for (unsigned j = 0; j < 16; ++j) { const unsigned c = xb_ld(&bar[XB_XCNT(j)]); sum += c; cnt += (c > 0u) ? 1u : 0u; mine = (j == x) ? c : mine; }
        if (sum == G) break;
        __builtin_amdgcn_s_sleep(1);
        if ((++sp & 255u) == 0u) { if (xb_ld(&bar[XB_TMO])) break; if (sp > XB_SPIN_CAP) { atomicAdd(&bar[XB_TMO], 1u); break; } }
    }
    nloc = mine > 0u ? mine : 1u; nx = cnt > 0u ? cnt : 1u;
}
__device__ __forceinline__ void xcd_barrier(const XcdBarrier& b, int tid) {
    asm volatile("s_waitcnt vmcnt(0)" ::: "memory");
    __syncthreads();
    if (tid == 0) {
        unsigned* bar = b.bar;
        __builtin_amdgcn_s_waitcnt(0);
        unsigned nloc = b.st[0], nx = b.st[1];
        if (nloc == 0u) { xcd_barrier_complete(bar, b.x, nloc, nx); b.st[0] = nloc; b.st[1] = nx; }
        const unsigned old = xb_add(&bar[XB_XSUB(b.x)], 1u);
        const unsigned gen = old / nloc;
        if (old + 1u == (gen + 1u) * nloc) {
            __builtin_amdgcn_fence(__ATOMIC_RELEASE, "agent");
            asm volatile("s_waitcnt vmcnt(0)" ::: "memory");
            const unsigned og = xb_add(&bar[XB_TOP], 1u);
            const unsigned tg = og / nx;
            if (og + 1u == (tg + 1u) * nx) xb_add(&bar[XB_TOPGEN], 1u);
            else XB_SPIN(xb_ld(&bar[XB_TOPGEN]) == tg, bar);
            __builtin_amdgcn_fence(__ATOMIC_ACQUIRE, "agent");
            xb_add(&bar[XB_XGEN(b.x)], 1u);
            asm volatile("s_waitcnt vmcnt(0)" ::: "memory");
        } else {
            XB_SPIN(xb_ld(&bar[XB_XGEN(b.x)]) == gen, bar);
            __builtin_amdgcn_fence(__ATOMIC_ACQUIRE, "agent");
            asm volatile("s_waitcnt vmcnt(0)" ::: "memory");
        }
    }
    __syncthreads();
}

#ifndef PROBE_DUP
#define PROBE_DUP 0
#endif
__global__ void __launch_bounds__(NTHR, 2) fwd_megakernel(Args args) {
    extern __shared__ __attribute__((aligned(16))) unsigned char lds_raw[];
    cg::grid_group grid = cg::this_grid();
    Ctx F;
    F.lds = (LAS unsigned char*)lds_raw;
    const int wave_s = __builtin_amdgcn_readfirstlane((int)threadIdx.x >> 6);
#if !MK_MULTI
    {
        volatile LAS unsigned* st0 = (volatile LAS unsigned*)(F.lds + LDS_BARST_OFF);
        if (threadIdx.x == 0) { st0[0] = 0u; st0[1] = 0u; (void)xb_add((unsigned*)(args.ws + WS_BAR) + XB_XCNT(xb_xcc_id()), 1u); }
        __syncthreads();
    }
#endif
    const int lo = args.ph_lo, hi = args.ph_hi < NPHASES ? args.ph_hi : NPHASES;
    for (int ph2 = 2 * lo; ph2 < 2 * hi; ++ph2) {
        const int ph = ph2 >> 1;
        if (ph2 & 1) { if (ph < 3 || !((PROBE_DUP >> ((ph - 3) % 10)) & 1)) continue; }
        const bool seam = ph2 > 2 * lo;
        { CArgs* ap_ = (CArgs*)__builtin_amdgcn_kernarg_segment_ptr(); asm volatile("" : "+s"(ap_)); F.in.ap = ap_; F.out = ap_->out; F.ws = ap_->ws; }
        { int l_ = lane_id_fresh(); asm volatile("" : "+v"(l_)); int w_ = wave_s, b_ = blockIdx.x, g_ = gridDim.x; asm volatile("" : "+s"(w_), "+s"(b_), "+s"(g_));
          F.lane = l_; F.wave = w_; F.tid = w_ * 64 + l_; F.bid = b_; F.G = g_; }
        if (seam) {
            if (ph == 1 && !(ph2 & 1)) grid.sync();
            else { XcdBarrier xb; xb.bar = (unsigned*)(F.ws + WS_BAR); xb.x = xb_xcc_id(); xb.st = (volatile LAS unsigned*)(F.lds + LDS_BARST_OFF); xcd_barrier(xb, F.tid); }
        }
        bf16_t* H = (bf16_t*)(F.ws + WS_H); bf16_t* Gh = (bf16_t*)(F.ws + WS_G); float* Y = (float*)(F.ws + WS_Y);
        const float* MOD = (const float*)(F.ws + WS_MOD);
        if (ph == 0) { phase_prologue(F); continue; }
        if (ph == 1) { phase_prologue2(F); continue; }
        if (ph == 2) { phase_prologue3(F); phase_rowwise(F, true, false, false, true, MT, 0.f, nullptr, nullptr, 0, F.in[6] + 0, MOD, 0, 1); continue; }
        const int q = ph - 3, l = q / 10, kind = q % 10;
        const bool lastl = (l == DEPTH - 1);
        unsigned* CTL = (unsigned*)(F.ws + WS_CTL);
        if (kind == 0 || kind == 8) {
            const int s = kind == 0 ? 0 : 1; const int Mff = (lastl && s == 1) ? ML : MT;
            pg8::Gemm g{H, (const bf16_t*)(F.ws + WS_WGU) + (size_t)(l * 2 + s) * 5632 * DM, Mff, 5632, DM, DM, DM, 0, 0, 1};
            pg8::StaticOrder S; S.init(Mff, 5632, 1, F.G, F.bid);
            pg8::EpiSwiGLU E{Gh};
            pg8::gemm_phase<pg8::EpiSwiGLU, true, true, false>(F.lds, F.tid, g, S, E);
        } else if (kind == 1 || kind == 9) {
            const int s = kind == 1 ? 0 : 1; const int Mff = (lastl && s == 1) ? ML : MT; const int which = s ? 2 : 0;
            const bool split = (Mff == MT); const int total = 4 * (Mff / 256);
            unsigned* ctl = CTL + (l * 3 + which) * Q_SLOT_WORDS;
            if (F.tid == 0) *(LAS int*)(F.lds + LDS_PEND_OFF) = -1;
            __syncthreads();
            pg8::Gemm g{Gh, (const bf16_t*)(F.ws + WS_WD) + (size_t)(l * 2 + s) * DM * DFF, Mff, DM, DFF, DFF, DFF, 0, 0, 1};
            pg8::StaticOrder S; S.init(ML, DM, 1, F.G, F.bid);
            pg8::EpiBf16YQ E{(bf16_t*)Y, nullptr, ctl, F.in.ap, 0, 4, total, l, which, split};
            pg8::gemm_phase<pg8::EpiBf16YQ, true, true, false>(F.lds, F.tid, g, S, E);
            if (split) {
                pg8::Gemm g2{Gh + (size_t)ML * DFF, g.Bt, MC, DM, DFF / 2, DFF, DFF, (size_t)(DFF / 2) * 2, (size_t)(DFF / 2) * 2, 2};
                pg8::StaticOrder S2; S2.init(MC, DM, 2, F.G, F.bid);
                pg8::EpiBf16YQ E2{(bf16_t*)Y + (size_t)ML * DM, (bf16_t*)(F.ws + WS_Y2), ctl, F.in.ap, ML / 256, 8, total, l, which, split};
                pg8::gemm_phase<pg8::EpiBf16YQ, true, true, true>(F.lds, F.tid, g2, S2, E2);
            }
            rowq_drain(F.lds, ctl, total, F.in.ap, l, which, split, F.tid, F.wave);
        } else if (kind == 2) {
            pg8::Gemm g{H, (const bf16_t*)(F.ws + WS_WIN) + (size_t)l * INC * DM, MT, INC, DM, DM, DM, 0, 0, 1};
            pg8::StaticOrder S; S.init(MT, INC, 1, F.G, F.bid);
            pg8::EpiWin E{(bf16_t*)(F.ws + WS_Q), (bf16_t*)(F.ws + WS_K), (bf16_t*)(F.ws + WS_VT), (bf16_t*)(F.ws + WS_SSMA), (bf16_t*)(F.ws + WS_CZ), (const f32x2*)(F.ws + WS_CS)};
            pg8::gemm_phase<pg8::EpiWin, true, true, false>(F.lds, F.tid, g, S, E);
        } else if (kind == 3) {
            {
            pg8::Gemm g{(const bf16_t*)(F.ws + WS_SSMA), (const bf16_t*)(F.ws + WS_SST) + (size_t)l * 16 * 256 * 256, NCHUNK, 256, 256, 512, 256, (size_t)NCHUNK * 512 * 2, (size_t)256 * 256 * 2, 16};
            pg8::StaticOrder S; S.init(NCHUNK, 256, 16, F.G, F.bid);
            pg8::EpiF32 E{(float*)(F.ws + WS_SL), 256, (size_t)NCHUNK * 256};
            pg8::gemm_phase<pg8::EpiF32, true, true, true>(F.lds, F.tid, g, S, E);
            }
            __syncthreads();
            if (F.bid & 1) { phase_conv(F, l, lastl ? ML : MT); phase_attn(F, l, lastl); }
            else { phase_attn(F, l, lastl); phase_conv(F, l, lastl ? ML : MT); }
        } else if (kind == 4) {
            phase_scan(F, l);
        } else if (kind == 5) {
            pg8::Gemm g{(const bf16_t*)(F.ws + WS_SSMA), (const bf16_t*)(F.ws + WS_SOUT) + (size_t)l * 16 * 256 * 512, NCHUNK, 256, 512, 512, 512, (size_t)NCHUNK * 512 * 2, (size_t)256 * 512 * 2, 16};
            pg8::StaticOrder S; S.init(NCHUNK, 256, 16, F.G, F.bid);
            pg8::EpiSsmOut E{(bf16_t*)(F.ws + WS_YG)};
            pg8::gemm_phase<pg8::EpiSsmOut, true, true, true>(F.lds, F.tid, g, S, E);
        } else if (kind == 6) {
            const int Mg = lastl ? ML : MT;
            pg8::Gemm g{(const bf16_t*)(F.ws + WS_YG), (const bf16_t*)(F.ws + WS_WGLU) + (size_t)l * 256 * 256, Mg, 256, 256, 256, 256, 0, 0, 1};
            pg8::StaticOrder S; S.init(Mg, 256, 1, F.G, F.bid);
            pg8::EpiGlu E{(const bf16_t*)(F.ws + WS_YG), F.in[23] + l * 256, H};
            pg8::gemm_phase<pg8::EpiGlu, true, true, false>(F.lds, F.tid, g, S, E);
        } else {
            const int Mg = lastl ? ML : MT; const int total = 4 * (Mg / 256);
            unsigned* ctl = CTL + (l * 3 + 1) * Q_SLOT_WORDS;
            if (F.tid == 0) *(LAS int*)(F.lds + LDS_PEND_OFF) = -1;
            __syncthreads();
            pg8::Gemm g{H, (const bf16_t*)(F.ws + WS_WOUT) + (size_t)l * DM * DM, Mg, DM, DM, DM, DM, 0, 0, 1};
            pg8::StaticOrder S; S.init(Mg, DM, 1, F.G, F.bid);
            pg8::EpiBf16YQ E{(bf16_t*)Y, nullptr, ctl, F.in.ap, 0, 4, total, l, 1, false};
            pg8::gemm_phase<pg8::EpiBf16YQ, true, true, false>(F.lds, F.tid, g, S, E);
            rowq_drain(F.lds, ctl, total, F.in.ap, l, 1, false, F.tid, F.wave);
        }
    }
}

extern "C" void kernel_launch(void* const* d_in, const int* in_sizes, int n_in, void* d_out, int out_size, void* d_ws, size_t ws_size, hipStream_t stream) {
    static int grid = 0;
    if (grid == 0) {
        if (n_in != 25 || out_size != ML * DM || ws_size < WS_END) { fprintf(stderr, "kernel_launch: unexpected shapes: n_in %d out %d ws %zu\n", n_in, out_size, ws_size); grid = -1; return; }
        int dev = 0, cus = 0, per_cu = 0;
        hipGetDevice(&dev); hipDeviceGetAttribute(&cus, hipDeviceAttributeMultiprocessorCount, dev);
        if (hipFuncSetAttribute((const void*)fwd_megakernel, hipFuncAttributeMaxDynamicSharedMemorySize, LDS_BYTES) != hipSuccess) { fprintf(stderr, "kernel_launch: hipFuncSetAttribute failed\n"); grid = -1; return; }
        if (hipOccupancyMaxActiveBlocksPerMultiprocessor(&per_cu, (const void*)fwd_megakernel, NTHR, LDS_BYTES) != hipSuccess || per_cu < 1) { fprintf(stderr, "kernel_launch: occupancy query says %d\n", per_cu); per_cu = 1; }
        (void)hipGetLastError();
        grid = cus * per_cu;
        fprintf(stderr, "kernel_launch: grid %d (cus %d x %d)\n", grid, cus, per_cu);
    }
    if (grid < 0) return;
    Args a{};
    for (int i = 0; i < 25; ++i) a.in[i] = (const float*)d_in[i];
    a.out = (float*)d_out; a.ws = (unsigned char*)d_ws;
#if MK_MULTI
    for (int p = 0; p < NPHASES; ++p) { a.ph_lo = p; a.ph_hi = p + 1; hipLaunchKernelGGL(fwd_megakernel, dim3(grid), dim3(NTHR), LDS_BYTES, stream, a); }
#else
    a.ph_lo = 0; a.ph_hi = 1 << 20;
    if (hipMemsetAsync((char*)d_ws + WS_BAR, 0, 16384, stream) != hipSuccess) { fprintf(stderr, "kernel_launch: memset of the barrier words failed\n"); return; }
    void* kargs[] = {&a};
    hipError_t e = hipLaunchCooperativeKernel((const void*)fwd_megakernel, dim3(grid), dim3(NTHR), kargs, LDS_BYTES, stream);
    if (e != hipSuccess) fprintf(stderr, "cooperative launch failed: %s (grid %d)\n", hipGetErrorString(e), grid);
#endif
}
```
